# Optimizing an MI355X kernel written in HIP

```python
import jax, jax.numpy as jnp
from jax import lax
import numpy as np

D_MODEL = 1024
BATCH = 8
SEQ = 2048
DEPTH = 1
DEC_BATCH = 128
DEC_SEQ = 8
PAST_LEN = 16384
PAGE_SIZE = 128

CHUNK = 128
SGU_GROUPS = 4
SGU_WIDTH = D_MODEL // 2
SGU_GROUP_DIM = SGU_WIDTH // SGU_GROUPS
POOL_WINDOWS = (2, 4, 8, 16)
POOL_GROUPS = len(POOL_WINDOWS)
POOL_WIDTH = D_MODEL // 4
POOL_GROUP_DIM = POOL_WIDTH // POOL_GROUPS
POOL_STATE = max(POOL_WINDOWS) - 1
N_MEM = 256
X_HEADS = 4
X_WIDTH = D_MODEL // 4
X_HEAD_DIM = X_WIDTH // X_HEADS
N_BRANCH = 3
D_FF = 4 * D_MODEL
D_IN = 2 * SGU_WIDTH + POOL_WIDTH + X_WIDTH + N_BRANCH * D_MODEL
EPS = 1e-6

kernel_name = "hybrid_gmlp_pool_memxattn_decode_step"


def rmsnorm(x, g):
    xf = x.astype(jnp.float32)
    y = xf * lax.rsqrt(jnp.mean(xf * xf, axis=-1, keepdims=True) + EPS)
    return (y * g.astype(jnp.float32)).astype(x.dtype)


def layernorm(x, g, b):
    xf = x.astype(jnp.float32)
    mu = jnp.mean(xf, axis=-1, keepdims=True)
    xc = xf - mu
    y = xc * lax.rsqrt(jnp.mean(xc * xc, axis=-1, keepdims=True) + EPS)
    return (y * g.astype(jnp.float32) + b.astype(jnp.float32)).astype(x.dtype)


def chunk_spatial_gate(u, vhat, w_s, b_s):
    bsz, length, _ = u.shape
    n_chunks = -(-length // CHUNK)
    pad = n_chunks * CHUNK - length
    vp = jnp.pad(vhat, ((0, 0), (0, pad), (0, 0)))
    vp = vp.reshape(bsz, n_chunks, CHUNK, SGU_GROUPS, SGU_GROUP_DIM)
    causal = jnp.tril(jnp.ones((CHUNK, CHUNK), dtype=bool))
    w = jnp.where(causal, w_s, 0).astype(vp.dtype)
    mixed = jnp.einsum('gij,bnjgd->bnigd', w, vp) + b_s.T[None, None, :, :, None]
    mixed = mixed.reshape(bsz, n_chunks * CHUNK, SGU_WIDTH)[:, :length]
    return u * mixed


def multiscale_pool(p_prev, p_new, start_pos, w_pool, pool_scale):
    bsz, length, _ = p_new.shape
    ext = jnp.concatenate([p_prev, p_new], axis=1)
    extf = ext.astype(jnp.float32)
    csum = jnp.pad(jnp.cumsum(extf, axis=1), ((0, 0), (1, 0), (0, 0)))
    pos = start_pos + jnp.arange(length)
    means = []
    for gi, win in enumerate(POOL_WINDOWS):
        sl = slice(gi * POOL_GROUP_DIM, (gi + 1) * POOL_GROUP_DIM)
        hi = csum[:, POOL_STATE + 1:POOL_STATE + 1 + length, sl]
        lo = csum[:, POOL_STATE + 1 - win:POOL_STATE + 1 - win + length, sl]
        cnt = jnp.minimum(pos + 1, win).astype(jnp.float32)[None, :, None]
        means.append((hi - lo) / cnt)
    pooled = jnp.concatenate(means, axis=-1) - extf[:, POOL_STATE:]
    pooled = pooled.astype(p_new.dtype).reshape(bsz, length, POOL_GROUPS, POOL_GROUP_DIM)
    mixed = jnp.einsum('blgd,gde->blge', pooled, w_pool).reshape(bsz, length, POOL_WIDTH)
    return mixed * pool_scale, ext[:, -POOL_STATE:]


def memory_kv(mem, g_mem, w_kv):
    bsz = mem.shape[0]
    kv = rmsnorm(mem, g_mem) @ w_kv
    k, v = jnp.split(kv, 2, axis=-1)
    return (k.reshape(bsz, N_MEM, X_HEADS, X_HEAD_DIM),
            v.reshape(bsz, N_MEM, X_HEADS, X_HEAD_DIM))


def memory_attend(q, mem_k, mem_v):
    bsz, length, _ = q.shape
    qh = q.reshape(bsz, length, X_HEADS, X_HEAD_DIM)
    s = jnp.einsum('blhd,bmhd->bhlm', qh, mem_k,
                   preferred_element_type=jnp.float32) * (X_HEAD_DIM ** -0.5)
    p = jax.nn.softmax(s, axis=-1).astype(mem_v.dtype)
    o = jnp.einsum('bhlm,bmhd->blhd', p, mem_v)
    return o.reshape(bsz, length, X_WIDTH)


def decoder_layer(x, pool_prev, start_pos, mem_k, mem_v,
                  g_mix, w_in, g_v, b_v, w_s, b_s, w_pool, pool_scale,
                  w_out_a, w_out_b, w_out_c, w_o, g_ffn, w_up, w_down):
    length = x.shape[1]
    h = rmsnorm(x, g_mix)
    z = h @ w_in
    cuts = [SGU_WIDTH, 2 * SGU_WIDTH, 2 * SGU_WIDTH + POOL_WIDTH,
            2 * SGU_WIDTH + POOL_WIDTH + X_WIDTH]
    u, v, p, q, gate_logits = jnp.split(z, cuts, axis=-1)
    u = jax.nn.gelu(u)
    vhat = layernorm(jax.nn.gelu(v), g_v, b_v)
    a = chunk_spatial_gate(u, vhat, w_s, b_s) @ w_out_a
    pooled, pool_tail = multiscale_pool(pool_prev, p, start_pos, w_pool, pool_scale)
    b = pooled @ w_out_b
    c = memory_attend(q, mem_k, mem_v) @ w_out_c
    gates = jax.nn.sigmoid(gate_logits.astype(jnp.float32)).astype(x.dtype)
    g_a, g_b, g_c = jnp.split(gates, N_BRANCH, axis=-1)
    x = x + (g_a * a + g_b * b + g_c * c) @ w_o
    h2 = rmsnorm(x, g_ffn)
    x = x + jnp.square(jax.nn.relu(h2 @ w_up)) @ w_down
    open_start = ((length - 1) // CHUNK) * CHUNK
    return x, vhat[:, open_start:], pool_tail


def setup_inputs(seed: int = 0) -> dict:
    key = jax.random.key(seed)
    ks = iter(jax.random.split(key, 32))
    nrm = lambda shape, scale=1.0: jax.random.normal(next(ks), shape, jnp.float32) * scale
    gain = lambda shape: 1.0 + 0.05 * jax.random.normal(next(ks), shape, jnp.float32)
    L = DEPTH
    return {
        "x_prompt": nrm((BATCH, SEQ, D_MODEL)),
        "x_sample": nrm((DEC_BATCH, DEC_SEQ, D_MODEL)),
        "mem_prompt": nrm((BATCH, N_MEM, D_MODEL)),
        "cache_mem_k": nrm((L, DEC_BATCH, N_MEM, X_HEADS, X_HEAD_DIM)),
        "cache_mem_v": nrm((L, DEC_BATCH, N_MEM, X_HEADS, X_HEAD_DIM)),
        "state_pool": nrm((L, DEC_BATCH, POOL_STATE, POOL_WIDTH)),
        "g_mix": gain((L, D_MODEL)),
        "w_in": nrm((L, D_MODEL, D_IN), D_MODEL ** -0.5),
        "g_v": gain((L, SGU_WIDTH)),
        "b_v": nrm((L, SGU_WIDTH), 0.02),
        "w_s": nrm((L, SGU_GROUPS, CHUNK, CHUNK), CHUNK ** -0.5),
        "b_s": gain((L, SGU_GROUPS, CHUNK)),
        "w_pool": nrm((L, POOL_GROUPS, POOL_GROUP_DIM, POOL_GROUP_DIM), POOL_GROUP_DIM ** -0.5),
        "pool_scale": 1.0 + 0.1 * nrm((L, POOL_WIDTH)),
        "g_mem": gain((L, D_MODEL)),
        "w_kv": nrm((L, D_MODEL, 2 * X_WIDTH), D_MODEL ** -0.5),
        "w_out_a": nrm((L, SGU_WIDTH, D_MODEL), SGU_WIDTH ** -0.5),
        "w_out_b": nrm((L, POOL_WIDTH, D_MODEL), POOL_WIDTH ** -0.5),
        "w_out_c": nrm((L, X_WIDTH, D_MODEL), X_WIDTH ** -0.5),
        "w_o": nrm((L, D_MODEL, D_MODEL), D_MODEL ** -0.5),
        "g_ffn": gain((L, D_MODEL)),
        "w_up": nrm((L, D_MODEL, D_FF), D_MODEL ** -0.5),
        "w_down": nrm((L, D_FF, D_MODEL), D_FF ** -0.5),
        "g_final": gain((D_MODEL,)),
    }


def reference(x_prompt, x_sample, mem_prompt, cache_mem_k, cache_mem_v, state_pool,
              g_mix, w_in, g_v, b_v, w_s, b_s, w_pool, pool_scale, g_mem, w_kv,
              w_out_a, w_out_b, w_out_c, w_o, g_ffn, w_up, w_down, g_final):
    yp, ys = x_prompt, x_sample
    zero_prev = jnp.zeros((x_prompt.shape[0], POOL_STATE, POOL_WIDTH), x_prompt.dtype)
    mk_p, mv_p, pool_p, pool_s, cv_p, cv_s = [], [], [], [], [], []
    for l in range(DEPTH):
        lw = (g_mix[l], w_in[l], g_v[l], b_v[l], w_s[l], b_s[l], w_pool[l], pool_scale[l],
              w_out_a[l], w_out_b[l], w_out_c[l], w_o[l], g_ffn[l], w_up[l], w_down[l])
        mem_k, mem_v = memory_kv(mem_prompt, g_mem[l], w_kv[l])
        yp, vrows_p, ptail_p = decoder_layer(yp, zero_prev, 0, mem_k, mem_v, *lw)
        ys, vrows_s, ptail_s = decoder_layer(ys, state_pool[l], PAST_LEN,
                                             cache_mem_k[l], cache_mem_v[l], *lw)
        mk_p.append(mem_k)
        mv_p.append(mem_v)
        pool_p.append(ptail_p)
        pool_s.append(ptail_s)
        cv_p.append(vrows_p)
        cv_s.append(vrows_s)
    y_prompt = rmsnorm(yp, g_final)
    y_sample = rmsnorm(ys, g_final)
    return (y_prompt, y_sample, jnp.stack(mk_p), jnp.stack(mv_p), jnp.stack(pool_p),
            jnp.stack(pool_s), jnp.stack(cv_p), jnp.stack(cv_s))
```

```cpp
#include <hip/hip_runtime.h>
#include <hip/hip_cooperative_groups.h>
#include <cstdio>
#include <cstdint>
namespace cg = cooperative_groups;

#define LAS __attribute__((address_space(3)))
typedef unsigned short bf16_t;
typedef short bf16x8 __attribute__((ext_vector_type(8)));
typedef float f32x4 __attribute__((ext_vector_type(4)));
typedef float f32x2 __attribute__((ext_vector_type(2)));
typedef unsigned u32x4 __attribute__((ext_vector_type(4)));
typedef unsigned u32x2 __attribute__((ext_vector_type(2)));

constexpr int DM = 1024, MP = 16384, MS = 1024, MT = MP + MS  , DIN = 4608, DFF = 4096;
constexpr int MKV = 2048;
constexpr float EPS = 1e-6f;
constexpr size_t MiB = 1u << 20;
constexpr size_t WS_WIN = 1 * MiB;
constexpr size_t WS_WO = 11 * MiB;
constexpr size_t WS_WUP = 13 * MiB;
constexpr size_t WS_WDN = 21 * MiB;
constexpr size_t WS_WBR = 29 * MiB;
constexpr size_t WS_WSB = 31 * MiB;
constexpr size_t WS_SSP4 = 2 * MiB + 256 * 1024;
constexpr size_t WS_SSP = 1 * MiB;
constexpr size_t WS_XN = 48 * MiB;
constexpr size_t WS_Z = 86 * MiB;
constexpr size_t WS_X1B_LO = 239 * MiB, WS_X1B_HI = 31 * MiB;
constexpr int X1B_SPLIT = 34;
constexpr size_t OS_P = 0;
constexpr size_t OS_KB = 17 * MiB;
constexpr size_t OS_VTB = 34 * MiB;
constexpr size_t O_Y = 0, O_MK = 17825792, O_MV = 18350080, O_PP = 18874368, O_PS = 18905088, O_CVP = 19396608, O_CVS = 19920896;
constexpr int LDS_BYTES = 147456 + 256;

__device__ __forceinline__ unsigned f2bf(float f) { unsigned u = __builtin_bit_cast(unsigned, f); return (u + 0x7fffu + ((u >> 16) & 1u)) >> 16; }
__device__ __forceinline__ unsigned pk2(float lo, float hi) { return f2bf(lo) | (f2bf(hi) << 16); }
__device__ __forceinline__ float bf_lo(unsigned w) { return __builtin_bit_cast(float, w << 16); }
__device__ __forceinline__ float bf_hi(unsigned w) { return __builtin_bit_cast(float, w & 0xffff0000u); }
__device__ __forceinline__ unsigned cvt_pk_bf16(float lo, float hi) { unsigned r; asm volatile("v_cvt_pk_bf16_f32 %0, %1, %2" : "=v"(r) : "v"(lo), "v"(hi)); return r; }
__device__ __forceinline__ float gelu_t(float x) {
    const float y = 0.7978845608f * (x + 0.044715f * x * x * x);
    const float e = __builtin_amdgcn_exp2f(-2.885390082f * y);
    return x * __builtin_amdgcn_rcpf(1.0f + e);
}
__device__ __forceinline__ unsigned gate_q(float x) { const float g = __builtin_amdgcn_rcpf(1.0f + __builtin_amdgcn_exp2f(-1.4426950409f * x)); return (unsigned)fminf(fmaxf(g * 255.0f + 0.5f, 1.0f), 255.0f); }
__device__ __forceinline__ float ub0(unsigned w) { return (float)(w & 0xffu); }
__device__ __forceinline__ float ub1(unsigned w) { return (float)((w >> 8) & 0xffu); }
__device__ __forceinline__ float ub2(unsigned w) { return (float)((w >> 16) & 0xffu); }
__device__ __forceinline__ float ub3(unsigned w) { return (float)(w >> 24); }
__device__ __forceinline__ f32x2 gelu_t2(f32x2 x) {
    const f32x2 x2 = x * x, pch = x2 * 0.0356774081f + 0.7978845608f, t = (pch * x) * (-2.885390082f);
    f32x2 e; e.x = __builtin_amdgcn_exp2f(t.x); e.y = __builtin_amdgcn_exp2f(t.y);
    const f32x2 d = e + 1.0f; f32x2 r; r.x = __builtin_amdgcn_rcpf(d.x); r.y = __builtin_amdgcn_rcpf(d.y);
    return x * r;
}

__device__ __forceinline__ int lane_id() { int l; asm volatile("v_mbcnt_lo_u32_b32 %0, -1, 0\n\tv_mbcnt_hi_u32_b32 %0, -1, %0" : "=v"(l)); return l; }
struct Args {
    const float *x_prompt, *x_sample, *mem, *cache_k, *cache_v, *state_pool;
    const float *g_mix, *w_in, *g_v, *b_v, *w_s, *b_s, *w_pool, *pool_scale, *g_mem, *w_kv;
    const float *w_out_a, *w_out_b, *w_out_c, *w_o, *g_ffn, *w_up, *w_down, *g_final;
    float* out; unsigned char* ws; int ph_lo, ph_hi;
};

namespace pg8 {
constexpr int BM = 256, BK = 64, HALF = 128, HTB = HALF * BK * 2, STAGE_BYTES = 8 * HTB;
__device__ __forceinline__ int lds_byte(int r, int c) { const int st = (r >> 4) * 2 + (c >> 5), rr = r & 15, cc = c & 31, ob = rr * 64 + cc * 2; return st * 1024 + (ob ^ (((ob >> 9) & 1) << 5)); }
__device__ __forceinline__ void stage_rc(int b, int& R, int& C) { const int st = b / 1024, sb = b % 1024, swz = sb ^ (((sb >> 9) & 1) << 5); R = (st >> 1) * 16 + swz / 64; C = (st & 1) * 32 + (swz % 64) / 2; }
__device__ __forceinline__ int perm32(int rho) { const int n = rho >> 4, i = rho & 15; return 8 * (i >> 2) + 4 * n + (i & 3); }

struct Unit { int pm, pn, ka, kb, nt, tag; };
struct Gemm { const bf16_t* A; const bf16_t* Bt; int lda, ldb; const bf16_t* A2; int psplit; };

__device__ __forceinline__ void tile_map(int nM, int nN, int L, int& pm, int& pn) {
    const int nwg = nM * nN; int wgid = L;
    { const int q = nwg / 8, r = nwg % 8, xcd = wgid % 8, off = wgid / 8; wgid = (xcd < r ? xcd * (q + 1) : r * (q + 1) + (xcd - r) * q) + off; }
    const int nig = 8 * nN, gid = wgid / nig, fm = gid * 8, gsz = (nM - fm) < 8 ? (nM - fm) : 8;
    pm = fm + ((wgid % nig) % gsz); pn = (wgid % nig) / gsz;
}

template <class Epi, class Sched>
__device__ __forceinline__ void gemm_phase(LAS unsigned char* lds, const Gemm g, const Sched& S, const Epi& E, int wave_s) {
    const int wid = wave_s, lane = lane_id(), tid = wid * 64 + lane, wr = wid >> 2, wc = wid & 3, fr = lane & 15, fq = lane >> 4;
    unsigned voffA[2], voffB[2];
#pragma unroll
    for (int i = 0; i < 2; ++i) { int R, C; stage_rc(tid * 16 + i * 8192, R, C); const int Rb = (R & ~31) + perm32(R & 31);
        voffA[i] = (unsigned)(R * g.lda + C) * 2u; voffB[i] = (unsigned)(Rb * g.ldb + C) * 2u; }
    const size_t kstep = (size_t)(BK * 2);
    const size_t hstepA = (size_t)HALF * g.lda * 2, hstepB = (size_t)HALF * g.ldb * 2;
    const size_t tstepA = 2 * hstepA, tstepB = 2 * hstepB;
    const unsigned ldsw = (unsigned)wid * 1024u;
    const int aoff = lds_byte(wr * 64 + fr, fq * 8), boff = lds_byte(wc * 32 + fr, fq * 8);
#define PG8_SA(b, h) (((b) * 2 + (h)) * HTB)
#define PG8_SB(b, h) ((4 + (b) * 2 + (h)) * HTB)
#define PG8_STAGE(bufoff, gbase, voff) do { _Pragma("unroll") for (int _i = 0; _i < 2; ++_i) \
        __builtin_amdgcn_global_load_lds((const unsigned*)((const char*)(gbase) + (voff)[_i]), (LAS unsigned*)(lds + (bufoff) + ldsw + _i * 8192), 16, 0, 0); } while (0)
#define PG8_LDA(dst, b, h) do { _Pragma("unroll") for (int m = 0; m < 4; ++m) _Pragma("unroll") for (int k = 0; k < 2; ++k) dst[m][k] = *(const LAS bf16x8*)(lds + PG8_SA(b, h) + aoff + m * 2048 + k * 1024); } while (0)
#define PG8_LDB(dst, b, h) do { _Pragma("unroll") for (int n = 0; n < 2; ++n) _Pragma("unroll") for (int k = 0; k < 2; ++k) dst[n][k] = *(const LAS bf16x8*)(lds + PG8_SB(b, h) + boff + n * 2048 + k * 1024); } while (0)
#define PG8_MMA(ai, bj, At, Bt) do { __builtin_amdgcn_s_setprio(1); _Pragma("unroll") for (int m = 0; m < 4; ++m) _Pragma("unroll") for (int n = 0; n < 2; ++n) _Pragma("unroll") for (int k = 0; k < 2; ++k) \
        acc[ai][bj][m][n] = __builtin_amdgcn_mfma_f32_16x16x32_bf16(Bt[n][k], At[m][k], acc[ai][bj][m][n], 0, 0, 0); __builtin_amdgcn_s_setprio(0); } while (0)
#define PG8_WAIT_V(n) asm volatile("s_waitcnt vmcnt(" #n ")" ::: "memory")
#define PG8_WAIT_L(n) asm volatile("s_waitcnt lgkmcnt(" #n ")" ::: "memory")
#define PG8_BAR __builtin_amdgcn_s_barrier()
#define PG8_SCHED __builtin_amdgcn_sched_barrier(0)
    Unit cur, nxt; int ui = 0;
    if (!S.next(0, cur)) return;
    f32x4 acc[2][2][4][2];
#pragma unroll
    for (int a = 0; a < 2; ++a)
#pragma unroll
        for (int b = 0; b < 2; ++b)
#pragma unroll
            for (int m = 0; m < 4; ++m)
#pragma unroll
                for (int n = 0; n < 2; ++n) acc[a][b][m][n] = (f32x4){0.f, 0.f, 0.f, 0.f};
    bf16x8 At[4][2], B0[2][2], B1[2][2];
    const char* cA = (cur.pm < g.psplit ? (const char*)g.A + (size_t)cur.pm * tstepA : (const char*)g.A2 + (size_t)(cur.pm - g.psplit) * tstepA) + cur.ka; const char* cB = (const char*)g.Bt + (size_t)cur.pn * tstepB + cur.kb;
    PG8_STAGE(PG8_SB(0, 0), cB, voffB); PG8_STAGE(PG8_SB(0, 1), cB + hstepB, voffB); PG8_STAGE(PG8_SA(0, 0), cA, voffA); PG8_STAGE(PG8_SA(0, 1), cA + hstepA, voffA);
    if (wr == 1) PG8_BAR;
    PG8_WAIT_V(2); PG8_BAR;
    PG8_STAGE(PG8_SB(1, 0), cB + kstep, voffB); PG8_STAGE(PG8_SA(1, 0), cA + kstep, voffA); PG8_STAGE(PG8_SB(1, 1), cB + hstepB + kstep, voffB);
    PG8_WAIT_V(6); PG8_BAR;
    for (;;) {
        const bool has_next = S.next(ui + 1, nxt);
        const char* nA = has_next ? (nxt.pm < g.psplit ? (const char*)g.A + (size_t)nxt.pm * tstepA : (const char*)g.A2 + (size_t)(nxt.pm - g.psplit) * tstepA) + nxt.ka : cA; const char* nB = has_next ? (const char*)g.Bt + (size_t)nxt.pn * tstepB + nxt.kb : cB;
        const int nt = cur.nt;
        for (int t = 0; t < nt; t += 2) {
            const bool last = (t == nt - 2);
            const char* a1 = cA + (size_t)(t + 1) * kstep;
            const char* a2 = last ? nA : cA + (size_t)(t + 2) * kstep; const char* b2 = last ? nB : cB + (size_t)(t + 2) * kstep;
            const char* a3 = a2 + kstep; const char* b3 = b2 + kstep;
            PG8_LDB(B0, 0, 0); PG8_LDB(B1, 0, 1); PG8_SCHED; PG8_LDA(At, 0, 0); PG8_STAGE(PG8_SA(1, 1), a1 + hstepA, voffA);
            PG8_WAIT_V(8); PG8_WAIT_L(0); PG8_BAR; PG8_MMA(0, 0, At, B0); PG8_MMA(0, 1, At, B1); PG8_BAR; PG8_SCHED;
            PG8_LDA(At, 0, 1); PG8_STAGE(PG8_SB(0, 0), b2, voffB); PG8_STAGE(PG8_SB(0, 1), b2 + hstepB, voffB); PG8_STAGE(PG8_SA(0, 0), a2, voffA);
            PG8_WAIT_V(8); PG8_WAIT_L(0); PG8_BAR; PG8_MMA(1, 0, At, B0); PG8_MMA(1, 1, At, B1); PG8_BAR; PG8_SCHED;
            PG8_LDB(B0, 1, 0); PG8_LDB(B1, 1, 1); PG8_SCHED; PG8_LDA(At, 1, 0); PG8_STAGE(PG8_SA(0, 1), a2 + hstepA, voffA);
            PG8_WAIT_V(8); PG8_WAIT_L(0); PG8_BAR; PG8_MMA(0, 0, At, B0); PG8_MMA(0, 1, At, B1); PG8_BAR; PG8_SCHED;
            PG8_LDA(At, 1, 1); PG8_STAGE(PG8_SB(1, 0), b3, voffB); PG8_STAGE(PG8_SB(1, 1), b3 + hstepB, voffB); PG8_STAGE(PG8_SA(1, 0), a3, voffA);
            PG8_WAIT_V(8); PG8_WAIT_L(0); PG8_BAR; PG8_MMA(1, 0, At, B0); PG8_MMA(1, 1, At, B1); PG8_BAR; PG8_SCHED;
        }
        if (wr == 0) PG8_BAR;
        const bool zero = E(acc, cur, wr, wc, fr, fq);
        if (!has_next) break;
        if (zero) {
#pragma unroll
            for (int a = 0; a < 2; ++a)
#pragma unroll
                for (int b = 0; b < 2; ++b)
#pragma unroll
                    for (int m = 0; m < 4; ++m)
#pragma unroll
                        for (int n = 0; n < 2; ++n) acc[a][b][m][n] = (f32x4){0.f, 0.f, 0.f, 0.f};
        }
        cur = nxt; cA = nA; cB = nB; ++ui;
        if (wr == 1) PG8_BAR;
    }
    PG8_WAIT_V(0);
    PG8_BAR;
#undef PG8_SA
#undef PG8_SB
#undef PG8_STAGE
#undef PG8_LDA
#undef PG8_LDB
#undef PG8_MMA
#undef PG8_WAIT_V
#undef PG8_WAIT_L
#undef PG8_BAR
#undef PG8_SCHED
}
}
using pg8::Unit;

struct SchedP1 {
    int G, c;
    __device__ __forceinline__ bool next(int i, Unit& u) const {
        int L = i * G + c;
        if (L < 1224) { pg8::tile_map(68, 18, L, u.pm, u.pn); u.ka = 0; u.kb = 0; u.nt = 16; u.tag = 0; return true; }
        L -= 1224;
        if (L < 16) { u.pm = 68 + (L & 7); u.pn = 18 + (L >> 3); u.ka = 0; u.kb = 0; u.nt = 16; u.tag = 1; return true; }
        return false;
    }
};
struct SchedT {
    int nM, nN, nt, G, c;
    __device__ __forceinline__ bool next(int i, Unit& u) const {
        const int L = i * G + c; if (L >= nM * nN) return false;
        pg8::tile_map(nM, nN, L, u.pm, u.pn); u.ka = 0; u.kb = 0; u.nt = nt; u.tag = 0; return true;
    }
};
struct SchedP3 {
    int G, c;
    __device__ __forceinline__ bool next(int i, Unit& u) const {
        const int j = i / 3, br = i - 3 * j; const int L = j * G + c; if (L >= 272) return false;
        pg8::tile_map(68, 4, L, u.pm, u.pn);
        u.tag = br; u.nt = br == 0 ? 8 : 4; u.ka = br == 0 ? 0 : (br == 1 ? 2048 : 2560); u.kb = br == 0 ? 0 : (br == 1 ? 1024 : 1536);
        return true;
    }
};

struct SchedOne3 {
    int pm, pn;
    __device__ __forceinline__ bool next(int i, Unit& u) const {
        if (i >= 3) return false;
        u.pm = pm; u.pn = pn; u.tag = i; u.nt = i == 0 ? 8 : 4; u.ka = i == 0 ? 0 : (i == 1 ? 2048 : 2560); u.kb = i == 0 ? 0 : (i == 1 ? 1024 : 1536); return true;
    }
};
struct SchedOne {
    int pm, pn, nt;
    __device__ __forceinline__ bool next(int i, Unit& u) const { if (i >= 1) return false; u.pm = pm; u.pn = pn; u.ka = 0; u.kb = 0; u.nt = nt; u.tag = 0; return true; }
};
__device__ __forceinline__ void tile272(int L, int& pm, int& pn) { if (L < 256) pg8::tile_map(64, 4, L, pm, pn); else { pm = 64 + ((L - 256) >> 2); pn = (L - 256) & 3; } }
struct SchedP6 {
    int G, c;
    __device__ __forceinline__ bool next(int i, Unit& u) const {
        if (G == 256) {
            if (i == 1) { pg8::tile_map(64, 4, c, u.pm, u.pn); u.ka = 0; u.kb = 0; u.nt = 64; u.tag = 0; return true; }
            if (i == 0) { const int j = c >> 4; u.pm = 64 + (j >> 2); u.pn = j & 3; u.ka = (c & 15) * 512; u.kb = u.ka; u.nt = 4; u.tag = 1 + (c & 15); return true; }
            return false;
        }
        const int L = i * G + c; if (L >= 272) return false;
        pg8::tile_map(68, 4, L, u.pm, u.pn); u.ka = 0; u.kb = 0; u.nt = 64; u.tag = 0; return true;
    }
};
__device__ __forceinline__ float* part_base(unsigned char* ws, int s) {
    const size_t mb = s < 8 ? 48 + 4 * (size_t)s : (s < 12 ? 222 + 4 * (size_t)(s - 8) : (s < 14 ? 13 + 4 * (size_t)(s - 12) : 3 + 4 * (size_t)(s - 14)));
    return (float*)(ws + mb * MiB);
}
__device__ __forceinline__ void panel_signal(unsigned* cnt, int wave_s);
__device__ __forceinline__ void panel_wait(unsigned* cnt, unsigned want, unsigned* bar, int wave_s);
#define EPI_ROWS(u) const int row0 = (u).pm * 256 + wr * 64 + fr; const int col0 = (u).pn * 256 + wc * 32 + 8 * fq;
struct EpiP1 {
    bf16_t* Z; float* P; float* outk; float* outv; bf16_t* KB; bf16_t* VTB;
    __device__ __forceinline__ bool operator()(const f32x4 (&acc)[2][2][4][2], const Unit& u, int wr, int wc, int fr, int fq) const {
        EPI_ROWS(u)
        if (u.tag == 0) {
            const int pn = u.pn;
#pragma unroll
            for (int ai = 0; ai < 2; ++ai)
#pragma unroll
                for (int m = 0; m < 4; ++m) { const int row = row0 + ai * 128 + m * 16;
#pragma unroll
                    for (int bj = 0; bj < 2; ++bj) { const int col = col0 + bj * 128; f32x4 v0 = acc[ai][bj][m][0], v1 = acc[ai][bj][m][1];
                        if (pn == 4) { float* p = P + (size_t)row * 256 + (col - 1024); *(f32x4*)p = v0; *(f32x4*)(p + 4) = v1; }
                        else {
                            if (pn < 4) {
                                const f32x2 a0 = gelu_t2((f32x2){v0[0], v0[1]}), a1 = gelu_t2((f32x2){v0[2], v0[3]}), a2 = gelu_t2((f32x2){v1[0], v1[1]}), a3 = gelu_t2((f32x2){v1[2], v1[3]});
                                v0 = (f32x4){a0.x, a0.y, a1.x, a1.y}; v1 = (f32x4){a2.x, a2.y, a3.x, a3.y};
                            } else if (pn >= 6) {
                                u32x2 q; q.x = gate_q(v0[0]) | (gate_q(v0[1]) << 8) | (gate_q(v0[2]) << 16) | (gate_q(v0[3]) << 24); q.y = gate_q(v1[0]) | (gate_q(v1[1]) << 8) | (gate_q(v1[2]) << 16) | (gate_q(v1[3]) << 24);
                                *(u32x2*)((unsigned char*)Z + (size_t)row * (DIN * 2) + 1536 + col) = q; continue;
                            }
                            u32x4 w; w.x = cvt_pk_bf16(v0[0], v0[1]); w.y = cvt_pk_bf16(v0[2], v0[3]); w.z = cvt_pk_bf16(v1[0], v1[1]); w.w = cvt_pk_bf16(v1[2], v1[3]);
                            *(u32x4*)(Z + (size_t)row * DIN + col) = w;
                        } } }
        } else {
            const bool isv = (u.pn == 19);
#pragma unroll
            for (int ai = 0; ai < 2; ++ai)
#pragma unroll
                for (int m = 0; m < 4; ++m) { const int r = row0 - 68 * 256 + ai * 128 + m * 16;
#pragma unroll
                    for (int bj = 0; bj < 2; ++bj) { const int c = wc * 32 + 8 * fq + bj * 128; const f32x4 v0 = acc[ai][bj][m][0], v1 = acc[ai][bj][m][1];
                        float* o = (isv ? outv : outk) + (size_t)r * 256 + c; *(f32x4*)o = v0; *(f32x4*)(o + 4) = v1;
                        if (!isv) { u32x4 w; w.x = cvt_pk_bf16(v0[0], v0[1]); w.y = cvt_pk_bf16(v0[2], v0[3]); w.z = cvt_pk_bf16(v1[0], v1[1]); w.w = cvt_pk_bf16(v1[2], v1[3]);
                            *(u32x4*)(KB + (size_t)r * 256 + c) = w; }
                        else { bf16_t* vt = VTB + ((size_t)(r >> 8) * 256 + c) * 256 + (r & 255);
#pragma unroll
                            for (int e = 0; e < 4; ++e) { vt[(size_t)e * 256] = (bf16_t)f2bf(v0[e]); vt[(size_t)(e + 4) * 256] = (bf16_t)f2bf(v1[e]); } }
                    } }
        }
        return true;
    }
};
struct EpiP3 {
    const bf16_t* Z; bf16_t* MG; bool wt;
    __device__ __forceinline__ bool operator()(f32x4 (&acc)[2][2][4][2], const Unit& u, int wr, int wc, int fr, int fq) const {
        EPI_ROWS(u)
        const int br = u.tag;
        u32x2 gn[2][4][2], gd[2][4][2];
#pragma unroll
        for (int ai = 0; ai < 2; ++ai)
#pragma unroll
            for (int m = 0; m < 4; ++m)
#pragma unroll
                for (int bj = 0; bj < 2; ++bj) { const unsigned char* gp = (const unsigned char*)Z + (size_t)(row0 + ai * 128 + m * 16) * (DIN * 2) + 3072 + br * 1024 + col0 + bj * 128;
                    gn[ai][m][bj] = *(const u32x2*)gp; if (br < 2) gd[ai][m][bj] = *(const u32x2*)(gp + 1024); }
        asm volatile("" ::: "memory");
#pragma unroll
        for (int ai = 0; ai < 2; ++ai)
#pragma unroll
            for (int m = 0; m < 4; ++m) { const int row = row0 + ai * 128 + m * 16;
#pragma unroll
                for (int bj = 0; bj < 2; ++bj) { const int col = col0 + bj * 128;
                    const u32x2 g1 = gn[ai][m][bj];
                    float f[8];
                    f[0] = ub0(g1.x); f[1] = ub1(g1.x); f[2] = ub2(g1.x); f[3] = ub3(g1.x); f[4] = ub0(g1.y); f[5] = ub1(g1.y); f[6] = ub2(g1.y); f[7] = ub3(g1.y);
                    if (br < 2) { const u32x2 g2 = gd[ai][m][bj];
                        f[0] *= __builtin_amdgcn_rcpf(ub0(g2.x)); f[1] *= __builtin_amdgcn_rcpf(ub1(g2.x)); f[2] *= __builtin_amdgcn_rcpf(ub2(g2.x)); f[3] *= __builtin_amdgcn_rcpf(ub3(g2.x));
                        f[4] *= __builtin_amdgcn_rcpf(ub0(g2.y)); f[5] *= __builtin_amdgcn_rcpf(ub1(g2.y)); f[6] *= __builtin_amdgcn_rcpf(ub2(g2.y)); f[7] *= __builtin_amdgcn_rcpf(ub3(g2.y)); }
                    else {
#pragma unroll
                        for (int e = 0; e < 8; ++e) f[e] *= (1.0f / 255.0f); }
                    f32x4 v0 = acc[ai][bj][m][0], v1 = acc[ai][bj][m][1];
                    v0[0] *= f[0]; v0[1] *= f[1]; v0[2] *= f[2]; v0[3] *= f[3]; v1[0] *= f[4]; v1[1] *= f[5]; v1[2] *= f[6]; v1[3] *= f[7];
                    if (br < 2) { acc[ai][bj][m][0] = v0; acc[ai][bj][m][1] = v1; }
                    else { u32x4 w; w.x = cvt_pk_bf16(v0[0], v0[1]); w.y = cvt_pk_bf16(v0[2], v0[3]); w.z = cvt_pk_bf16(v1[0], v1[1]); w.w = cvt_pk_bf16(v1[2], v1[3]);
                        if (!wt) *(u32x4*)(MG + (size_t)row * DM + col) = w;
                        else { unsigned long long* mp = (unsigned long long*)(MG + (size_t)row * DM + col);
                            __hip_atomic_store(mp, (unsigned long long)w.x | ((unsigned long long)w.y << 32), __ATOMIC_RELAXED, __HIP_MEMORY_SCOPE_AGENT);
                            __hip_atomic_store(mp + 1, (unsigned long long)w.z | ((unsigned long long)w.w << 32), __ATOMIC_RELAXED, __HIP_MEMORY_SCOPE_AGENT); } }
                } }
        return br == 2;
    }
};
struct EpiP4 {
    const float* xp; const float* xs; float* out; bf16_t* X1Blo; bf16_t* X1Bhi; float* SSP; float* SSP4; LAS unsigned char* lds;
    __device__ __forceinline__ bool operator()(const f32x4 (&acc)[2][2][4][2], const Unit& u, int wr, int wc, int fr, int fq) const {
        EPI_ROWS(u)
        const float* xb = u.pm < 64 ? xp : xs - (size_t)MP * DM;
        bf16_t* X1B = u.pm < X1B_SPLIT ? X1Blo : X1Bhi - (size_t)X1B_SPLIT * 256 * DM;
#pragma unroll
        for (int ai = 0; ai < 2; ++ai) {
            f32x4 xv[4][2][2];
#pragma unroll
            for (int m = 0; m < 4; ++m)
#pragma unroll
                for (int bj = 0; bj < 2; ++bj) { const size_t off = (size_t)(row0 + ai * 128 + m * 16) * DM + col0 + bj * 128; xv[m][bj][0] = *(const f32x4*)(xb + off); xv[m][bj][1] = *(const f32x4*)(xb + off + 4); }
            asm volatile("" ::: "memory");
#pragma unroll
            for (int m = 0; m < 4; ++m) { const int row = row0 + ai * 128 + m * 16; float ss = 0.f;
#pragma unroll
                for (int bj = 0; bj < 2; ++bj) { const int col = col0 + bj * 128; const size_t off = (size_t)row * DM + col;
                    const f32x4 v0 = acc[ai][bj][m][0] + xv[m][bj][0], v1 = acc[ai][bj][m][1] + xv[m][bj][1];
                    u32x4 w; w.x = cvt_pk_bf16(v0[0], v0[1]); w.y = cvt_pk_bf16(v0[2], v0[3]); w.z = cvt_pk_bf16(v1[0], v1[1]); w.w = cvt_pk_bf16(v1[2], v1[3]);
                    *(u32x4*)(X1B + off) = w;
                    ss += (v0[0] * v0[0] + v0[1] * v0[1]) + (v0[2] * v0[2] + v0[3] * v0[3]) + (v1[0] * v1[0] + v1[1] * v1[1]) + (v1[2] * v1[2] + v1[3] * v1[3]); }
                ss += __shfl_xor(ss, 16); ss += __shfl_xor(ss, 32);
                if (fq == 0) { SSP[(size_t)row * 16 + u.pn * 4 + wc] = ss; ((LAS float*)(lds + 131072))[(ai * 128 + wr * 64 + m * 16 + fr) * 4 + wc] = ss; } }
            asm volatile("" ::: "memory");
        }
        __syncthreads();
        { const int t = (wr * 4 + wc) * 64 + fq * 16 + fr;
          if (t < 256) { const f32x4 q = *(const LAS f32x4*)(lds + 131072 + t * 16); SSP4[(size_t)(u.pm * 256 + t) * 4 + u.pn] = (q[0] + q[1]) + (q[2] + q[3]); } }
        __syncthreads();
        return true;
    }
};
struct EpiP5 {
    const float* SSP; bf16_t* H; const float* SSP4; int n4;
    __device__ __forceinline__ bool operator()(const f32x4 (&acc)[2][2][4][2], const Unit& u, int wr, int wc, int fr, int fq) const {
        EPI_ROWS(u)
        if (u.pm < n4) {
            f32x4 sq[2][4];
#pragma unroll
            for (int ai = 0; ai < 2; ++ai)
#pragma unroll
                for (int m = 0; m < 4; ++m) sq[ai][m] = *(const f32x4*)(SSP4 + (size_t)(row0 + ai * 128 + m * 16) * 4);
            asm volatile("" ::: "memory");
#pragma unroll
            for (int ai = 0; ai < 2; ++ai)
#pragma unroll
                for (int m = 0; m < 4; ++m) { const int row = row0 + ai * 128 + m * 16; const f32x4 q = sq[ai][m];
                    const float rstd = 1.0f / sqrtf(((q[0] + q[1]) + (q[2] + q[3])) * (1.0f / DM) + EPS);
#pragma unroll
                    for (int bj = 0; bj < 2; ++bj) { const int col = col0 + bj * 128; f32x4 v0 = acc[ai][bj][m][0] * rstd, v1 = acc[ai][bj][m][1] * rstd;
#pragma unroll
                        for (int e = 0; e < 4; ++e) { const float a = fmaxf(v0[e], 0.f), b = fmaxf(v1[e], 0.f); v0[e] = a * a; v1[e] = b * b; }
                        u32x4 w; w.x = cvt_pk_bf16(v0[0], v0[1]); w.y = cvt_pk_bf16(v0[2], v0[3]); w.z = cvt_pk_bf16(v1[0], v1[1]); w.w = cvt_pk_bf16(v1[2], v1[3]);
                        *(u32x4*)(H + (size_t)row * DFF + col) = w; } }
            return true;
        }
#pragma unroll
        for (int ai = 0; ai < 2; ++ai) {
            f32x4 sv[4][4];
#pragma unroll
            for (int m = 0; m < 4; ++m) { const f32x4* sp = (const f32x4*)(SSP + (size_t)(row0 + ai * 128 + m * 16) * 16);
#pragma unroll
                for (int k = 0; k < 4; ++k) sv[m][k] = sp[k]; }
            asm volatile("" ::: "memory");
#pragma unroll
            for (int m = 0; m < 4; ++m) { const int row = row0 + ai * 128 + m * 16;
                const f32x4 s0 = sv[m][0], s1 = sv[m][1], s2 = sv[m][2], s3 = sv[m][3];
                const float ss = ((s0[0] + s0[1]) + (s0[2] + s0[3])) + ((s1[0] + s1[1]) + (s1[2] + s1[3])) + ((s2[0] + s2[1]) + (s2[2] + s2[3])) + ((s3[0] + s3[1]) + (s3[2] + s3[3]));
                const float rstd = 1.0f / sqrtf(ss * (1.0f / DM) + EPS);
#pragma unroll
                for (int bj = 0; bj < 2; ++bj) { const int col = col0 + bj * 128; f32x4 v0 = acc[ai][bj][m][0] * rstd, v1 = acc[ai][bj][m][1] * rstd;
#pragma unroll
                    for (int e = 0; e < 4; ++e) { const float a = fmaxf(v0[e], 0.f), b = fmaxf(v1[e], 0.f); v0[e] = a * a; v1[e] = b * b; }
                    u32x4 w; w.x = cvt_pk_bf16(v0[0], v0[1]); w.y = cvt_pk_bf16(v0[2], v0[3]); w.z = cvt_pk_bf16(v1[0], v1[1]); w.w = cvt_pk_bf16(v1[2], v1[3]);
                    *(u32x4*)(H + (size_t)row * DFF + col) = w; } }
            asm volatile("" ::: "memory");
        }
        return true;
    }
};
struct EpiP6 {
    float* out; unsigned char* ws; const bf16_t* X1Blo; const bf16_t* X1Bhi;
    __device__ __forceinline__ bool operator()(const f32x4 (&acc)[2][2][4][2], const Unit& u, int wr, int wc, int fr, int fq) const {
        EPI_ROWS(u)
        if (u.tag == 0) {
            const bf16_t* X1B = u.pm < X1B_SPLIT ? X1Blo : X1Bhi - (size_t)X1B_SPLIT * 256 * DM;
#pragma unroll
            for (int ai = 0; ai < 2; ++ai) {
                u32x4 xv[4][2];
#pragma unroll
                for (int m = 0; m < 4; ++m)
#pragma unroll
                    for (int bj = 0; bj < 2; ++bj) xv[m][bj] = *(const u32x4*)(X1B + (size_t)(row0 + ai * 128 + m * 16) * DM + col0 + bj * 128);
                asm volatile("" ::: "memory");
#pragma unroll
                for (int m = 0; m < 4; ++m)
#pragma unroll
                    for (int bj = 0; bj < 2; ++bj) { const size_t off = (size_t)(row0 + ai * 128 + m * 16) * DM + col0 + bj * 128; const u32x4 xw = xv[m][bj];
                        *(f32x4*)(out + off) = acc[ai][bj][m][0] + (f32x4){bf_lo(xw.x), bf_hi(xw.x), bf_lo(xw.y), bf_hi(xw.y)};
                        *(f32x4*)(out + off + 4) = acc[ai][bj][m][1] + (f32x4){bf_lo(xw.z), bf_hi(xw.z), bf_lo(xw.w), bf_hi(xw.w)}; }
                asm volatile("" ::: "memory");
            }
        } else {
            float* pb = part_base(ws, u.tag - 1);
#pragma unroll
            for (int ai = 0; ai < 2; ++ai)
#pragma unroll
                for (int m = 0; m < 4; ++m) { const int row = row0 - MP + ai * 128 + m * 16;
#pragma unroll
                    for (int bj = 0; bj < 2; ++bj) { float* o = pb + (size_t)row * DM + col0 + bj * 128; *(f32x4*)o = acc[ai][bj][m][0]; *(f32x4*)(o + 4) = acc[ai][bj][m][1]; } }
        }
        return true;
    }
};

struct EpiP6F {
    float* out; unsigned char* ws; const bf16_t* X1Blo; const bf16_t* X1Bhi; float* SSP4; unsigned* cnt; unsigned* bar; const float* gfin; LAS unsigned char* lds;
    __device__ __forceinline__ bool operator()(f32x4 (&acc)[2][2][4][2], const Unit& u, int wr, int wc, int fr, int fq) const {
        EPI_ROWS(u)
        if (u.tag != 0) {
            float* pb = part_base(ws, u.tag - 1);
#pragma unroll
            for (int ai = 0; ai < 2; ++ai)
#pragma unroll
                for (int m = 0; m < 4; ++m) { const int row = row0 - MP + ai * 128 + m * 16;
#pragma unroll
                    for (int bj = 0; bj < 2; ++bj) { float* o = pb + (size_t)row * DM + col0 + bj * 128; *(f32x4*)o = acc[ai][bj][m][0]; *(f32x4*)(o + 4) = acc[ai][bj][m][1]; } }
            return true;
        }
        const bf16_t* X1B = u.pm < X1B_SPLIT ? X1Blo : X1Bhi - (size_t)X1B_SPLIT * 256 * DM;
#pragma unroll
        for (int ai = 0; ai < 2; ++ai) {
            u32x4 xv[4][2];
#pragma unroll
            for (int m = 0; m < 4; ++m)
#pragma unroll
                for (int bj = 0; bj < 2; ++bj) xv[m][bj] = *(const u32x4*)(X1B + (size_t)(row0 + ai * 128 + m * 16) * DM + col0 + bj * 128);
            asm volatile("" ::: "memory");
#pragma unroll
            for (int m = 0; m < 4; ++m) { const int row = row0 + ai * 128 + m * 16; float ss = 0.f;
#pragma unroll
                for (int bj = 0; bj < 2; ++bj) { const u32x4 xw = xv[m][bj];
                    const f32x4 v0 = acc[ai][bj][m][0] + (f32x4){bf_lo(xw.x), bf_hi(xw.x), bf_lo(xw.y), bf_hi(xw.y)}, v1 = acc[ai][bj][m][1] + (f32x4){bf_lo(xw.z), bf_hi(xw.z), bf_lo(xw.w), bf_hi(xw.w)};
                    acc[ai][bj][m][0] = v0; acc[ai][bj][m][1] = v1;
                    ss += (v0[0] * v0[0] + v0[1] * v0[1]) + (v0[2] * v0[2] + v0[3] * v0[3]) + (v1[0] * v1[0] + v1[1] * v1[1]) + (v1[2] * v1[2] + v1[3] * v1[3]); }
                ss += __shfl_xor(ss, 16); ss += __shfl_xor(ss, 32);
                if (fq == 0) ((LAS float*)(lds + 131072))[(ai * 128 + wr * 64 + m * 16 + fr) * 4 + wc] = ss; (void)row; }
            asm volatile("" ::: "memory");
        }
        __syncthreads();
        { const int t = (wr * 4 + wc) * 64 + fq * 16 + fr;
          if (t < 256) { const f32x4 q = *(const LAS f32x4*)(lds + 131072 + t * 16); __hip_atomic_store(SSP4 + (size_t)(u.pm * 256 + t) * 4 + u.pn, (q[0] + q[1]) + (q[2] + q[3]), __ATOMIC_RELAXED, __HIP_MEMORY_SCOPE_AGENT); } }
        panel_signal(cnt + 64 * u.pm, wr * 4 + wc);
        panel_wait(cnt + 64 * u.pm, 4u, bar, wr * 4 + wc);
        f32x4 sq[2][4];
#pragma unroll
        for (int ai = 0; ai < 2; ++ai)
#pragma unroll
            for (int m = 0; m < 4; ++m) sq[ai][m] = *(const f32x4*)(SSP4 + (size_t)(row0 + ai * 128 + m * 16) * 4);
        asm volatile("" ::: "memory");
#pragma unroll
        for (int ai = 0; ai < 2; ++ai)
#pragma unroll
            for (int m = 0; m < 4; ++m) { const int row = row0 + ai * 128 + m * 16; const f32x4 q = sq[ai][m];
                const float rstd = 1.0f / sqrtf(((q[0] + q[1]) + (q[2] + q[3])) * (1.0f / DM) + EPS);
#pragma unroll
                for (int bj = 0; bj < 2; ++bj) { const size_t off = (size_t)row * DM + col0 + bj * 128;
                    const f32x4 g0 = *(const f32x4*)(gfin + col0 + bj * 128), g1 = *(const f32x4*)(gfin + col0 + bj * 128 + 4);
                    *(f32x4*)(out + off) = acc[ai][bj][m][0] * rstd * g0; *(f32x4*)(out + off + 4) = acc[ai][bj][m][1] * rstd * g1; } }
        return true;
    }
};

__device__ __forceinline__ float wave_sum(float v) {
#pragma unroll
    for (int o = 1; o < 64; o <<= 1) v += __shfl_xor(v, o);
    return v;
}
__device__ __forceinline__ void tr_item(const float* W, int N, bf16_t* WT, int ldt, int col_off, const float* kscale, LAS float* scr, int item, int lane) {
    const int nblk = N / 32, kb = item / nblk, nb = item % nblk, k0 = 64 * kb, n0 = 32 * nb;
    f32x4 t[8];
#pragma unroll
    for (int i = 0; i < 8; ++i) { const int kk = 8 * i + (lane >> 3); t[i] = *(const f32x4*)(W + (size_t)(k0 + kk) * N + n0 + 4 * (lane & 7)); }
    if (kscale) {
#pragma unroll
        for (int i = 0; i < 8; ++i) t[i] = t[i] * kscale[k0 + 8 * i + (lane >> 3)];
    }
#pragma unroll
    for (int i = 0; i < 8; ++i) { LAS float* d = scr + (8 * i + (lane >> 3)) * 33 + 4 * (lane & 7); d[0] = t[i][0]; d[1] = t[i][1]; d[2] = t[i][2]; d[3] = t[i][3]; }
    asm volatile("s_waitcnt lgkmcnt(0)" ::: "memory");
    const int c = lane & 7;
#pragma unroll
    for (int j = 0; j < 4; ++j) { const int n = (lane >> 3) + 8 * j; const LAS float* s = scr + (8 * c) * 33 + n;
        u32x4 o; o.x = pk2(s[0 * 33], s[1 * 33]); o.y = pk2(s[2 * 33], s[3 * 33]); o.z = pk2(s[4 * 33], s[5 * 33]); o.w = pk2(s[6 * 33], s[7 * 33]);
        *(u32x4*)(WT + (size_t)(n0 + n) * ldt + col_off + k0 + 8 * c) = o; }
    asm volatile("s_waitcnt lgkmcnt(0)" ::: "memory");
}
__device__ __forceinline__ const float* p0_src_row(const Args& a, int row) { return row < MP ? a.x_prompt + (size_t)row * DM : (row < MT ? a.x_sample + (size_t)(row - MP) * DM : a.mem + (size_t)(row - MT) * DM); }
__device__ __forceinline__ void rms_rows2_to_bf16(const float* x0, const float* x1, const float* g0, const float* g1, bf16_t* o0, bf16_t* o1, int lane) {
    const f32x4* xr0 = (const f32x4*)x0 + lane; const f32x4* xr1 = (const f32x4*)x1 + lane;
    f32x4 v[2][4]; float s0 = 0.f, s1 = 0.f;
#pragma unroll
    for (int j = 0; j < 4; ++j) { v[0][j] = xr0[64 * j]; v[1][j] = xr1[64 * j]; }
#pragma unroll
    for (int j = 0; j < 4; ++j) { s0 += (v[0][j][0] * v[0][j][0] + v[0][j][1] * v[0][j][1]) + (v[0][j][2] * v[0][j][2] + v[0][j][3] * v[0][j][3]);
                                  s1 += (v[1][j][0] * v[1][j][0] + v[1][j][1] * v[1][j][1]) + (v[1][j][2] * v[1][j][2] + v[1][j][3] * v[1][j][3]); }
    const float r0 = 1.0f / sqrtf(wave_sum(s0) * (1.0f / DM) + EPS), r1 = 1.0f / sqrtf(wave_sum(s1) * (1.0f / DM) + EPS);
    u32x2* p0 = (u32x2*)o0 + lane; u32x2* p1 = (u32x2*)o1 + lane;
#pragma unroll
    for (int j = 0; j < 4; ++j) { const f32x4 ga = ((const f32x4*)g0 + lane)[64 * j], gb = ((const f32x4*)g1 + lane)[64 * j]; u32x2 w;
        w.x = pk2(v[0][j][0] * r0 * ga[0], v[0][j][1] * r0 * ga[1]); w.y = pk2(v[0][j][2] * r0 * ga[2], v[0][j][3] * r0 * ga[3]); p0[64 * j] = w;
        w.x = pk2(v[1][j][0] * r1 * gb[0], v[1][j][1] * r1 * gb[1]); w.y = pk2(v[1][j][2] * r1 * gb[2], v[1][j][3] * r1 * gb[3]); p1[64 * j] = w; }
}
__device__ __forceinline__ void p0_prologue(const Args& a, LAS unsigned char* lds, int tid, int G) {
    const int wave = tid >> 6, lane = tid & 63;
    LAS float* scr = (LAS float*)(lds + wave * 16384);
    const int gw = blockIdx.x * 8 + wave, NGW = G * 8;
    const int gt = blockIdx.x * 512 + tid, NGT = G * 512;
    bf16_t* WinT = (bf16_t*)(a.ws + WS_WIN); bf16_t* WoT = (bf16_t*)(a.ws + WS_WO); bf16_t* WupT = (bf16_t*)(a.ws + WS_WUP); bf16_t* WdnT = (bf16_t*)(a.ws + WS_WDN); bf16_t* WbrT = (bf16_t*)(a.ws + WS_WBR);
    bf16_t* VTB = (bf16_t*)((unsigned char*)a.out + OS_VTB); bf16_t* KB = (bf16_t*)((unsigned char*)a.out + OS_KB);
    constexpr int I_IN = 16 * 144, I_KV = 16 * 16, I_O = 16 * 32, I_UP = 16 * 128, I_DN = 64 * 32, I_A = 8 * 32, I_C = 4 * 32, I_V = 128 * 32;
    constexpr int NITEMS = I_IN + I_KV + I_O + I_A + I_C + I_V;
    for (int it = gw; it < NITEMS; it += NGW) {
        int r = it;
        if (r < I_IN) { tr_item(a.w_in, DIN, WinT, 1024, 0, nullptr, scr, r, lane); continue; } r -= I_IN;
        if (r < I_KV) { tr_item(a.w_kv, 512, WinT + (size_t)4608 * 1024, 1024, 0, nullptr, scr, r, lane); continue; } r -= I_KV;
        if (r < I_O) { tr_item(a.w_o, 1024, WoT, 1024, 0, nullptr, scr, r, lane); continue; } r -= I_O;
        if (r < I_A) { tr_item(a.w_out_a, 1024, WbrT, 1024, 0, nullptr, scr, r, lane); continue; } r -= I_A;
        if (r < I_C) { tr_item(a.w_out_c, 1024, WbrT, 1024, 768, nullptr, scr, r, lane); continue; } r -= I_C;
        { const int b = r >> 5; tr_item(a.cache_v + (size_t)b * 65536, 256, VTB + (size_t)(8 + b) * 65536, 256, 0, nullptr, scr, r & 31, lane); }
    }
    for (int idx = gt; idx < 256 * 1024; idx += NGT) { const int n = idx & 1023, k = idx >> 10, g = k >> 6, kk = k & 63; float s = 0.f;
        const float* wp = a.w_pool + g * 4096 + kk * 64; const float* sc = a.pool_scale + g * 64; const float* wb = a.w_out_b + (size_t)(g * 64) * 1024 + n;
#pragma unroll 32
        for (int e = 0; e < 64; ++e) s += wp[e] * sc[e] * wb[(size_t)e * 1024];
        WbrT[(size_t)n * 1024 + 512 + k] = (bf16_t)f2bf(s); }
    bf16_t* XN = (bf16_t*)(a.ws + WS_XN);
    for (int r2 = gw; r2 < (MT + MKV) / 2; r2 += NGW) { const int row = 2 * r2;
        rms_rows2_to_bf16(p0_src_row(a, row), p0_src_row(a, row + 1), row < MT ? a.g_mix : a.g_mem, row < MT ? a.g_mix : a.g_mem, XN + (size_t)row * DM, XN + (size_t)(row + 1) * DM, lane); }
    bf16_t* WsB = (bf16_t*)(a.ws + WS_WSB);
    for (int idx = gt; idx < 131072; idx += NGT) { const int e = idx & 65535, g = e >> 14, r = (e >> 7) & 127, c = e & 127; float v;
        if (idx < 65536) v = c <= r ? a.w_s[e] : 0.f;
        else v = ((r >> 3) == (c >> 3) && (c & 7) <= (r & 7)) ? a.w_s[g * 16384 + (r & 7) * 128 + (c & 7)] : 0.f;
        WsB[idx] = (bf16_t)f2bf(v); }
}

__device__ __forceinline__ void p0_deferred(const Args& a, LAS unsigned char* lds, int tid, int G) {
    const int wave = tid >> 6, lane = tid & 63;
    LAS float* scr = (LAS float*)(lds + wave * 16384);
    const int nc = G, cc = (int)blockIdx.x;
    bf16_t* WupT = (bf16_t*)(a.ws + WS_WUP); bf16_t* WdnT = (bf16_t*)(a.ws + WS_WDN);
    for (int it = cc * 8 + wave; it < 4096; it += nc * 8) {
        if (it < 2048) tr_item(a.w_up, DFF, WupT, 1024, 0, a.g_ffn, scr, it, lane);
        else tr_item(a.w_down, 1024, WdnT, 4096, 0, nullptr, scr, it - 2048, lane);
    }
}

__device__ __forceinline__ void p2a_unit(const Args& a, LAS unsigned char* lds, int c, int tid) {
    const int w = __builtin_amdgcn_readfirstlane(tid >> 6), l = tid & 63;
    bf16_t* Z = (bf16_t*)(a.ws + WS_Z);
    const int row0 = c * 128;
    const int g = w >> 1, ih = w & 1, fr = l & 15, fq = l >> 4;
    const bf16_t* Wg = (const bf16_t*)(a.ws + WS_WSB) + (c >= 128 ? 65536 : 0) + g * 16384;
    __syncthreads();
    u32x4 v[2][8];
#pragma unroll
    for (int rr = 0; rr < 2; ++rr) { const u32x4* src = (const u32x4*)(Z + (size_t)(row0 + 2 * l + rr) * DIN + 512 + 64 * w);
#pragma unroll
        for (int e = 0; e < 8; ++e) v[rr][e] = src[e]; }
    LAS f32x2* ST = (LAS f32x2*)(lds + 139264);
#pragma unroll
    for (int rr = 0; rr < 2; ++rr) { float s = 0.f, q = 0.f;
#pragma unroll
        for (int e = 0; e < 8; ++e)
#pragma unroll
            for (int d = 0; d < 4; ++d) { const float x0 = bf_lo(v[rr][e][d]), x1 = bf_hi(v[rr][e][d]); s += x0 + x1; q += x0 * x0 + x1 * x1; }
        ST[(2 * l + rr) * 8 + w] = (f32x2){s, q}; }
    __syncthreads();
    float mean[2], rstd[2];
#pragma unroll
    for (int rr = 0; rr < 2; ++rr) { float s = 0.f, q = 0.f;
#pragma unroll
        for (int k = 0; k < 8; ++k) { const f32x2 t = ST[(2 * l + rr) * 8 + k]; s += t[0]; q += t[1]; }
        mean[rr] = s * (1.0f / 512.0f); const float var = fmaxf(q * (1.0f / 512.0f) - mean[rr] * mean[rr], 0.f); rstd[rr] = 1.0f / sqrtf(var + EPS); }
    const bool wout = (c >= 128) || ((c & 15) == 15);
    float* op = c >= 128 ? a.out + O_CVS + (size_t)((c - 128) * 128 + 2 * l) * 512 : a.out + O_CVP + (size_t)((c >> 4) * 128 + 2 * l) * 512;
#pragma unroll
    for (int e = 0; e < 8; ++e) { float y[2][8];
#pragma unroll
        for (int d = 0; d < 4; ++d) { const int ch = 64 * w + 8 * e + 2 * d; const float g0 = a.g_v[ch], g1 = a.g_v[ch + 1], b0 = a.b_v[ch], b1 = a.b_v[ch + 1];
            y[0][2 * d] = (bf_lo(v[0][e][d]) - mean[0]) * rstd[0] * g0 + b0; y[0][2 * d + 1] = (bf_hi(v[0][e][d]) - mean[0]) * rstd[0] * g1 + b1;
            y[1][2 * d] = (bf_lo(v[1][e][d]) - mean[1]) * rstd[1] * g0 + b0; y[1][2 * d + 1] = (bf_hi(v[1][e][d]) - mean[1]) * rstd[1] * g1 + b1;
            *(LAS unsigned*)(lds + ch * 272 + 4 * l) = pk2(y[0][2 * d], y[1][2 * d]);
            *(LAS unsigned*)(lds + (ch + 1) * 272 + 4 * l) = pk2(y[0][2 * d + 1], y[1][2 * d + 1]); }
        if (wout) {
#pragma unroll
            for (int rr = 0; rr < 2; ++rr) { float* o = op + rr * 512 + 64 * w + 8 * e; *(f32x4*)o = (f32x4){y[rr][0], y[rr][1], y[rr][2], y[rr][3]}; *(f32x4*)(o + 4) = (f32x4){y[rr][4], y[rr][5], y[rr][6], y[rr][7]}; } }
    }
    bf16x8 wf[4][4];
#pragma unroll
    for (int mt = 0; mt < 4; ++mt)
#pragma unroll
        for (int ks = 0; ks < 4; ++ks) wf[mt][ks] = *(const bf16x8*)(Wg + (64 * ih + 16 * mt + fr) * 128 + 32 * ks + 8 * fq);
    __syncthreads();
    const int nks = ih ? 4 : 2;
    for (int np = 0; np < 2; ++np) {
        u32x2 uu[4][4];
#pragma unroll
        for (int mt = 0; mt < 4; ++mt)
#pragma unroll
            for (int nt = 0; nt < 4; ++nt) uu[mt][nt] = *(const u32x2*)(Z + (size_t)(row0 + 64 * ih + 16 * mt + fr) * DIN + g * 128 + np * 64 + nt * 16 + 4 * fq);
        f32x4 acc[4][4];
#pragma unroll
        for (int i = 0; i < 4; ++i)
#pragma unroll
            for (int j = 0; j < 4; ++j) acc[i][j] = (f32x4){0.f, 0.f, 0.f, 0.f};
#pragma unroll
        for (int ks = 0; ks < 4; ++ks) if (ks < nks) {
            bf16x8 vf[4];
#pragma unroll
            for (int nt = 0; nt < 4; ++nt) vf[nt] = *(const LAS bf16x8*)(lds + (g * 128 + np * 64 + nt * 16 + fr) * 272 + (32 * ks + 8 * fq) * 2);
#pragma unroll
            for (int mt = 0; mt < 4; ++mt)
#pragma unroll
                for (int nt = 0; nt < 4; ++nt) acc[mt][nt] = __builtin_amdgcn_mfma_f32_16x16x32_bf16(vf[nt], wf[mt][ks], acc[mt][nt], 0, 0, 0);
        }
#pragma unroll
        for (int mt = 0; mt < 4; ++mt) { const int i = 64 * ih + 16 * mt + fr; const float bias = a.b_s[g * 128 + (c >= 128 ? (i & 7) : i)];
#pragma unroll
            for (int nt = 0; nt < 4; ++nt) { bf16_t* up = Z + (size_t)(row0 + i) * DIN + g * 128 + np * 64 + nt * 16 + 4 * fq;
                const u32x2 u2 = uu[mt][nt]; u32x2 o;
                o.x = pk2(bf_lo(u2.x) * (acc[mt][nt][0] + bias), bf_hi(u2.x) * (acc[mt][nt][1] + bias));
                o.y = pk2(bf_lo(u2.y) * (acc[mt][nt][2] + bias), bf_hi(u2.y) * (acc[mt][nt][3] + bias));
                *(u32x2*)up = o; } }
    }
}
template <int WIN, bool SAMPLE>
__device__ __forceinline__ void p2b_rows(const Args& a, const float* P, bf16_t* Z, int grow0, int ch) {
#pragma unroll 1
    for (int r4 = 0; r4 < 32; r4 += 4) {
        float v[4][WIN];
#pragma unroll
        for (int i = 0; i < 4; ++i) { const int grow = grow0 + r4 + i;
            if (!SAMPLE) { const int t = grow & 2047;
#pragma unroll
                for (int k = 0; k < WIN; ++k) v[i][k] = (t - k >= 0) ? P[(size_t)(grow - k) * 256 + ch] : 0.f;
            } else { const int sr = grow - MP, b = sr >> 3, t = sr & 7;
#pragma unroll
                for (int k = 0; k < WIN; ++k) v[i][k] = (t - k >= 0) ? P[(size_t)(grow - k) * 256 + ch] : a.state_pool[((size_t)b * 15 + 15 + t - k) * 256 + ch];
            } }
#pragma unroll
        for (int i = 0; i < 4; ++i) { const int grow = grow0 + r4 + i; float sum = 0.f;
#pragma unroll
            for (int k = 0; k < WIN; ++k) sum += v[i][k];
            float inv = 1.0f / (float)WIN;
            if (!SAMPLE) { const int t = grow & 2047; if (t + 1 < WIN) inv = 1.0f / (float)(t + 1); }
            Z[(size_t)grow * DIN + 1024 + ch] = (bf16_t)f2bf(sum * inv - v[i][0]); }
    }
}
template <int WIN>
__device__ __forceinline__ void p2b_rows_prompt(const float* P, bf16_t* Z, int grow0, int ch) {
    const int t0 = grow0 & 2047;
    float x[32 + WIN - 1];
#pragma unroll
    for (int j = 0; j < 32 + WIN - 1; ++j) { const int d = j - (WIN - 1); x[j] = (t0 + d >= 0) ? P[(size_t)(grow0 + d) * 256 + ch] : 0.f; }
    float sum = 0.f;
#pragma unroll
    for (int j = 0; j < WIN; ++j) sum += x[j];
#pragma unroll
    for (int i = 0; i < 32; ++i) {
        if (i > 0) sum += x[i + WIN - 1] - x[i - 1];
        const int t = t0 + i; const float inv = (t + 1 < WIN) ? 1.0f / (float)(t + 1) : 1.0f / (float)WIN;
        Z[(size_t)(grow0 + i) * DIN + 1024 + ch] = (bf16_t)f2bf(sum * inv - x[i + WIN - 1]);
    }
}
template <int WIN>
__device__ __forceinline__ void p2b_rows_sample(const Args& a, const float* P, bf16_t* Z, int grow0, int ch) {
    float x[4][8 + WIN - 1];
#pragma unroll
    for (int q = 0; q < 4; ++q) { const int b = (grow0 - MP) / 8 + q;
#pragma unroll
        for (int j = 0; j < 8 + WIN - 1; ++j) { const int d = j - (WIN - 1);
            x[q][j] = d >= 0 ? P[(size_t)(grow0 + 8 * q + d) * 256 + ch] : a.state_pool[((size_t)b * 15 + 15 + d) * 256 + ch]; } }
#pragma unroll
    for (int q = 0; q < 4; ++q) { float sum = 0.f;
#pragma unroll
        for (int j = 0; j < WIN; ++j) sum += x[q][j];
#pragma unroll
        for (int i = 0; i < 8; ++i) { if (i > 0) sum += x[q][i + WIN - 1] - x[q][i - 1];
            Z[(size_t)(grow0 + 8 * q + i) * DIN + 1024 + ch] = (bf16_t)f2bf(sum * (1.0f / (float)WIN) - x[q][i + WIN - 1]); } }
}
__device__ __forceinline__ void p2b_unit(const Args& a, int u, int tid) {
    bf16_t* Z = (bf16_t*)(a.ws + WS_Z);
    const float* P = (const float*)((const unsigned char*)a.out + OS_P);
    const int ch = tid & 255, grow0 = u * 64 + (tid >> 8) * 32, gi = __builtin_amdgcn_readfirstlane(ch >> 6);
    if (grow0 < MP) { if (gi == 0) p2b_rows_prompt<2>(P, Z, grow0, ch); else if (gi == 1) p2b_rows_prompt<4>(P, Z, grow0, ch); else if (gi == 2) p2b_rows_prompt<8>(P, Z, grow0, ch); else p2b_rows_prompt<16>(P, Z, grow0, ch); }
    else { if (gi == 0) p2b_rows_sample<2>(a, P, Z, grow0, ch); else if (gi == 1) p2b_rows_sample<4>(a, P, Z, grow0, ch); else if (gi == 2) p2b_rows_sample<8>(a, P, Z, grow0, ch); else p2b_rows_sample<16>(a, P, Z, grow0, ch); }
}
__device__ __forceinline__ void attn_wave(const Args& a, int qrow0, int valid, int kvb, int h, int lane) {
    bf16_t* Z = (bf16_t*)(a.ws + WS_Z);
    const bf16_t* KB = (const bf16_t*)((const unsigned char*)a.out + OS_KB) + (size_t)kvb * 65536 + h * 64;
    const bf16_t* VT = (const bf16_t*)((const unsigned char*)a.out + OS_VTB) + (size_t)kvb * 65536 + (size_t)(h * 64) * 256;
    const int fr = lane & 15, fq = lane >> 4;
    const int qr = qrow0 + (fr < valid ? fr : valid - 1);
    bf16x8 qf[2];
#pragma unroll
    for (int ks = 0; ks < 2; ++ks) qf[ks] = *(const bf16x8*)(Z + (size_t)qr * DIN + 1280 + h * 64 + 32 * ks + 8 * fq);
    f32x4 s[16];
#pragma unroll
    for (int t = 0; t < 16; ++t) { s[t] = (f32x4){0.f, 0.f, 0.f, 0.f};
        const int key = 32 * (t >> 1) + 8 * (fr >> 2) + 4 * (t & 1) + (fr & 3);
#pragma unroll
        for (int ks = 0; ks < 2; ++ks) { bf16x8 kf;
            if (kvb < 8) kf = *(const bf16x8*)(KB + (size_t)key * 256 + 32 * ks + 8 * fq);
            else { const f32x4* kp = (const f32x4*)(a.cache_k + (size_t)(kvb - 8) * 65536 + (size_t)key * 256 + h * 64 + 32 * ks + 8 * fq); const f32x4 k0 = kp[0], k1 = kp[1];
                u32x4 kw; kw.x = pk2(k0[0], k0[1]); kw.y = pk2(k0[2], k0[3]); kw.z = pk2(k1[0], k1[1]); kw.w = pk2(k1[2], k1[3]); kf = __builtin_bit_cast(bf16x8, kw); }
            s[t] = __builtin_amdgcn_mfma_f32_16x16x32_bf16(kf, qf[ks], s[t], 0, 0, 0); } }
    float mx = -3.0e38f;
#pragma unroll
    for (int t = 0; t < 16; ++t) mx = fmaxf(mx, fmaxf(fmaxf(s[t][0], s[t][1]), fmaxf(s[t][2], s[t][3])));
    mx = fmaxf(mx, __shfl_xor(mx, 16)); mx = fmaxf(mx, __shfl_xor(mx, 32));
    const float sc = 0.125f * 1.4426950409f; float sum = 0.f;
#pragma unroll
    for (int t = 0; t < 16; ++t)
#pragma unroll
        for (int e = 0; e < 4; ++e) { const float p = __builtin_amdgcn_exp2f((s[t][e] - mx) * sc); s[t][e] = p; sum += p; }
    sum += __shfl_xor(sum, 16); sum += __shfl_xor(sum, 32);
    const float rs = 1.0f / sum;
    f32x4 o[4];
#pragma unroll
    for (int dt = 0; dt < 4; ++dt) o[dt] = (f32x4){0.f, 0.f, 0.f, 0.f};
#pragma unroll
    for (int sk = 0; sk < 8; ++sk) { u32x4 pw; pw.x = pk2(s[2 * sk][0], s[2 * sk][1]); pw.y = pk2(s[2 * sk][2], s[2 * sk][3]); pw.z = pk2(s[2 * sk + 1][0], s[2 * sk + 1][1]); pw.w = pk2(s[2 * sk + 1][2], s[2 * sk + 1][3]);
        const bf16x8 pf = __builtin_bit_cast(bf16x8, pw);
#pragma unroll
        for (int dt = 0; dt < 4; ++dt) { const bf16x8 vf = *(const bf16x8*)(VT + (size_t)(16 * dt + fr) * 256 + 32 * sk + 8 * fq);
            o[dt] = __builtin_amdgcn_mfma_f32_16x16x32_bf16(vf, pf, o[dt], 0, 0, 0); } }
    if (fr < valid) {
#pragma unroll
        for (int dt = 0; dt < 4; ++dt) { u32x2 w; w.x = pk2(o[dt][0] * rs, o[dt][1] * rs); w.y = pk2(o[dt][2] * rs, o[dt][3] * rs);
            *(u32x2*)(Z + (size_t)(qrow0 + fr) * DIN + 1280 + h * 64 + 16 * dt + 4 * fq) = w; } }
}
__device__ __forceinline__ void attn_block_prompt(const Args& a, LAS unsigned char* lds, int c, int h, int tid) {
    const int w = tid >> 6, lane = tid & 63, fr = lane & 15, fq = lane >> 4, kvb = c >> 4, qrow0 = c * 128 + 16 * w;
    bf16_t* Z = (bf16_t*)(a.ws + WS_Z);
    const bf16_t* KB = (const bf16_t*)((const unsigned char*)a.out + OS_KB) + (size_t)kvb * 65536 + h * 64;
    const bf16_t* VT = (const bf16_t*)((const unsigned char*)a.out + OS_VTB) + (size_t)kvb * 65536 + (size_t)(h * 64) * 256;
    u32x4 kst[4], vst[4];
#pragma unroll
    for (int i = 0; i < 4; ++i) { const int ck = tid + 512 * i;
        kst[i] = *(const u32x4*)(KB + (size_t)(ck >> 3) * 256 + (ck & 7) * 8);
        vst[i] = *(const u32x4*)(VT + (size_t)(ck >> 5) * 256 + (ck & 31) * 8); }
    bf16x8 qf[2];
#pragma unroll
    for (int ks = 0; ks < 2; ++ks) qf[ks] = *(const bf16x8*)(Z + (size_t)(qrow0 + fr) * DIN + 1280 + h * 64 + 32 * ks + 8 * fq);
    __syncthreads();
#pragma unroll
    for (int i = 0; i < 4; ++i) { const int ck = tid + 512 * i;
        *(LAS u32x4*)(lds + (ck >> 3) * 144 + (ck & 7) * 16) = kst[i];
        *(LAS u32x4*)(lds + 36864 + (ck >> 5) * 528 + (ck & 31) * 16) = vst[i]; }
    __syncthreads();
    f32x4 s[16];
#pragma unroll
    for (int t = 0; t < 16; ++t) { s[t] = (f32x4){0.f, 0.f, 0.f, 0.f};
        const int key = 32 * (t >> 1) + 8 * (fr >> 2) + 4 * (t & 1) + (fr & 3);
#pragma unroll
        for (int ks = 0; ks < 2; ++ks) { const bf16x8 kf = *(const LAS bf16x8*)(lds + key * 144 + (32 * ks + 8 * fq) * 2);
            s[t] = __builtin_amdgcn_mfma_f32_16x16x32_bf16(kf, qf[ks], s[t], 0, 0, 0); } }
    float mx = -3.0e38f;
#pragma unroll
    for (int t = 0; t < 16; ++t) mx = fmaxf(mx, fmaxf(fmaxf(s[t][0], s[t][1]), fmaxf(s[t][2], s[t][3])));
    mx = fmaxf(mx, __shfl_xor(mx, 16)); mx = fmaxf(mx, __shfl_xor(mx, 32));
    const float sc = 0.125f * 1.4426950409f; float sum = 0.f;
#pragma unroll
    for (int t = 0; t < 16; ++t)
#pragma unroll
        for (int e = 0; e < 4; ++e) { const float pe = __builtin_amdgcn_exp2f((s[t][e] - mx) * sc); s[t][e] = pe; sum += pe; }
    sum += __shfl_xor(sum, 16); sum += __shfl_xor(sum, 32);
    const float rs = 1.0f / sum;
    f32x4 o[4];
#pragma unroll
    for (int dt = 0; dt < 4; ++dt) o[dt] = (f32x4){0.f, 0.f, 0.f, 0.f};
#pragma unroll
    for (int sk = 0; sk < 8; ++sk) { u32x4 pw; pw.x = pk2(s[2 * sk][0], s[2 * sk][1]); pw.y = pk2(s[2 * sk][2], s[2 * sk][3]); pw.z = pk2(s[2 * sk + 1][0], s[2 * sk + 1][1]); pw.w = pk2(s[2 * sk + 1][2], s[2 * sk + 1][3]);
        const bf16x8 pf = __builtin_bit_cast(bf16x8, pw);
#pragma unroll
        for (int dt = 0; dt < 4; ++dt) { const bf16x8 vf = *(const LAS bf16x8*)(lds + 36864 + (16 * dt + fr) * 528 + (32 * sk + 8 * fq) * 2);
            o[dt] = __builtin_amdgcn_mfma_f32_16x16x32_bf16(vf, pf, o[dt], 0, 0, 0); } }
#pragma unroll
    for (int dt = 0; dt < 4; ++dt) { u32x2 wv; wv.x = pk2(o[dt][0] * rs, o[dt][1] * rs); wv.y = pk2(o[dt][2] * rs, o[dt][3] * rs);
        *(u32x2*)(Z + (size_t)(qrow0 + fr) * DIN + 1280 + h * 64 + 16 * dt + 4 * fq) = wv; }
}
__device__ __forceinline__ void p2_mixers(const Args& a, LAS unsigned char* lds, int tid, int G) {
    const int w = tid >> 6, lane = tid & 63;
    {
        const float* P = (const float*)((const unsigned char*)a.out + OS_P);
        for (int idx = blockIdx.x * 512 + tid; idx < 30720 + 491520; idx += G * 512) {
            if (idx < 30720) { const int b = idx / 3840, rem = idx % 3840; a.out[O_PP + idx] = P[(size_t)(b * 2048 + 2033) * 256 + rem]; }
            else { const int j = idx - 30720, b = j / 3840, rem = j % 3840, s = rem >> 8, cc = rem & 255;
                a.out[O_PS + j] = s < 7 ? a.state_pool[((size_t)b * 15 + 8 + s) * 256 + cc] : P[(size_t)(MP + b * 8 + (s - 7)) * 256 + cc]; } }
    }
    for (int it = blockIdx.x; it < 136; it += G) p2a_unit(a, lds, it, tid);
    { int u0 = ((int)blockIdx.x - 136) % G; if (u0 < 0) u0 += G;
      for (int u = u0; u < 272; u += G) p2b_unit(a, u, tid); }
    { int u0 = ((int)blockIdx.x - 408) % G; if (u0 < 0) u0 += G;
      for (int idx = u0; idx < 576; idx += G) {
        if (idx < 512) { attn_block_prompt(a, lds, idx >> 2, idx & 3, tid); }
        else { const int batch = 2 * (idx - 512) + (w >> 2); attn_wave(a, MP + 8 * batch, 8, 8 + batch, w & 3, lane); } } }
}
__device__ __forceinline__ void p7_final(const Args& a, LAS unsigned char* lds, int tid, int G) {
    const int wave = tid >> 6, lane = tid & 63;
    const f32x4* gr = (const f32x4*)a.g_final + lane;
    const bool split = (G == 256);
    for (int r2 = blockIdx.x * 8 + wave; r2 < (split ? 0 : MT) / 2; r2 += G * 8) {
        f32x4* xa = (f32x4*)(a.out + (size_t)(2 * r2) * DM) + lane; f32x4* xb = xa + DM / 4; f32x4 v[2][4]; float s0 = 0.f, s1 = 0.f;
#pragma unroll
        for (int j = 0; j < 4; ++j) { v[0][j] = xa[64 * j]; v[1][j] = xb[64 * j]; }
#pragma unroll
        for (int j = 0; j < 4; ++j) { s0 += (v[0][j][0] * v[0][j][0] + v[0][j][1] * v[0][j][1]) + (v[0][j][2] * v[0][j][2] + v[0][j][3] * v[0][j][3]);
                                      s1 += (v[1][j][0] * v[1][j][0] + v[1][j][1] * v[1][j][1]) + (v[1][j][2] * v[1][j][2] + v[1][j][3] * v[1][j][3]); }
        const float r0 = 1.0f / sqrtf(wave_sum(s0) * (1.0f / DM) + EPS), r1 = 1.0f / sqrtf(wave_sum(s1) * (1.0f / DM) + EPS);
#pragma unroll
        for (int j = 0; j < 4; ++j) { const f32x4 gg = gr[64 * j]; xa[64 * j] = v[0][j] * r0 * gg; xb[64 * j] = v[1][j] * r1 * gg; }
    }
    if (split) {
        LAS float* red = (LAS float*)lds;
        const int rr = tid >> 7, t7 = tid & 127, c8 = t7 * 8;
        const f32x4 g0 = *(const f32x4*)(a.g_final + c8), g1 = *(const f32x4*)(a.g_final + c8 + 4);
        for (int sr0 = blockIdx.x * 4; sr0 < MS; sr0 += G * 4) { const int sr = sr0 + rr;
            const u32x4 xw = *(const u32x4*)((const bf16_t*)(a.ws + WS_X1B_HI) + (size_t)(MP + sr - X1B_SPLIT * 256) * DM + c8);
            f32x4 pv[16][2];
#pragma unroll
            for (int k = 0; k < 16; ++k) { const f32x4* pp = (const f32x4*)(part_base(a.ws, k) + (size_t)sr * DM + c8); pv[k][0] = pp[0]; pv[k][1] = pp[1]; }
            f32x4 v0 = (f32x4){bf_lo(xw.x), bf_hi(xw.x), bf_lo(xw.y), bf_hi(xw.y)}, v1 = (f32x4){bf_lo(xw.z), bf_hi(xw.z), bf_lo(xw.w), bf_hi(xw.w)};
#pragma unroll
            for (int k = 0; k < 16; ++k) { v0 += pv[k][0]; v1 += pv[k][1]; }
            const float ws_ = wave_sum((v0[0] * v0[0] + v0[1] * v0[1]) + (v0[2] * v0[2] + v0[3] * v0[3]) + (v1[0] * v1[0] + v1[1] * v1[1]) + (v1[2] * v1[2] + v1[3] * v1[3]));
            __syncthreads();
            if (lane == 0) red[wave] = ws_;
            __syncthreads();
            const float rstd = 1.0f / sqrtf((red[2 * rr] + red[2 * rr + 1]) * (1.0f / DM) + EPS);
            float* xo = a.out + (size_t)(MP + sr) * DM + c8;
            *(f32x4*)xo = v0 * rstd * g0; *(f32x4*)(xo + 4) = v1 * rstd * g1;
        }
    }
}

#define XB_TMO      128
#define XB_XCNT(j)  (256  + 64 * (j))
#define XB_XSUB(j)  (1280 + 64 * (j))
#define XB_XGEN(j)  (2304 + 64 * (j))
#define XB_TOP      3328
#define XB_TOPGEN   3392
#define XCD_BAR_WORDS 3456
#define XB_SPIN_CAP (1u << 18)
__device__ __forceinline__ unsigned xb_ld(unsigned* p)              { return __hip_atomic_load(p, __ATOMIC_RELAXED, __HIP_MEMORY_SCOPE_AGENT); }
__device__ __forceinline__ unsigned xb_add(unsigned* p, unsigned v) { return __hip_atomic_fetch_add(p, v, __ATOMIC_RELAXED, __HIP_MEMORY_SCOPE_AGENT); }
__device__ __forceinline__ unsigned xb_xcc_id() { return (unsigned)__builtin_amdgcn_s_getreg((3 << 11) | 20) & 0xFu; }
#define XB_SPIN(cond, bar) do { unsigned _sp = 0; while (cond) { __builtin_amdgcn_s_sleep(1); \
    if ((++_sp & 255u) == 0u) { if (xb_ld(&(bar)[XB_TMO])) break; if (_sp > XB_SPIN_CAP) { atomicAdd(&(bar)[XB_TMO], 1u); break; } } } } while (0)
struct XcdBarrier { unsigned* bar; unsigned x; volatile LAS unsigned* st; };
__device__ __forceinline__ XcdBarrier xcd_barrier_post(unsigned* bar, volatile LAS unsigned* st, int wave_s) {
    XcdBarrier b; b.bar = bar; b.x = xb_xcc_id(); b.st = st;
    if (wave_s == 0 && lane_id() == 0) (void)xb_add(&bar[XB_XCNT(b.x)], 1u);
    return b;
}
__device__ __forceinline__ void xcd_barrier_complete(unsigned* bar, unsigned x, unsigned& nloc, unsigned& nx) {
    const unsigned G = gridDim.x * gridDim.y * gridDim.z;
    unsigned sum, cnt, mine, sp = 0u;
    for (;;) {
        sum = 0u; cnt = 0u; mine = 0u;
#pragma unroll
        for (unsigned j = 0; j < 16; ++j) { const unsigned c = xb_ld(&bar[XB_XCNT(j)]); sum += c; cnt += (c > 0u) ? 1u : 0u; mine = (j == x) ? c : mine; }
        if (sum == G) break;
        __builtin_amdgcn_s_sleep(1);
        if ((++sp & 255u) == 0u) { if (xb_ld(&bar[XB_TMO])) break; if (sp > XB_SPIN_CAP) { atomicAdd(&bar[XB_TMO], 1u); break; } }
    }
    nloc = mine > 0u ? mine : 1u; nx = cnt > 0u ? cnt : 1u;
}
__device__ __forceinline__ void xcd_barrier(const XcdBarrier& b, int wave_s) {
    asm volatile("s_waitcnt vmcnt(0)" ::: "memory");
    __syncthreads();
    if (wave_s == 0 && lane_id() == 0) {
        unsigned* bar = b.bar;
        __builtin_amdgcn_s_waitcnt(0);
        unsigned nloc = b.st[0], nx = b.st[1];
        if (nloc == 0u) { xcd_barrier_complete(bar, b.x, nloc, nx); b.st[0] = nloc; b.st[1] = nx; }
        const unsigned old = xb_add(&bar[XB_XSUB(b.x)], 1u);
        const unsigned gen = old / nloc;
        if (old + 1u == (gen + 1u) * nloc) {
            __builtin_amdgcn_fence(__ATOMIC_RELEASE, "agent");
            asm volatile("s_waitcnt vmcnt(0)" ::: "memory");
            const unsigned og = xb_add(&bar[XB_TOP], 1u);
            const unsigned tg = og / nx;
            if (og + 1u == (tg + 1u) * nx) xb_add(&bar[XB_TOPGEN], 1u);
            else XB_SPIN(xb_ld(&bar[XB_TOPGEN]) == tg, bar);
            __builtin_amdgcn_fence(__ATOMIC_ACQUIRE, "agent");
            xb_add(&bar[XB_XGEN(b.x)], 1u);
            asm volatile("s_waitcnt vmcnt(0)" ::: "memory");
        } else {
            XB_SPIN(xb_ld(&bar[XB_XGEN(b.x)]) == gen, bar);
            __builtin_amdgcn_fence(__ATOMIC_ACQUIRE, "agent");
            asm volatile("s_waitcnt vmcnt(0)" ::: "memory");
        }
    }
    __syncthreads();
}

__device__ __forceinline__ void panel_signal(unsigned* cnt, int wave_s) {
    asm volatile("s_waitcnt vmcnt(0)" ::: "memory");
    __syncthreads();
    if (wave_s == 0 && lane_id() == 0) (void)xb_add(cnt, 1u);
}
__device__ __forceinline__ void panel_wait(unsigned* cnt, unsigned want, unsigned* bar, int wave_s) {
    if (wave_s == 0 && lane_id() == 0) { XB_SPIN(xb_ld(cnt) < want, bar); __builtin_amdgcn_fence(__ATOMIC_ACQUIRE, "agent"); asm volatile("s_waitcnt vmcnt(0)" ::: "memory"); }
    __syncthreads();
}

template <bool P3S>
__device__ __forceinline__ void mini_block(const Args& a, LAS unsigned char* lds, int blk, int tid) {
    const int w = tid >> 6, lane = tid & 63, fr = lane & 15, fq = lane >> 4, rb = blk >> 4, cb = blk & 15;
    const int k0 = 128 * w;
    const bf16_t* Ab; int lda, acol;
    if (P3S) { Ab = (const bf16_t*)(a.ws + WS_Z); lda = DIN; acol = k0 + (k0 >= 512 ? 512 : 0); }
    else { Ab = (const bf16_t*)(a.ws + WS_XN); lda = DM; acol = k0; }
    const bf16_t* Bb = (const bf16_t*)(a.ws + (P3S ? WS_WBR : WS_WO));
    bf16x8 af[4][4], bf[4][4];
#pragma unroll
    for (int t = 0; t < 4; ++t)
#pragma unroll
        for (int ks = 0; ks < 4; ++ks) { af[t][ks] = *(const bf16x8*)(Ab + (size_t)(MP + 64 * rb + 16 * t + fr) * lda + acol + 32 * ks + 8 * fq);
                                         bf[t][ks] = *(const bf16x8*)(Bb + (size_t)(64 * cb + 16 * t + fr) * 1024 + k0 + 32 * ks + 8 * fq); }
    f32x4 acc[4][4];
#pragma unroll
    for (int mt = 0; mt < 4; ++mt)
#pragma unroll
        for (int nt = 0; nt < 4; ++nt) acc[mt][nt] = (f32x4){0.f, 0.f, 0.f, 0.f};
#pragma unroll
    for (int ks = 0; ks < 4; ++ks)
#pragma unroll
        for (int mt = 0; mt < 4; ++mt)
#pragma unroll
            for (int nt = 0; nt < 4; ++nt) acc[mt][nt] = __builtin_amdgcn_mfma_f32_16x16x32_bf16(bf[nt][ks], af[mt][ks], acc[mt][nt], 0, 0, 0);
    LAS float* red = (LAS float*)lds;
    __syncthreads();
#pragma unroll
    for (int mt = 0; mt < 4; ++mt)
#pragma unroll
        for (int nt = 0; nt < 4; ++nt) *(LAS f32x4*)(red + (size_t)((w * 64 + 16 * mt + fr) * 68 + 16 * nt + 4 * fq)) = acc[mt][nt];
    __syncthreads();
    const int r = tid >> 3, c8 = (tid & 7) * 8, row = MP + 64 * rb + r, col = 64 * cb + c8;
    f32x4 s0[3], s1[3];
#pragma unroll
    for (int g = 0; g < 3; ++g) { s0[g] = (f32x4){0.f, 0.f, 0.f, 0.f}; s1[g] = s0[g]; }
#pragma unroll
    for (int ww = 0; ww < 8; ++ww) { const int g = P3S ? (ww < 4 ? 0 : (ww < 6 ? 1 : 2)) : 0; const LAS f32x4* pp = (const LAS f32x4*)(red + (size_t)((ww * 64 + r) * 68 + c8)); s0[g] += pp[0]; s1[g] += pp[1]; }
    if (P3S) {
        bf16_t* MG = (bf16_t*)(a.ws + WS_XN);
        const unsigned char* gp = (const unsigned char*)(a.ws + WS_Z) + (size_t)row * (DIN * 2) + 3072 + col;
        const u32x2 qa = *(const u32x2*)gp, qb = *(const u32x2*)(gp + 1024), qc = *(const u32x2*)(gp + 2048); const float k = 1.0f / 255.0f;
        float m[8];
        m[0] = (s0[0][0] * ub0(qa.x) + s0[1][0] * ub0(qb.x) + s0[2][0] * ub0(qc.x)) * k; m[1] = (s0[0][1] * ub1(qa.x) + s0[1][1] * ub1(qb.x) + s0[2][1] * ub1(qc.x)) * k;
        m[2] = (s0[0][2] * ub2(qa.x) + s0[1][2] * ub2(qb.x) + s0[2][2] * ub2(qc.x)) * k; m[3] = (s0[0][3] * ub3(qa.x) + s0[1][3] * ub3(qb.x) + s0[2][3] * ub3(qc.x)) * k;
        m[4] = (s1[0][0] * ub0(qa.y) + s1[1][0] * ub0(qb.y) + s1[2][0] * ub0(qc.y)) * k; m[5] = (s1[0][1] * ub1(qa.y) + s1[1][1] * ub1(qb.y) + s1[2][1] * ub1(qc.y)) * k;
        m[6] = (s1[0][2] * ub2(qa.y) + s1[1][2] * ub2(qb.y) + s1[2][2] * ub2(qc.y)) * k; m[7] = (s1[0][3] * ub3(qa.y) + s1[1][3] * ub3(qb.y) + s1[2][3] * ub3(qc.y)) * k;
        u32x4 o; o.x = pk2(m[0], m[1]); o.y = pk2(m[2], m[3]); o.z = pk2(m[4], m[5]); o.w = pk2(m[6], m[7]);
        *(u32x4*)(MG + (size_t)row * DM + col) = o;
    } else {
        const f32x4* xp = (const f32x4*)(a.x_sample + (size_t)(row - MP) * DM + col);
        const f32x4 v0 = s0[0] + xp[0], v1 = s1[0] + xp[1];
        u32x4 o; o.x = pk2(v0[0], v0[1]); o.y = pk2(v0[2], v0[3]); o.z = pk2(v1[0], v1[1]); o.w = pk2(v1[2], v1[3]);
        *(u32x4*)((bf16_t*)(a.ws + WS_X1B_HI) + (size_t)(row - X1B_SPLIT * 256) * DM + col) = o;
        float ss = (v0[0] * v0[0] + v0[1] * v0[1]) + (v0[2] * v0[2] + v0[3] * v0[3]) + (v1[0] * v1[0] + v1[1] * v1[1]) + (v1[2] * v1[2] + v1[3] * v1[3]);
        ss += __shfl_xor(ss, 1); ss += __shfl_xor(ss, 2); ss += __shfl_xor(ss, 4);
        if ((tid & 7) == 0) ((float*)(a.ws + WS_SSP))[(size_t)row * 16 + cb] = ss;
    }
    __syncthreads();
}

__global__ void __launch_bounds__(512, 2) fwd_kernel(Args a) {
    extern __shared__ __attribute__((aligned(16))) unsigned char lds_raw[];
    LAS unsigned char* lds = (LAS unsigned char*)lds_raw;
    cg::grid_group grid = cg::this_grid();
    const int wave_s = __builtin_amdgcn_readfirstlane((int)threadIdx.x >> 6);
#define tid (wave_s * 64 + lane_id())
    const int G = gridDim.x, c = blockIdx.x;
    const int lo = a.ph_lo, hi = a.ph_hi;
#define IN(k) (lo <= (k) && (k) < hi)
#define SEAM(k) do { if (IN(k) && IN((k) + 1)) xcd_barrier(bar, wave_s); } while (0)
    if (tid < 64) ((LAS unsigned*)(lds + 147456))[tid] = 0u;
    __syncthreads();
    const XcdBarrier bar = xcd_barrier_post((unsigned*)a.ws, (volatile LAS unsigned*)(lds + 147456), wave_s);
    if (lo < 0) grid.sync();
    bf16_t* XN = (bf16_t*)(a.ws + WS_XN); bf16_t* Z = (bf16_t*)(a.ws + WS_Z); bf16_t* MG = XN; bf16_t* H = Z; bf16_t* X1Blo = (bf16_t*)(a.ws + WS_X1B_LO); bf16_t* X1Bhi = (bf16_t*)(a.ws + WS_X1B_HI);
    float* SSP = (float*)(a.ws + WS_SSP);
    constexpr int REPS[8] = {1, 1, 1, 1, 1, 1, 1, 1};
    if (IN(0)) { for (int rep = 0; rep < REPS[0]; ++rep) p0_prologue(a, lds, tid, G); } SEAM(0);
    if (IN(1)) { for (int rep = 0; rep < REPS[1]; ++rep) { pg8::Gemm g{XN, (const bf16_t*)(a.ws + WS_WIN), 1024, 1024, nullptr, 1 << 30}; SchedP1 S{G, c};
        EpiP1 E{Z, (float*)((unsigned char*)a.out + OS_P), a.out + O_MK, a.out + O_MV, (bf16_t*)((unsigned char*)a.out + OS_KB), (bf16_t*)((unsigned char*)a.out + OS_VTB)};
        pg8::gemm_phase(lds, g, S, E, wave_s); } } SEAM(1);
    if (IN(2)) { p2_mixers(a, lds, tid, G); } SEAM(2);
    if (IN(3)) {
        unsigned* cnt = (unsigned*)a.ws + 8192;
        const pg8::Gemm g3{Z, (const bf16_t*)(a.ws + WS_WBR), DIN, 1024, nullptr, 1 << 30}; const EpiP3 E3{Z, MG, G != 256};
        const pg8::Gemm g4{MG, (const bf16_t*)(a.ws + WS_WO), 1024, 1024, nullptr, 1 << 30}; const EpiP4 E4{a.x_prompt, a.x_sample, a.out, X1Blo, X1Bhi, SSP, (float*)(a.ws + WS_SSP4), lds};
        if (G == 256) {
            int pm, pn; pg8::tile_map(64, 4, c, pm, pn);
            { SchedOne3 S{pm, pn}; pg8::gemm_phase(lds, g3, S, E3, wave_s); }
            mini_block<true>(a, lds, c, tid);
            xcd_barrier(bar, wave_s);
            { SchedOne S{pm, pn, 16}; pg8::gemm_phase(lds, g4, S, E4, wave_s); }
            mini_block<false>(a, lds, c, tid);
        } else {
            for (int L = c; L < 272; L += G) { int pm, pn; tile272(L, pm, pn); SchedOne3 S{pm, pn}; pg8::gemm_phase(lds, g3, S, E3, wave_s); panel_signal(cnt + 64 * pm, wave_s); }
            int L0 = (c - 16) % G; if (L0 < 0) L0 += G;
            for (int L = L0; L < 272; L += G) { int pm, pn; tile272(L, pm, pn); panel_wait(cnt + 64 * pm, 4u, (unsigned*)a.ws, wave_s); SchedOne S{pm, pn, 16}; pg8::gemm_phase(lds, g4, S, E4, wave_s); }
        }
        p0_deferred(a, lds, tid, G);
    } SEAM(4);
    if (IN(5)) { for (int rep = 0; rep < REPS[5]; ++rep) { pg8::Gemm g{X1Blo, (const bf16_t*)(a.ws + WS_WUP), 1024, 1024, X1Bhi, X1B_SPLIT}; SchedT S{68, 16, 16, G, c}; EpiP5 E{SSP, H, (const float*)(a.ws + WS_SSP4), G == 256 ? 64 : 68}; pg8::gemm_phase(lds, g, S, E, wave_s); } } SEAM(5);
    if (IN(6)) { pg8::Gemm g{H, (const bf16_t*)(a.ws + WS_WDN), DFF, DFF, nullptr, 1 << 30}; SchedP6 S{G, c};
        if (G == 256) { EpiP6F E{a.out, a.ws, X1Blo, X1Bhi, a.out + (size_t)MP * DM  , (unsigned*)a.ws + 8192 + 64 * 68, (unsigned*)a.ws, a.g_final, lds}; pg8::gemm_phase(lds, g, S, E, wave_s); }
        else { EpiP6 E{a.out, a.ws, X1Blo, X1Bhi}; pg8::gemm_phase(lds, g, S, E, wave_s); } } SEAM(6);
    if (IN(7)) { p7_final(a, lds, tid, G); }
#undef IN
#undef SEAM
#undef tid
}

extern "C" void kernel_launch(void* const* d_in, const int* in_sizes, int n_in, void* d_out, int out_size, void* d_ws, size_t ws_size, hipStream_t stream) {
    static int grid = 0;
    if (grid == 0) {
        int dev = 0, cus = 0, per_cu = 0;
        if (n_in != 24 || ws_size < 256 * MiB) { fprintf(stderr, "kernel_launch: unexpected n_in %d / ws %zu\n", n_in, ws_size); grid = -1; return; }
        (void)hipGetDevice(&dev);
        (void)hipDeviceGetAttribute(&cus, hipDeviceAttributeMultiprocessorCount, dev);
        if (hipFuncSetAttribute((const void*)fwd_kernel, hipFuncAttributeMaxDynamicSharedMemorySize, LDS_BYTES) != hipSuccess) fprintf(stderr, "kernel_launch: hipFuncSetAttribute failed\n");
        if (hipOccupancyMaxActiveBlocksPerMultiprocessor(&per_cu, (const void*)fwd_kernel, 512, LDS_BYTES) != hipSuccess || per_cu < 1) per_cu = 1;
        (void)hipGetLastError();
        grid = cus * per_cu;
        if (grid <= 0) grid = 256;
    }
    if (grid < 0) return;
    if (hipMemsetAsync(d_ws, 0, 131072, stream) != hipSuccess) { fprintf(stderr, "kernel_launch: memset failed\n"); return; }
    Args a{};
    const float** pp = (const float**)&a;
    for (int i = 0; i < 24; ++i) pp[i] = (const float*)d_in[i];
    a.out = (float*)d_out; a.ws = (unsigned char*)d_ws; a.ph_lo = 0; a.ph_hi = 8;
    void* args[] = {&a};
    hipError_t e = hipLaunchCooperativeKernel((const void*)fwd_kernel, dim3(grid), dim3(512), args, LDS_BYTES, stream);
    if (e != hipSuccess) fprintf(stderr, "kernel_launch: cooperative launch failed: %s (grid %d)\n", hipGetErrorString(e), grid);
}
```

```cpp
#include <hip/hip_runtime.h>
#include <hip/hip_cooperative_groups.h>
#include <cstdio>
#include <cstdint>
namespace cg = cooperative_groups;

#define LAS __attribute__((address_space(3)))
typedef unsigned short bf16_t;
typedef short bf16x8 __attribute__((ext_vector_type(8)));
typedef float f32x4 __attribute__((ext_vector_type(4)));
typedef float f32x2 __attribute__((ext_vector_type(2)));
typedef unsigned u32x4 __attribute__((ext_vector_type(4)));
typedef unsigned u32x2 __attribute__((ext_vector_type(2)));

constexpr int DM = 1024, MP = 16384, MS = 1024, MT = MP + MS  , DIN = 4608, DFF = 4096;
constexpr int MKV = 2048;
constexpr float EPS = 1e-6f;
constexpr size_t MiB = 1u << 20;
constexpr size_t WS_WIN = 1 * MiB;
constexpr size_t WS_WO = 11 * MiB;
constexpr size_t WS_WUP = 13 * MiB;
constexpr size_t WS_WDN = 21 * MiB;
constexpr size_t WS_WBR = 29 * MiB;
constexpr size_t WS_WSB = 31 * MiB;
constexpr size_t WS_SSP4 = 2 * MiB + 256 * 1024;
constexpr size_t WS_SSP = 1 * MiB;
constexpr size_t WS_XN = 48 * MiB;
constexpr size_t WS_Z = 86 * MiB;
constexpr size_t WS_X1B_LO = 239 * MiB, WS_X1B_HI = 31 * MiB;
constexpr int X1B_SPLIT = 34;
constexpr size_t OS_P = 0;
constexpr size_t OS_KB = 17 * MiB;
constexpr size_t OS_VTB = 34 * MiB;
constexpr size_t O_Y = 0, O_MK = 17825792, O_MV = 18350080, O_PP = 18874368, O_PS = 18905088, O_CVP = 19396608, O_CVS = 19920896;
constexpr int LDS_BYTES = 147456 + 256;

__device__ __forceinline__ unsigned f2bf(float f) { unsigned u = __builtin_bit_cast(unsigned, f); return (u + 0x7fffu + ((u >> 16) & 1u)) >> 16; }
__device__ __forceinline__ unsigned pk2(float lo, float hi) { return f2bf(lo) | (f2bf(hi) << 16); }
__device__ __forceinline__ float bf_lo(unsigned w) { return __builtin_bit_cast(float, w << 16); }
__device__ __forceinline__ float bf_hi(unsigned w) { return __builtin_bit_cast(float, w & 0xffff0000u); }
__device__ __forceinline__ unsigned cvt_pk_bf16(float lo, float hi) { unsigned r; asm volatile("v_cvt_pk_bf16_f32 %0, %1, %2" : "=v"(r) : "v"(lo), "v"(hi)); return r; }
__device__ __forceinline__ float gelu_t(float x) {
    const float y = 0.7978845608f * (x + 0.044715f * x * x * x);
    const float e = __builtin_amdgcn_exp2f(-2.885390082f * y);
    return x * __builtin_amdgcn_rcpf(1.0f + e);
}
__device__ __forceinline__ unsigned gate_q(float x) { const float g = __builtin_amdgcn_rcpf(1.0f + __builtin_amdgcn_exp2f(-1.4426950409f * x)); return (unsigned)fminf(fmaxf(g * 255.0f + 0.5f, 1.0f), 255.0f); }
__device__ __forceinline__ float ub0(unsigned w) { return (float)(w & 0xffu); }
__device__ __forceinline__ float ub1(unsigned w) { return (float)((w >> 8) & 0xffu); }
__device__ __forceinline__ float ub2(unsigned w) { return (float)((w >> 16) & 0xffu); }
__device__ __forceinline__ float ub3(unsigned w) { return (float)(w >> 24); }
__device__ __forceinline__ f32x2 gelu_t2(f32x2 x) {
    const f32x2 x2 = x * x, pch = x2 * 0.0356774081f + 0.7978845608f, t = (pch * x) * (-2.885390082f);
    f32x2 e; e.x = __builtin_amdgcn_exp2f(t.x); e.y = __builtin_amdgcn_exp2f(t.y);
    const f32x2 d = e + 1.0f; f32x2 r; r.x = __builtin_amdgcn_rcpf(d.x); r.y = __builtin_amdgcn_rcpf(d.y);
    return x * r;
}

__device__ __forceinline__ int lane_id() { int l; asm volatile("v_mbcnt_lo_u32_b32 %0, -1, 0\n\tv_mbcnt_hi_u32_b32 %0, -1, %0" : "=v"(l)); return l; }
struct Args {
    const float *x_prompt, *x_sample, *mem, *cache_k, *cache_v, *state_pool;
    const float *g_mix, *w_in, *g_v, *b_v, *w_s, *b_s, *w_pool, *pool_scale, *g_mem, *w_kv;
    const float *w_out_a, *w_out_b, *w_out_c, *w_o, *g_ffn, *w_up, *w_down, *g_final;
    float* out; unsigned char* ws; int ph_lo, ph_hi;
};

namespace pg8 {
constexpr int BM = 256, BK = 64, HALF = 128, HTB = HALF * BK * 2, STAGE_BYTES = 8 * HTB;
__device__ __forceinline__ int lds_byte(int r, int c) { const int st = (r >> 4) * 2 + (c >> 5), rr = r & 15, cc = c & 31, ob = rr * 64 + cc * 2; return st * 1024 + (ob ^ (((ob >> 9) & 1) << 5)); }
__device__ __forceinline__ void stage_rc(int b, int& R, int& C) { const int st = b / 1024, sb = b % 1024, swz = sb ^ (((sb >> 9) & 1) << 5); R = (st >> 1) * 16 + swz / 64; C = (st & 1) * 32 + (swz % 64) / 2; }
__device__ __forceinline__ int perm32(int rho) { const int n = rho >> 4, i = rho & 15; return 8 * (i >> 2) + 4 * n + (i & 3); }

struct Unit { int pm, pn, ka, kb, nt, tag; };
struct Gemm { const bf16_t* A; const bf16_t* Bt; int lda, ldb; const bf16_t* A2; int psplit; };

__device__ __forceinline__ void tile_map(int nM, int nN, int L, int& pm, int& pn) {
    const int nwg = nM * nN; int wgid = L;
    { const int q = nwg / 8, r = nwg % 8, xcd = wgid % 8, off = wgid / 8; wgid = (xcd < r ? xcd * (q + 1) : r * (q + 1) + (xcd - r) * q) + off; }
    const int nig = 8 * nN, gid = wgid / nig, fm = gid * 8, gsz = (nM - fm) < 8 ? (nM - fm) : 8;
    pm = fm + ((wgid % nig) % gsz); pn = (wgid % nig) / gsz;
}

template <class Epi, class Sched>
__device__ __forceinline__ void gemm_phase(LAS unsigned char* lds, const Gemm g, const Sched& S, const Epi& E, int wave_s) {
    const int wid = wave_s, lane = lane_id(), tid = wid * 64 + lane, wr = wid >> 2, wc = wid & 3, fr = lane & 15, fq = lane >> 4;
    unsigned voffA[2], voffB[2];
#pragma unroll
    for (int i = 0; i < 2; ++i) { int R, C; stage_rc(tid * 16 + i * 8192, R, C); const int Rb = (R & ~31) + perm32(R & 31);
        voffA[i] = (unsigned)(R * g.lda + C) * 2u; voffB[i] = (unsigned)(Rb * g.ldb + C) * 2u; }
    const size_t kstep = (size_t)(BK * 2);
    const size_t hstepA = (size_t)HALF * g.lda * 2, hstepB = (size_t)HALF * g.ldb * 2;
    const size_t tstepA = 2 * hstepA, tstepB = 2 * hstepB;
    const unsigned ldsw = (unsigned)wid * 1024u;
    const int aoff = lds_byte(wr * 64 + fr, fq * 8), boff = lds_byte(wc * 32 + fr, fq * 8);
#define PG8_SA(b, h) (((b) * 2 + (h)) * HTB)
#define PG8_SB(b, h) ((4 + (b) * 2 + (h)) * HTB)
#define PG8_STAGE(bufoff, gbase, voff) do { _Pragma("unroll") for (int _i = 0; _i < 2; ++_i) \
        __builtin_amdgcn_global_load_lds((const unsigned*)((const char*)(gbase) + (voff)[_i]), (LAS unsigned*)(lds + (bufoff) + ldsw + _i * 8192), 16, 0, 0); } while (0)
#define PG8_LDA(dst, b, h) do { _Pragma("unroll") for (int m = 0; m < 4; ++m) _Pragma("unroll") for (int k = 0; k < 2; ++k) dst[m][k] = *(const LAS bf16x8*)(lds + PG8_SA(b, h) + aoff + m * 2048 + k * 1024); } while (0)
#define PG8_LDB(dst, b, h) do { _Pragma("unroll") for (int n = 0; n < 2; ++n) _Pragma("unroll") for (int k = 0; k < 2; ++k) dst[n][k] = *(const LAS bf16x8*)(lds + PG8_SB(b, h) + boff + n * 2048 + k * 1024); } while (0)
#define PG8_MMA(ai, bj, At, Bt) do { __builtin_amdgcn_s_setprio(1); _Pragma("unroll") for (int m = 0; m < 4; ++m) _Pragma("unroll") for (int n = 0; n < 2; ++n) _Pragma("unroll") for (int k = 0; k < 2; ++k) \
        acc[ai][bj][m][n] = __builtin_amdgcn_mfma_f32_16x16x32_bf16(Bt[n][k], At[m][k], acc[ai][bj][m][n], 0, 0, 0); __builtin_amdgcn_s_setprio(0); } while (0)
#define PG8_WAIT_V(n) asm volatile("s_waitcnt vmcnt(" #n ")" ::: "memory")
#define PG8_WAIT_L(n) asm volatile("s_waitcnt lgkmcnt(" #n ")" ::: "memory")
#define PG8_BAR __builtin_amdgcn_s_barrier()
#define PG8_SCHED __builtin_amdgcn_sched_barrier(0)
    Unit cur, nxt; int ui = 0;
    if (!S.next(0, cur)) return;
    f32x4 acc[2][2][4][2];
#pragma unroll
    for (int a = 0; a < 2; ++a)
#pragma unroll
        for (int b = 0; b < 2; ++b)
#pragma unroll
            for (int m = 0; m < 4; ++m)
#pragma unroll
                for (int n = 0; n < 2; ++n) acc[a][b][m][n] = (f32x4){0.f, 0.f, 0.f, 0.f};
    bf16x8 At[4][2], B0[2][2], B1[2][2];
    const char* cA = (cur.pm < g.psplit ? (const char*)g.A + (size_t)cur.pm * tstepA : (const char*)g.A2 + (size_t)(cur.pm - g.psplit) * tstepA) + cur.ka; const char* cB = (const char*)g.Bt + (size_t)cur.pn * tstepB + cur.kb;
    PG8_STAGE(PG8_SB(0, 0), cB, voffB); PG8_STAGE(PG8_SB(0, 1), cB + hstepB, voffB); PG8_STAGE(PG8_SA(0, 0), cA, voffA); PG8_STAGE(PG8_SA(0, 1), cA + hstepA, voffA);
    if (wr == 1) PG8_BAR;
    PG8_WAIT_V(2); PG8_BAR;
    PG8_STAGE(PG8_SB(1, 0), cB + kstep, voffB); PG8_STAGE(PG8_SA(1, 0), cA + kstep, voffA); PG8_STAGE(PG8_SB(1, 1), cB + hstepB + kstep, voffB);
    PG8_WAIT_V(6); PG8_BAR;
    for (;;) {
        const bool has_next = S.next(ui + 1, nxt);
        const char* nA = has_next ? (nxt.pm < g.psplit ? (const char*)g.A + (size_t)nxt.pm * tstepA : (const char*)g.A2 + (size_t)(nxt.pm - g.psplit) * tstepA) + nxt.ka : cA; const char* nB = has_next ? (const char*)g.Bt + (size_t)nxt.pn * tstepB + nxt.kb : cB;
        const int nt = cur.nt;
        for (int t = 0; t < nt; t += 2) {
            const bool last = (t == nt - 2);
            const char* a1 = cA + (size_t)(t + 1) * kstep;
            const char* a2 = last ? nA : cA + (size_t)(t + 2) * kstep; const char* b2 = last ? nB : cB + (size_t)(t + 2) * kstep;
            const char* a3 = a2 + kstep; const char* b3 = b2 + kstep;
            PG8_LDB(B0, 0, 0); PG8_LDB(B1, 0, 1); PG8_SCHED; PG8_LDA(At, 0, 0); PG8_STAGE(PG8_SA(1, 1), a1 + hstepA, voffA);
            PG8_WAIT_V(8); PG8_WAIT_L(0); PG8_BAR; PG8_MMA(0, 0, At, B0); PG8_MMA(0, 1, At, B1); PG8_BAR; PG8_SCHED;
            PG8_LDA(At, 0, 1); PG8_STAGE(PG8_SB(0, 0), b2, voffB); PG8_STAGE(PG8_SB(0, 1), b2 + hstepB, voffB); PG8_STAGE(PG8_SA(0, 0), a2, voffA);
            PG8_WAIT_V(8); PG8_WAIT_L(0); PG8_BAR; PG8_MMA(1, 0, At, B0); PG8_MMA(1, 1, At, B1); PG8_BAR; PG8_SCHED;
            PG8_LDB(B0, 1, 0); PG8_LDB(B1, 1, 1); PG8_SCHED; PG8_LDA(At, 1, 0); PG8_STAGE(PG8_SA(0, 1), a2 + hstepA, voffA);
            PG8_WAIT_V(8); PG8_WAIT_L(0); PG8_BAR; PG8_MMA(0, 0, At, B0); PG8_MMA(0, 1, At, B1); PG8_BAR; PG8_SCHED;
            PG8_LDA(At, 1, 1); PG8_STAGE(PG8_SB(1, 0), b3, voffB); PG8_STAGE(PG8_SB(1, 1), b3 + hstepB, voffB); PG8_STAGE(PG8_SA(1, 0), a3, voffA);
            PG8_WAIT_V(8); PG8_WAIT_L(0); PG8_BAR; PG8_MMA(1, 0, At, B0); PG8_MMA(1, 1, At, B1); PG8_BAR; PG8_SCHED;
        }
        if (wr == 0) PG8_BAR;
        const bool zero = E(acc, cur, wr, wc, fr, fq);
        if (!has_next) break;
        if (zero) {
#pragma unroll
            for (int a = 0; a < 2; ++a)
#pragma unroll
                for (int b = 0; b < 2; ++b)
#pragma unroll
                    for (int m = 0; m < 4; ++m)
#pragma unroll
                        for (int n = 0; n < 2; ++n) acc[a][b][m][n] = (f32x4){0.f, 0.f, 0.f, 0.f};
        }
        cur = nxt; cA = nA; cB = nB; ++ui;
        if (wr == 1) PG8_BAR;
    }
    PG8_WAIT_V(0);
    PG8_BAR;
#undef PG8_SA
#undef PG8_SB
#undef PG8_STAGE
#undef PG8_LDA
#undef PG8_LDB
#undef PG8_MMA
#undef PG8_WAIT_V
#undef PG8_WAIT_L
#undef PG8_BAR
#undef PG8_SCHED
}
}
using pg8::Unit;

struct SchedP1 {
    int G, c;
    __device__ __forceinline__ bool next(int i, Unit& u) const {
        int L = i * G + c;
        if (L < 1224) { pg8::tile_map(68, 18, L, u.pm, u.pn); u.ka = 0; u.kb = 0; u.nt = 16; u.tag = 0; return true; }
        L -= 1224;
        if (L < 16) { u.pm = 68 + (L & 7); u.pn = 18 + (L >> 3); u.ka = 0; u.kb = 0; u.nt = 16; u.tag = 1; return true; }
        return false;
    }
};
struct SchedT {
    int nM, nN, nt, G, c;
    __device__ __forceinline__ bool next(int i, Unit& u) const {
        const int L = i * G + c; if (L >= nM * nN) return false;
        pg8::tile_map(nM, nN, L, u.pm, u.pn); u.ka = 0; u.kb = 0; u.nt = nt; u.tag = 0; return true;
    }
};
struct SchedP3 {
    int G, c;
    __device__ __forceinline__ bool next(int i, Unit& u) const {
        const int j = i / 3, br = i - 3 * j; const int L = j * G + c; if (L >= 272) return false;
        pg8::tile_map(68, 4, L, u.pm, u.pn);
        u.tag = br; u.nt = br == 0 ? 8 : 4; u.ka = br == 0 ? 0 : (br == 1 ? 2048 : 2560); u.kb = br == 0 ? 0 : (br == 1 ? 1024 : 1536);
        return true;
    }
};

struct SchedOne3 {
    int pm, pn;
    __device__ __forceinline__ bool next(int i, Unit& u) const {
        if (i >= 3) return false;
        u.pm = pm; u.pn = pn; u.tag = i; u.nt = i == 0 ? 8 : 4; u.ka = i == 0 ? 0 : (i == 1 ? 2048 : 2560); u.kb = i == 0 ? 0 : (i == 1 ? 1024 : 1536); return true;
    }
};
struct SchedOne {
    int pm, pn, nt;
    __device__ __forceinline__ bool next(int i, Unit& u) const { if (i >= 1) return false; u.pm = pm; u.pn = pn; u.ka = 0; u.kb = 0; u.nt = nt; u.tag = 0; return true; }
};
__device__ __forceinline__ void tile272(int L, int& pm, int& pn) { if (L < 256) pg8::tile_map(64, 4, L, pm, pn); else { pm = 64 + ((L - 256) >> 2); pn = (L - 256) & 3; } }
struct SchedP6 {
    int G, c;
    __device__ __forceinline__ bool next(int i, Unit& u) const {
        if (G == 256) {
            if (i == 1) { pg8::tile_map(64, 4, c, u.pm, u.pn); u.ka = 0; u.kb = 0; u.nt = 64; u.tag = 0; return true; }
            if (i == 0) { const int j = c >> 4; u.pm = 64 + (j >> 2); u.pn = j & 3; u.ka = (c & 15) * 512; u.kb = u.ka; u.nt = 4; u.tag = 1 + (c & 15); return true; }
            return false;
        }
        const int L = i * G + c; if (L >= 272) return false;
        pg8::tile_map(68, 4, L, u.pm, u.pn); u.ka = 0; u.kb = 0; u.nt = 64; u.tag = 0; return true;
    }
};
__device__ __forceinline__ float* part_base(unsigned char* ws, int s) {
    const size_t mb = s < 8 ? 48 + 4 * (size_t)s : (s < 12 ? 222 + 4 * (size_t)(s - 8) : (s < 14 ? 13 + 4 * (size_t)(s - 12) : 3 + 4 * (size_t)(s - 14)));
    return (float*)(ws + mb * MiB);
}
__device__ __forceinline__ void panel_signal(unsigned* cnt, int wave_s);
__device__ __forceinline__ void panel_wait(unsigned* cnt, unsigned want, unsigned* bar, int wave_s);
#define EPI_ROWS(u) const int row0 = (u).pm * 256 + wr * 64 + fr; const int col0 = (u).pn * 256 + wc * 32 + 8 * fq;
struct EpiP1 {
    bf16_t* Z; float* P; float* outk; float* outv; bf16_t* KB; bf16_t* VTB;
    __device__ __forceinline__ bool operator()(const f32x4 (&acc)[2][2][4][2], const Unit& u, int wr, int wc, int fr, int fq) const {
        EPI_ROWS(u)
        if (u.tag == 0) {
            const int pn = u.pn;
#pragma unroll
            for (int ai = 0; ai < 2; ++ai)
#pragma unroll
                for (int m = 0; m < 4; ++m) { const int row = row0 + ai * 128 + m * 16;
#pragma unroll
                    for (int bj = 0; bj < 2; ++bj) { const int col = col0 + bj * 128; f32x4 v0 = acc[ai][bj][m][0], v1 = acc[ai][bj][m][1];
                        if (pn == 4) { float* p = P + (size_t)row * 256 + (col - 1024); *(f32x4*)p = v0; *(f32x4*)(p + 4) = v1; }
                        else {
                            if (pn < 4) {
                                const f32x2 a0 = gelu_t2((f32x2){v0[0], v0[1]}), a1 = gelu_t2((f32x2){v0[2], v0[3]}), a2 = gelu_t2((f32x2){v1[0], v1[1]}), a3 = gelu_t2((f32x2){v1[2], v1[3]});
                                v0 = (f32x4){a0.x, a0.y, a1.x, a1.y}; v1 = (f32x4){a2.x, a2.y, a3.x, a3.y};
                            } else if (pn >= 6) {
                                u32x2 q; q.x = gate_q(v0[0]) | (gate_q(v0[1]) << 8) | (gate_q(v0[2]) << 16) | (gate_q(v0[3]) << 24); q.y = gate_q(v1[0]) | (gate_q(v1[1]) << 8) | (gate_q(v1[2]) << 16) | (gate_q(v1[3]) << 24);
                                *(u32x2*)((unsigned char*)Z + (size_t)row * (DIN * 2) + 1536 + col) = q; continue;
                            }
                            u32x4 w; w.x = cvt_pk_bf16(v0[0], v0[1]); w.y = cvt_pk_bf16(v0[2], v0[3]); w.z = cvt_pk_bf16(v1[0], v1[1]); w.w = cvt_pk_bf16(v1[2], v1[3]);
                            *(u32x4*)(Z + (size_t)row * DIN + col) = w;
                        } } }
        } else {
            const bool isv = (u.pn == 19);
#pragma unroll
            for (int ai = 0; ai < 2; ++ai)
#pragma unroll
                for (int m = 0; m < 4; ++m) { const int r = row0 - 68 * 256 + ai * 128 + m * 16;
#pragma unroll
                    for (int bj = 0; bj < 2; ++bj) { const int c = wc * 32 + 8 * fq + bj * 128; const f32x4 v0 = acc[ai][bj][m][0], v1 = acc[ai][bj][m][1];
                        float* o = (isv ? outv : outk) + (size_t)r * 256 + c; *(f32x4*)o = v0; *(f32x4*)(o + 4) = v1;
                        if (!isv) { u32x4 w; w.x = cvt_pk_bf16(v0[0], v0[1]); w.y = cvt_pk_bf16(v0[2], v0[3]); w.z = cvt_pk_bf16(v1[0], v1[1]); w.w = cvt_pk_bf16(v1[2], v1[3]);
                            *(u32x4*)(KB + (size_t)r * 256 + c) = w; }
                        else { bf16_t* vt = VTB + ((size_t)(r >> 8) * 256 + c) * 256 + (r & 255);
#pragma unroll
                            for (int e = 0; e < 4; ++e) { vt[(size_t)e * 256] = (bf16_t)f2bf(v0[e]); vt[(size_t)(e + 4) * 256] = (bf16_t)f2bf(v1[e]); } }
                    } }
        }
        return true;
    }
};
struct EpiP3 {
    const bf16_t* Z; bf16_t* MG; bool wt;
    __device__ __forceinline__ bool operator()(f32x4 (&acc)[2][2][4][2], const Unit& u, int wr, int wc, int fr, int fq) const {
        EPI_ROWS(u)
        const int br = u.tag;
        u32x2 gn[2][4][2], gd[2][4][2];
#pragma unroll
        for (int ai = 0; ai < 2; ++ai)
#pragma unroll
            for (int m = 0; m < 4; ++m)
#pragma unroll
                for (int bj = 0; bj < 2; ++bj) { const unsigned char* gp = (const unsigned char*)Z + (size_t)(row0 + ai * 128 + m * 16) * (DIN * 2) + 3072 + br * 1024 + col0 + bj * 128;
                    gn[ai][m][bj] = *(const u32x2*)gp; if (br < 2) gd[ai][m][bj] = *(const u32x2*)(gp + 1024); }
        asm volatile("" ::: "memory");
#pragma unroll
        for (int ai = 0; ai < 2; ++ai)
#pragma unroll
            for (int m = 0; m < 4; ++m) { const int row = row0 + ai * 128 + m * 16;
#pragma unroll
                for (int bj = 0; bj < 2; ++bj) { const int col = col0 + bj * 128;
                    const u32x2 g1 = gn[ai][m][bj];
                    float f[8];
                    f[0] = ub0(g1.x); f[1] = ub1(g1.x); f[2] = ub2(g1.x); f[3] = ub3(g1.x); f[4] = ub0(g1.y); f[5] = ub1(g1.y); f[6] = ub2(g1.y); f[7] = ub3(g1.y);
                    if (br < 2) { const u32x2 g2 = gd[ai][m][bj];
                        f[0] *= __builtin_amdgcn_rcpf(ub0(g2.x)); f[1] *= __builtin_amdgcn_rcpf(ub1(g2.x)); f[2] *= __builtin_amdgcn_rcpf(ub2(g2.x)); f[3] *= __builtin_amdgcn_rcpf(ub3(g2.x));
                        f[4] *= __builtin_amdgcn_rcpf(ub0(g2.y)); f[5] *= __builtin_amdgcn_rcpf(ub1(g2.y)); f[6] *= __builtin_amdgcn_rcpf(ub2(g2.y)); f[7] *= __builtin_amdgcn_rcpf(ub3(g2.y)); }
                    else {
#pragma unroll
                        for (int e = 0; e < 8; ++e) f[e] *= (1.0f / 255.0f); }
                    f32x4 v0 = acc[ai][bj][m][0], v1 = acc[ai][bj][m][1];
                    v0[0] *= f[0]; v0[1] *= f[1]; v0[2] *= f[2]; v0[3] *= f[3]; v1[0] *= f[4]; v1[1] *= f[5]; v1[2] *= f[6]; v1[3] *= f[7];
                    if (br < 2) { acc[ai][bj][m][0] = v0; acc[ai][bj][m][1] = v1; }
                    else { u32x4 w; w.x = cvt_pk_bf16(v0[0], v0[1]); w.y = cvt_pk_bf16(v0[2], v0[3]); w.z = cvt_pk_bf16(v1[0], v1[1]); w.w = cvt_pk_bf16(v1[2], v1[3]);
                        if (!wt) *(u32x4*)(MG + (size_t)row * DM + col) = w;
                        else { unsigned long long* mp = (unsigned long long*)(MG + (size_t)row * DM + col);
                            __hip_atomic_store(mp, (unsigned long long)w.x | ((unsigned long long)w.y << 32), __ATOMIC_RELAXED, __HIP_MEMORY_SCOPE_AGENT);
                            __hip_atomic_store(mp + 1, (unsigned long long)w.z | ((unsigned long long)w.w << 32), __ATOMIC_RELAXED, __HIP_MEMORY_SCOPE_AGENT); } }
                } }
        return br == 2;
    }
};
struct EpiP4 {
    const float* xp; const float* xs; float* out; bf16_t* X1Blo; bf16_t* X1Bhi; float* SSP; float* SSP4; LAS unsigned char* lds;
    __device__ __forceinline__ bool operator()(const f32x4 (&acc)[2][2][4][2], const Unit& u, int wr, int wc, int fr, int fq) const {
        EPI_ROWS(u)
        const float* xb = u.pm < 64 ? xp : xs - (size_t)MP * DM;
        bf16_t* X1B = u.pm < X1B_SPLIT ? X1Blo : X1Bhi - (size_t)X1B_SPLIT * 256 * DM;
#pragma unroll
        for (int ai = 0; ai < 2; ++ai) {
            f32x4 xv[4][2][2];
#pragma unroll
            for (int m = 0; m < 4; ++m)
#pragma unroll
                for (int bj = 0; bj < 2; ++bj) { const size_t off = (size_t)(row0 + ai * 128 + m * 16) * DM + col0 + bj * 128; xv[m][bj][0] = __builtin_nontemporal_load((const f32x4*)(xb + off)); xv[m][bj][1] = __builtin_nontemporal_load((const f32x4*)(xb + off + 4)); }
            asm volatile("" ::: "memory");
#pragma unroll
            for (int m = 0; m < 4; ++m) { const int row = row0 + ai * 128 + m * 16; float ss = 0.f;
#pragma unroll
                for (int bj = 0; bj < 2; ++bj) { const int col = col0 + bj * 128; const size_t off = (size_t)row * DM + col;
                    const f32x4 v0 = acc[ai][bj][m][0] + xv[m][bj][0], v1 = acc[ai][bj][m][1] + xv[m][bj][1];
                    u32x4 w; w.x = cvt_pk_bf16(v0[0], v0[1]); w.y = cvt_pk_bf16(v0[2], v0[3]); w.z = cvt_pk_bf16(v1[0], v1[1]); w.w = cvt_pk_bf16(v1[2], v1[3]);
                    *(u32x4*)(X1B + off) = w;
                    ss += (v0[0] * v0[0] + v0[1] * v0[1]) + (v0[2] * v0[2] + v0[3] * v0[3]) + (v1[0] * v1[0] + v1[1] * v1[1]) + (v1[2] * v1[2] + v1[3] * v1[3]); }
                ss += __shfl_xor(ss, 16); ss += __shfl_xor(ss, 32);
                if (fq == 0) { SSP[(size_t)row * 16 + u.pn * 4 + wc] = ss; ((LAS float*)(lds + 131072))[(ai * 128 + wr * 64 + m * 16 + fr) * 4 + wc] = ss; } }
            asm volatile("" ::: "memory");
        }
        __syncthreads();
        { const int t = (wr * 4 + wc) * 64 + fq * 16 + fr;
          if (t < 256) { const f32x4 q = *(const LAS f32x4*)(lds + 131072 + t * 16); SSP4[(size_t)(u.pm * 256 + t) * 4 + u.pn] = (q[0] + q[1]) + (q[2] + q[3]); } }
        __syncthreads();
        return true;
    }
};
struct EpiP5 {
    const float* SSP; bf16_t* H; const float* SSP4; int n4;
    __device__ __forceinline__ bool operator()(const f32x4 (&acc)[2][2][4][2], const Unit& u, int wr, int wc, int fr, int fq) const {
        EPI_ROWS(u)
        if (u.pm < n4) {
            f32x4 sq[2][4];
#pragma unroll
            for (int ai = 0; ai < 2; ++ai)
#pragma unroll
                for (int m = 0; m < 4; ++m) sq[ai][m] = *(const f32x4*)(SSP4 + (size_t)(row0 + ai * 128 + m * 16) * 4);
            asm volatile("" ::: "memory");
#pragma unroll
            for (int ai = 0; ai < 2; ++ai)
#pragma unroll
                for (int m = 0; m < 4; ++m) { const int row = row0 + ai * 128 + m * 16; const f32x4 q = sq[ai][m];
                    const float rstd = 1.0f / sqrtf(((q[0] + q[1]) + (q[2] + q[3])) * (1.0f / DM) + EPS);
#pragma unroll
                    for (int bj = 0; bj < 2; ++bj) { const int col = col0 + bj * 128; f32x4 v0 = acc[ai][bj][m][0] * rstd, v1 = acc[ai][bj][m][1] * rstd;
#pragma unroll
                        for (int e = 0; e < 4; ++e) { const float a = fmaxf(v0[e], 0.f), b = fmaxf(v1[e], 0.f); v0[e] = a * a; v1[e] = b * b; }
                        u32x4 w; w.x = cvt_pk_bf16(v0[0], v0[1]); w.y = cvt_pk_bf16(v0[2], v0[3]); w.z = cvt_pk_bf16(v1[0], v1[1]); w.w = cvt_pk_bf16(v1[2], v1[3]);
                        *(u32x4*)(H + (size_t)row * DFF + col) = w; } }
            return true;
        }
#pragma unroll
        for (int ai = 0; ai < 2; ++ai) {
            f32x4 sv[4][4];
#pragma unroll
            for (int m = 0; m < 4; ++m) { const f32x4* sp = (const f32x4*)(SSP + (size_t)(row0 + ai * 128 + m * 16) * 16);
#pragma unroll
                for (int k = 0; k < 4; ++k) sv[m][k] = sp[k]; }
            asm volatile("" ::: "memory");
#pragma unroll
            for (int m = 0; m < 4; ++m) { const int row = row0 + ai * 128 + m * 16;
                const f32x4 s0 = sv[m][0], s1 = sv[m][1], s2 = sv[m][2], s3 = sv[m][3];
                const float ss = ((s0[0] + s0[1]) + (s0[2] + s0[3])) + ((s1[0] + s1[1]) + (s1[2] + s1[3])) + ((s2[0] + s2[1]) + (s2[2] + s2[3])) + ((s3[0] + s3[1]) + (s3[2] + s3[3]));
                const float rstd = 1.0f / sqrtf(ss * (1.0f / DM) + EPS);
#pragma unroll
                for (int bj = 0; bj < 2; ++bj) { const int col = col0 + bj * 128; f32x4 v0 = acc[ai][bj][m][0] * rstd, v1 = acc[ai][bj][m][1] * rstd;
#pragma unroll
                    for (int e = 0; e < 4; ++e) { const float a = fmaxf(v0[e], 0.f), b = fmaxf(v1[e], 0.f); v0[e] = a * a; v1[e] = b * b; }
                    u32x4 w; w.x = cvt_pk_bf16(v0[0], v0[1]); w.y = cvt_pk_bf16(v0[2], v0[3]); w.z = cvt_pk_bf16(v1[0], v1[1]); w.w = cvt_pk_bf16(v1[2], v1[3]);
                    *(u32x4*)(H + (size_t)row * DFF + col) = w; } }
            asm volatile("" ::: "memory");
        }
        return true;
    }
};
struct EpiP6 {
    float* out; unsigned char* ws; const bf16_t* X1Blo; const bf16_t* X1Bhi;
    __device__ __forceinline__ bool operator()(const f32x4 (&acc)[2][2][4][2], const Unit& u, int wr, int wc, int fr, int fq) const {
        EPI_ROWS(u)
        if (u.tag == 0) {
            const bf16_t* X1B = u.pm < X1B_SPLIT ? X1Blo : X1Bhi - (size_t)X1B_SPLIT * 256 * DM;
#pragma unroll
            for (int ai = 0; ai < 2; ++ai) {
                u32x4 xv[4][2];
#pragma unroll
                for (int m = 0; m < 4; ++m)
#pragma unroll
                    for (int bj = 0; bj < 2; ++bj) xv[m][bj] = *(const u32x4*)(X1B + (size_t)(row0 + ai * 128 + m * 16) * DM + col0 + bj * 128);
                asm volatile("" ::: "memory");
#pragma unroll
                for (int m = 0; m < 4; ++m)
#pragma unroll
                    for (int bj = 0; bj < 2; ++bj) { const size_t off = (size_t)(row0 + ai * 128 + m * 16) * DM + col0 + bj * 128; const u32x4 xw = xv[m][bj];
                        *(f32x4*)(out + off) = acc[ai][bj][m][0] + (f32x4){bf_lo(xw.x), bf_hi(xw.x), bf_lo(xw.y), bf_hi(xw.y)};
                        *(f32x4*)(out + off + 4) = acc[ai][bj][m][1] + (f32x4){bf_lo(xw.z), bf_hi(xw.z), bf_lo(xw.w), bf_hi(xw.w)}; }
                asm volatile("" ::: "memory");
            }
        } else {
            float* pb = part_base(ws, u.tag - 1);
#pragma unroll
            for (int ai = 0; ai < 2; ++ai)
#pragma unroll
                for (int m = 0; m < 4; ++m) { const int row = row0 - MP + ai * 128 + m * 16;
#pragma unroll
                    for (int bj = 0; bj < 2; ++bj) { float* o = pb + (size_t)row * DM + col0 + bj * 128; *(f32x4*)o = acc[ai][bj][m][0]; *(f32x4*)(o + 4) = acc[ai][bj][m][1]; } }
        }
        return true;
    }
};

struct EpiP6F {
    float* out; unsigned char* ws; const bf16_t* X1Blo; const bf16_t* X1Bhi; float* SSP4; unsigned* cnt; unsigned* bar; const float* gfin; LAS unsigned char* lds;
    __device__ __forceinline__ bool operator()(f32x4 (&acc)[2][2][4][2], const Unit& u, int wr, int wc, int fr, int fq) const {
        EPI_ROWS(u)
        if (u.tag != 0) {
            float* pb = part_base(ws, u.tag - 1);
#pragma unroll
            for (int ai = 0; ai < 2; ++ai)
#pragma unroll
                for (int m = 0; m < 4; ++m) { const int row = row0 - MP + ai * 128 + m * 16;
#pragma unroll
                    for (int bj = 0; bj < 2; ++bj) { float* o = pb + (size_t)row * DM + col0 + bj * 128; *(f32x4*)o = acc[ai][bj][m][0]; *(f32x4*)(o + 4) = acc[ai][bj][m][1]; } }
            return true;
        }
        const bf16_t* X1B = u.pm < X1B_SPLIT ? X1Blo : X1Bhi - (size_t)X1B_SPLIT * 256 * DM;
#pragma unroll
        for (int ai = 0; ai < 2; ++ai) {
            u32x4 xv[4][2];
#pragma unroll
            for (int m = 0; m < 4; ++m)
#pragma unroll
                for (int bj = 0; bj < 2; ++bj) xv[m][bj] = *(const u32x4*)(X1B + (size_t)(row0 + ai * 128 + m * 16) * DM + col0 + bj * 128);
            asm volatile("" ::: "memory");
#pragma unroll
            for (int m = 0; m < 4; ++m) { const int row = row0 + ai * 128 + m * 16; float ss = 0.f;
#pragma unroll
                for (int bj = 0; bj < 2; ++bj) { const u32x4 xw = xv[m][bj];
                    const f32x4 v0 = acc[ai][bj][m][0] + (f32x4){bf_lo(xw.x), bf_hi(xw.x), bf_lo(xw.y), bf_hi(xw.y)}, v1 = acc[ai][bj][m][1] + (f32x4){bf_lo(xw.z), bf_hi(xw.z), bf_lo(xw.w), bf_hi(xw.w)};
                    acc[ai][bj][m][0] = v0; acc[ai][bj][m][1] = v1;
                    ss += (v0[0] * v0[0] + v0[1] * v0[1]) + (v0[2] * v0[2] + v0[3] * v0[3]) + (v1[0] * v1[0] + v1[1] * v1[1]) + (v1[2] * v1[2] + v1[3] * v1[3]); }
                ss += __shfl_xor(ss, 16); ss += __shfl_xor(ss, 32);
                if (fq == 0) ((LAS float*)(lds + 131072))[(ai * 128 + wr * 64 + m * 16 + fr) * 4 + wc] = ss; (void)row; }
            asm volatile("" ::: "memory");
        }
        __syncthreads();
        { const int t = (wr * 4 + wc) * 64 + fq * 16 + fr;
          if (t < 256) { const f32x4 q = *(const LAS f32x4*)(lds + 131072 + t * 16); __hip_atomic_store(SSP4 + (size_t)(u.pm * 256 + t) * 4 + u.pn, (q[0] + q[1]) + (q[2] + q[3]), __ATOMIC_RELAXED, __HIP_MEMORY_SCOPE_AGENT); } }
        panel_signal(cnt + 64 * u.pm, wr * 4 + wc);
        panel_wait(cnt + 64 * u.pm, 4u, bar, wr * 4 + wc);
        f32x4 sq[2][4];
#pragma unroll
        for (int ai = 0; ai < 2; ++ai)
#pragma unroll
            for (int m = 0; m < 4; ++m) sq[ai][m] = *(const f32x4*)(SSP4 + (size_t)(row0 + ai * 128 + m * 16) * 4);
        asm volatile("" ::: "memory");
#pragma unroll
        for (int ai = 0; ai < 2; ++ai)
#pragma unroll
            for (int m = 0; m < 4; ++m) { const int row = row0 + ai * 128 + m * 16; const f32x4 q = sq[ai][m];
                const float rstd = 1.0f / sqrtf(((q[0] + q[1]) + (q[2] + q[3])) * (1.0f / DM) + EPS);
#pragma unroll
                for (int bj = 0; bj < 2; ++bj) { const size_t off = (size_t)row * DM + col0 + bj * 128;
                    const f32x4 g0 = *(const f32x4*)(gfin + col0 + bj * 128), g1 = *(const f32x4*)(gfin + col0 + bj * 128 + 4);
                    __builtin_nontemporal_store(acc[ai][bj][m][0] * rstd * g0, (f32x4*)(out + off)); __builtin_nontemporal_store(acc[ai][bj][m][1] * rstd * g1, (f32x4*)(out + off + 4)); } }
        return true;
    }
};

__device__ __forceinline__ float wave_sum(float v) {
#pragma unroll
    for (int o = 1; o < 64; o <<= 1) v += __shfl_xor(v, o);
    return v;
}
__device__ __forceinline__ void tr_item(const float* W, int N, bf16_t* WT, int ldt, int col_off, const float* kscale, LAS float* scr, int item, int lane) {
    const int nblk = N / 32, kb = item / nblk, nb = item % nblk, k0 = 64 * kb, n0 = 32 * nb;
    f32x4 t[8];
#pragma unroll
    for (int i = 0; i < 8; ++i) { const int kk = 8 * i + (lane >> 3); t[i] = __builtin_nontemporal_load((const f32x4*)(W + (size_t)(k0 + kk) * N + n0 + 4 * (lane & 7))); }
    if (kscale) {
#pragma unroll
        for (int i = 0; i < 8; ++i) t[i] = t[i] * kscale[k0 + 8 * i + (lane >> 3)];
    }
#pragma unroll
    for (int i = 0; i < 8; ++i) { LAS float* d = scr + (8 * i + (lane >> 3)) * 33 + 4 * (lane & 7); d[0] = t[i][0]; d[1] = t[i][1]; d[2] = t[i][2]; d[3] = t[i][3]; }
    asm volatile("s_waitcnt lgkmcnt(0)" ::: "memory");
    const int c = lane & 7;
#pragma unroll
    for (int j = 0; j < 4; ++j) { const int n = (lane >> 3) + 8 * j; const LAS float* s = scr + (8 * c) * 33 + n;
        u32x4 o; o.x = pk2(s[0 * 33], s[1 * 33]); o.y = pk2(s[2 * 33], s[3 * 33]); o.z = pk2(s[4 * 33], s[5 * 33]); o.w = pk2(s[6 * 33], s[7 * 33]);
        *(u32x4*)(WT + (size_t)(n0 + n) * ldt + col_off + k0 + 8 * c) = o; }
    asm volatile("s_waitcnt lgkmcnt(0)" ::: "memory");
}
__device__ __forceinline__ const float* p0_src_row(const Args& a, int row) { return row < MP ? a.x_prompt + (size_t)row * DM : (row < MT ? a.x_sample + (size_t)(row - MP) * DM : a.mem + (size_t)(row - MT) * DM); }
__device__ __forceinline__ void rms_rows2_to_bf16(const float* x0, const float* x1, const float* g0, const float* g1, bf16_t* o0, bf16_t* o1, int lane) {
    const f32x4* xr0 = (const f32x4*)x0 + lane; const f32x4* xr1 = (const f32x4*)x1 + lane;
    f32x4 v[2][4]; float s0 = 0.f, s1 = 0.f;
#pragma unroll
    for (int j = 0; j < 4; ++j) { v[0][j] = __builtin_nontemporal_load(xr0 + 64 * j); v[1][j] = __builtin_nontemporal_load(xr1 + 64 * j); }
#pragma unroll
    for (int j = 0; j < 4; ++j) { s0 += (v[0][j][0] * v[0][j][0] + v[0][j][1] * v[0][j][1]) + (v[0][j][2] * v[0][j][2] + v[0][j][3] * v[0][j][3]);
                                  s1 += (v[1][j][0] * v[1][j][0] + v[1][j][1] * v[1][j][1]) + (v[1][j][2] * v[1][j][2] + v[1][j][3] * v[1][j][3]); }
    const float r0 = 1.0f / sqrtf(wave_sum(s0) * (1.0f / DM) + EPS), r1 = 1.0f / sqrtf(wave_sum(s1) * (1.0f / DM) + EPS);
    u32x2* p0 = (u32x2*)o0 + lane; u32x2* p1 = (u32x2*)o1 + lane;
#pragma unroll
    for (int j = 0; j < 4; ++j) { const f32x4 ga = ((const f32x4*)g0 + lane)[64 * j], gb = ((const f32x4*)g1 + lane)[64 * j]; u32x2 w;
        w.x = pk2(v[0][j][0] * r0 * ga[0], v[0][j][1] * r0 * ga[1]); w.y = pk2(v[0][j][2] * r0 * ga[2], v[0][j][3] * r0 * ga[3]); p0[64 * j] = w;
        w.x = pk2(v[1][j][0] * r1 * gb[0], v[1][j][1] * r1 * gb[1]); w.y = pk2(v[1][j][2] * r1 * gb[2], v[1][j][3] * r1 * gb[3]); p1[64 * j] = w; }
}
__device__ __forceinline__ void p0_prologue(const Args& a, LAS unsigned char* lds, int tid, int G) {
    const int wave = tid >> 6, lane = tid & 63;
    LAS float* scr = (LAS float*)(lds + wave * 16384);
    const int gw = blockIdx.x * 8 + wave, NGW = G * 8;
    const int gt = blockIdx.x * 512 + tid, NGT = G * 512;
    bf16_t* WinT = (bf16_t*)(a.ws + WS_WIN); bf16_t* WoT = (bf16_t*)(a.ws + WS_WO); bf16_t* WupT = (bf16_t*)(a.ws + WS_WUP); bf16_t* WdnT = (bf16_t*)(a.ws + WS_WDN); bf16_t* WbrT = (bf16_t*)(a.ws + WS_WBR);
    bf16_t* VTB = (bf16_t*)((unsigned char*)a.out + OS_VTB); bf16_t* KB = (bf16_t*)((unsigned char*)a.out + OS_KB);
    constexpr int I_IN = 16 * 144, I_KV = 16 * 16, I_O = 16 * 32, I_UP = 16 * 128, I_DN = 64 * 32, I_A = 8 * 32, I_C = 4 * 32, I_V = 128 * 32;
    constexpr int NITEMS = I_IN + I_KV + I_O + I_A + I_C + I_V;
    for (int it = gw; it < NITEMS; it += NGW) {
        int r = it;
        if (r < I_IN) { tr_item(a.w_in, DIN, WinT, 1024, 0, nullptr, scr, r, lane); continue; } r -= I_IN;
        if (r < I_KV) { tr_item(a.w_kv, 512, WinT + (size_t)4608 * 1024, 1024, 0, nullptr, scr, r, lane); continue; } r -= I_KV;
        if (r < I_O) { tr_item(a.w_o, 1024, WoT, 1024, 0, nullptr, scr, r, lane); continue; } r -= I_O;
        if (r < I_A) { tr_item(a.w_out_a, 1024, WbrT, 1024, 0, nullptr, scr, r, lane); continue; } r -= I_A;
        if (r < I_C) { tr_item(a.w_out_c, 1024, WbrT, 1024, 768, nullptr, scr, r, lane); continue; } r -= I_C;
        { const int b = r >> 5; tr_item(a.cache_v + (size_t)b * 65536, 256, VTB + (size_t)(8 + b) * 65536, 256, 0, nullptr, scr, r & 31, lane); }
    }
    for (int idx = gt; idx < 256 * 1024; idx += NGT) { const int n = idx & 1023, k = idx >> 10, g = k >> 6, kk = k & 63; float s = 0.f;
        const float* wp = a.w_pool + g * 4096 + kk * 64; const float* sc = a.pool_scale + g * 64; const float* wb = a.w_out_b + (size_t)(g * 64) * 1024 + n;
#pragma unroll 32
        for (int e = 0; e < 64; ++e) s += wp[e] * sc[e] * wb[(size_t)e * 1024];
        WbrT[(size_t)n * 1024 + 512 + k] = (bf16_t)f2bf(s); }
    bf16_t* XN = (bf16_t*)(a.ws + WS_XN);
    for (int r2 = gw; r2 < (MT + MKV) / 2; r2 += NGW) { const int row = 2 * r2;
        rms_rows2_to_bf16(p0_src_row(a, row), p0_src_row(a, row + 1), row < MT ? a.g_mix : a.g_mem, row < MT ? a.g_mix : a.g_mem, XN + (size_t)row * DM, XN + (size_t)(row + 1) * DM, lane); }
    bf16_t* WsB = (bf16_t*)(a.ws + WS_WSB);
    for (int idx = gt; idx < 131072; idx += NGT) { const int e = idx & 65535, g = e >> 14, r = (e >> 7) & 127, c = e & 127; float v;
        if (idx < 65536) v = c <= r ? a.w_s[e] : 0.f;
        else v = ((r >> 3) == (c >> 3) && (c & 7) <= (r & 7)) ? a.w_s[g * 16384 + (r & 7) * 128 + (c & 7)] : 0.f;
        WsB[idx] = (bf16_t)f2bf(v); }
}

__device__ __forceinline__ void p0_deferred(const Args& a, LAS unsigned char* lds, int tid, int G) {
    const int wave = tid >> 6, lane = tid & 63;
    LAS float* scr = (LAS float*)(lds + wave * 16384);
    const int nc = G, cc = (int)blockIdx.x;
    bf16_t* WupT = (bf16_t*)(a.ws + WS_WUP); bf16_t* WdnT = (bf16_t*)(a.ws + WS_WDN);
    for (int it = cc * 8 + wave; it < 4096; it += nc * 8) {
        if (it < 2048) tr_item(a.w_up, DFF, WupT, 1024, 0, a.g_ffn, scr, it, lane);
        else tr_item(a.w_down, 1024, WdnT, 4096, 0, nullptr, scr, it - 2048, lane);
    }
}

__device__ __forceinline__ void p2a_unit(const Args& a, LAS unsigned char* lds, int c, int tid) {
    const int w = __builtin_amdgcn_readfirstlane(tid >> 6), l = tid & 63;
    bf16_t* Z = (bf16_t*)(a.ws + WS_Z);
    const int row0 = c * 128;
    const int g = w >> 1, ih = w & 1, fr = l & 15, fq = l >> 4;
    const bf16_t* Wg = (const bf16_t*)(a.ws + WS_WSB) + (c >= 128 ? 65536 : 0) + g * 16384;
    __syncthreads();
    u32x4 v[2][8];
#pragma unroll
    for (int rr = 0; rr < 2; ++rr) { const u32x4* src = (const u32x4*)(Z + (size_t)(row0 + 2 * l + rr) * DIN + 512 + 64 * w);
#pragma unroll
        for (int e = 0; e < 8; ++e) v[rr][e] = src[e]; }
    LAS f32x2* ST = (LAS f32x2*)(lds + 139264);
#pragma unroll
    for (int rr = 0; rr < 2; ++rr) { float s = 0.f, q = 0.f;
#pragma unroll
        for (int e = 0; e < 8; ++e)
#pragma unroll
            for (int d = 0; d < 4; ++d) { const float x0 = bf_lo(v[rr][e][d]), x1 = bf_hi(v[rr][e][d]); s += x0 + x1; q += x0 * x0 + x1 * x1; }
        ST[(2 * l + rr) * 8 + w] = (f32x2){s, q}; }
    __syncthreads();
    float mean[2], rstd[2];
#pragma unroll
    for (int rr = 0; rr < 2; ++rr) { float s = 0.f, q = 0.f;
#pragma unroll
        for (int k = 0; k < 8; ++k) { const f32x2 t = ST[(2 * l + rr) * 8 + k]; s += t[0]; q += t[1]; }
        mean[rr] = s * (1.0f / 512.0f); const float var = fmaxf(q * (1.0f / 512.0f) - mean[rr] * mean[rr], 0.f); rstd[rr] = 1.0f / sqrtf(var + EPS); }
    const bool wout = (c >= 128) || ((c & 15) == 15);
    float* op = c >= 128 ? a.out + O_CVS + (size_t)((c - 128) * 128 + 2 * l) * 512 : a.out + O_CVP + (size_t)((c >> 4) * 128 + 2 * l) * 512;
#pragma unroll
    for (int e = 0; e < 8; ++e) { float y[2][8];
#pragma unroll
        for (int d = 0; d < 4; ++d) { const int ch = 64 * w + 8 * e + 2 * d; const float g0 = a.g_v[ch], g1 = a.g_v[ch + 1], b0 = a.b_v[ch], b1 = a.b_v[ch + 1];
            y[0][2 * d] = (bf_lo(v[0][e][d]) - mean[0]) * rstd[0] * g0 + b0; y[0][2 * d + 1] = (bf_hi(v[0][e][d]) - mean[0]) * rstd[0] * g1 + b1;
            y[1][2 * d] = (bf_lo(v[1][e][d]) - mean[1]) * rstd[1] * g0 + b0; y[1][2 * d + 1] = (bf_hi(v[1][e][d]) - mean[1]) * rstd[1] * g1 + b1;
            *(LAS unsigned*)(lds + ch * 272 + 4 * l) = pk2(y[0][2 * d], y[1][2 * d]);
            *(LAS unsigned*)(lds + (ch + 1) * 272 + 4 * l) = pk2(y[0][2 * d + 1], y[1][2 * d + 1]); }
        if (wout) {
#pragma unroll
            for (int rr = 0; rr < 2; ++rr) { float* o = op + rr * 512 + 64 * w + 8 * e; *(f32x4*)o = (f32x4){y[rr][0], y[rr][1], y[rr][2], y[rr][3]}; *(f32x4*)(o + 4) = (f32x4){y[rr][4], y[rr][5], y[rr][6], y[rr][7]}; } }
    }
    bf16x8 wf[4][4];
#pragma unroll
    for (int mt = 0; mt < 4; ++mt)
#pragma unroll
        for (int ks = 0; ks < 4; ++ks) wf[mt][ks] = *(const bf16x8*)(Wg + (64 * ih + 16 * mt + fr) * 128 + 32 * ks + 8 * fq);
    __syncthreads();
    const int nks = ih ? 4 : 2;
    for (int np = 0; np < 2; ++np) {
        u32x2 uu[4][4];
#pragma unroll
        for (int mt = 0; mt < 4; ++mt)
#pragma unroll
            for (int nt = 0; nt < 4; ++nt) uu[mt][nt] = *(const u32x2*)(Z + (size_t)(row0 + 64 * ih + 16 * mt + fr) * DIN + g * 128 + np * 64 + nt * 16 + 4 * fq);
        f32x4 acc[4][4];
#pragma unroll
        for (int i = 0; i < 4; ++i)
#pragma unroll
            for (int j = 0; j < 4; ++j) acc[i][j] = (f32x4){0.f, 0.f, 0.f, 0.f};
#pragma unroll
        for (int ks = 0; ks < 4; ++ks) if (ks < nks) {
            bf16x8 vf[4];
#pragma unroll
            for (int nt = 0; nt < 4; ++nt) vf[nt] = *(const LAS bf16x8*)(lds + (g * 128 + np * 64 + nt * 16 + fr) * 272 + (32 * ks + 8 * fq) * 2);
#pragma unroll
            for (int mt = 0; mt < 4; ++mt)
#pragma unroll
                for (int nt = 0; nt < 4; ++nt) acc[mt][nt] = __builtin_amdgcn_mfma_f32_16x16x32_bf16(vf[nt], wf[mt][ks], acc[mt][nt], 0, 0, 0);
        }
#pragma unroll
        for (int mt = 0; mt < 4; ++mt) { const int i = 64 * ih + 16 * mt + fr; const float bias = a.b_s[g * 128 + (c >= 128 ? (i & 7) : i)];
#pragma unroll
            for (int nt = 0; nt < 4; ++nt) { bf16_t* up = Z + (size_t)(row0 + i) * DIN + g * 128 + np * 64 + nt * 16 + 4 * fq;
                const u32x2 u2 = uu[mt][nt]; u32x2 o;
                o.x = pk2(bf_lo(u2.x) * (acc[mt][nt][0] + bias), bf_hi(u2.x) * (acc[mt][nt][1] + bias));
                o.y = pk2(bf_lo(u2.y) * (acc[mt][nt][2] + bias), bf_hi(u2.y) * (acc[mt][nt][3] + bias));
                *(u32x2*)up = o; } }
    }
}
template <int WIN, bool SAMPLE>
__device__ __forceinline__ void p2b_rows(const Args& a, const float* P, bf16_t* Z, int grow0, int ch) {
#pragma unroll 1
    for (int r4 = 0; r4 < 32; r4 += 4) {
        float v[4][WIN];
#pragma unroll
        for (int i = 0; i < 4; ++i) { const int grow = grow0 + r4 + i;
            if (!SAMPLE) { const int t = grow & 2047;
#pragma unroll
                for (int k = 0; k < WIN; ++k) v[i][k] = (t - k >= 0) ? P[(size_t)(grow - k) * 256 + ch] : 0.f;
            } else { const int sr = grow - MP, b = sr >> 3, t = sr & 7;
#pragma unroll
                for (int k = 0; k < WIN; ++k) v[i][k] = (t - k >= 0) ? P[(size_t)(grow - k) * 256 + ch] : a.state_pool[((size_t)b * 15 + 15 + t - k) * 256 + ch];
            } }
#pragma unroll
        for (int i = 0; i < 4; ++i) { const int grow = grow0 + r4 + i; float sum = 0.f;
#pragma unroll
            for (int k = 0; k < WIN; ++k) sum += v[i][k];
            float inv = 1.0f / (float)WIN;
            if (!SAMPLE) { const int t = grow & 2047; if (t + 1 < WIN) inv = 1.0f / (float)(t + 1); }
            Z[(size_t)grow * DIN + 1024 + ch] = (bf16_t)f2bf(sum * inv - v[i][0]); }
    }
}
template <int WIN>
__device__ __forceinline__ void p2b_rows_prompt(const float* P, bf16_t* Z, int grow0, int ch) {
    const int t0 = grow0 & 2047;
    float x[32 + WIN - 1];
#pragma unroll
    for (int j = 0; j < 32 + WIN - 1; ++j) { const int d = j - (WIN - 1); x[j] = (t0 + d >= 0) ? P[(size_t)(grow0 + d) * 256 + ch] : 0.f; }
    float sum = 0.f;
#pragma unroll
    for (int j = 0; j < WIN; ++j) sum += x[j];
#pragma unroll
    for (int i = 0; i < 32; ++i) {
        if (i > 0) sum += x[i + WIN - 1] - x[i - 1];
        const int t = t0 + i; const float inv = (t + 1 < WIN) ? 1.0f / (float)(t + 1) : 1.0f / (float)WIN;
        Z[(size_t)(grow0 + i) * DIN + 1024 + ch] = (bf16_t)f2bf(sum * inv - x[i + WIN - 1]);
    }
}
template <int WIN>
__device__ __forceinline__ void p2b_rows_sample(const Args& a, const float* P, bf16_t* Z, int grow0, int ch) {
    float x[4][8 + WIN - 1];
#pragma unroll
    for (int q = 0; q < 4; ++q) { const int b = (grow0 - MP) / 8 + q;
#pragma unroll
        for (int j = 0; j < 8 + WIN - 1; ++j) { const int d = j - (WIN - 1);
            x[q][j] = d >= 0 ? P[(size_t)(grow0 + 8 * q + d) * 256 + ch] : a.state_pool[((size_t)b * 15 + 15 + d) * 256 + ch]; } }
#pragma unroll
    for (int q = 0; q < 4; ++q) { float sum = 0.f;
#pragma unroll
        for (int j = 0; j < WIN; ++j) sum += x[q][j];
#pragma unroll
        for (int i = 0; i < 8; ++i) { if (i > 0) sum += x[q][i + WIN - 1] - x[q][i - 1];
            Z[(size_t)(grow0 + 8 * q + i) * DIN + 1024 + ch] = (bf16_t)f2bf(sum * (1.0f / (float)WIN) - x[q][i + WIN - 1]); } }
}
__device__ __forceinline__ void p2b_unit(const Args& a, int u, int tid) {
    bf16_t* Z = (bf16_t*)(a.ws + WS_Z);
    const float* P = (const float*)((const unsigned char*)a.out + OS_P);
    const int ch = tid & 255, grow0 = u * 64 + (tid >> 8) * 32, gi = __builtin_amdgcn_readfirstlane(ch >> 6);
    if (grow0 < MP) { if (gi == 0) p2b_rows_prompt<2>(P, Z, grow0, ch); else if (gi == 1) p2b_rows_prompt<4>(P, Z, grow0, ch); else if (gi == 2) p2b_rows_prompt<8>(P, Z, grow0, ch); else p2b_rows_prompt<16>(P, Z, grow0, ch); }
    else { if (gi == 0) p2b_rows_sample<2>(a, P, Z, grow0, ch); else if (gi == 1) p2b_rows_sample<4>(a, P, Z, grow0, ch); else if (gi == 2) p2b_rows_sample<8>(a, P, Z, grow0, ch); else p2b_rows_sample<16>(a, P, Z, grow0, ch); }
}
__device__ __forceinline__ void attn_wave(const Args& a, int qrow0, int valid, int kvb, int h, int lane) {
    bf16_t* Z = (bf16_t*)(a.ws + WS_Z);
    const bf16_t* KB = (const bf16_t*)((const unsigned char*)a.out + OS_KB) + (size_t)kvb * 65536 + h * 64;
    const bf16_t* VT = (const bf16_t*)((const unsigned char*)a.out + OS_VTB) + (size_t)kvb * 65536 + (size_t)(h * 64) * 256;
    const int fr = lane & 15, fq = lane >> 4;
    const int qr = qrow0 + (fr < valid ? fr : valid - 1);
    bf16x8 qf[2];
#pragma unroll
    for (int ks = 0; ks < 2; ++ks) qf[ks] = *(const bf16x8*)(Z + (size_t)qr * DIN + 1280 + h * 64 + 32 * ks + 8 * fq);
    f32x4 s[16];
#pragma unroll
    for (int t = 0; t < 16; ++t) { s[t] = (f32x4){0.f, 0.f, 0.f, 0.f};
        const int key = 32 * (t >> 1) + 8 * (fr >> 2) + 4 * (t & 1) + (fr & 3);
#pragma unroll
        for (int ks = 0; ks < 2; ++ks) { bf16x8 kf;
            if (kvb < 8) kf = *(const bf16x8*)(KB + (size_t)key * 256 + 32 * ks + 8 * fq);
            else { const f32x4* kp = (const f32x4*)(a.cache_k + (size_t)(kvb - 8) * 65536 + (size_t)key * 256 + h * 64 + 32 * ks + 8 * fq); const f32x4 k0 = __builtin_nontemporal_load(kp), k1 = __builtin_nontemporal_load(kp + 1);
                u32x4 kw; kw.x = pk2(k0[0], k0[1]); kw.y = pk2(k0[2], k0[3]); kw.z = pk2(k1[0], k1[1]); kw.w = pk2(k1[2], k1[3]); kf = __builtin_bit_cast(bf16x8, kw); }
            s[t] = __builtin_amdgcn_mfma_f32_16x16x32_bf16(kf, qf[ks], s[t], 0, 0, 0); } }
    float mx = -3.0e38f;
#pragma unroll
    for (int t = 0; t < 16; ++t) mx = fmaxf(mx, fmaxf(fmaxf(s[t][0], s[t][1]), fmaxf(s[t][2], s[t][3])));
    mx = fmaxf(mx, __shfl_xor(mx, 16)); mx = fmaxf(mx, __shfl_xor(mx, 32));
    const float sc = 0.125f * 1.4426950409f; float sum = 0.f;
#pragma unroll
    for (int t = 0; t < 16; ++t)
#pragma unroll
        for (int e = 0; e < 4; ++e) { const float p = __builtin_amdgcn_exp2f((s[t][e] - mx) * sc); s[t][e] = p; sum += p; }
    sum += __shfl_xor(sum, 16); sum += __shfl_xor(sum, 32);
    const float rs = 1.0f / sum;
    f32x4 o[4];
#pragma unroll
    for (int dt = 0; dt < 4; ++dt) o[dt] = (f32x4){0.f, 0.f, 0.f, 0.f};
#pragma unroll
    for (int sk = 0; sk < 8; ++sk) { u32x4 pw; pw.x = pk2(s[2 * sk][0], s[2 * sk][1]); pw.y = pk2(s[2 * sk][2], s[2 * sk][3]); pw.z = pk2(s[2 * sk + 1][0], s[2 * sk + 1][1]); pw.w = pk2(s[2 * sk + 1][2], s[2 * sk + 1][3]);
        const bf16x8 pf = __builtin_bit_cast(bf16x8, pw);
#pragma unroll
        for (int dt = 0; dt < 4; ++dt) { const bf16x8 vf = *(const bf16x8*)(VT + (size_t)(16 * dt + fr) * 256 + 32 * sk + 8 * fq);
            o[dt] = __builtin_amdgcn_mfma_f32_16x16x32_bf16(vf, pf, o[dt], 0, 0, 0); } }
    if (fr < valid) {
#pragma unroll
        for (int dt = 0; dt < 4; ++dt) { u32x2 w; w.x = pk2(o[dt][0] * rs, o[dt][1] * rs); w.y = pk2(o[dt][2] * rs, o[dt][3] * rs);
            *(u32x2*)(Z + (size_t)(qrow0 + fr) * DIN + 1280 + h * 64 + 16 * dt + 4 * fq) = w; } }
}
__device__ __forceinline__ void attn_block_prompt(const Args& a, LAS unsigned char* lds, int c, int h, int tid) {
    const int w = tid >> 6, lane = tid & 63, fr = lane & 15, fq = lane >> 4, kvb = c >> 4, qrow0 = c * 128 + 16 * w;
    bf16_t* Z = (bf16_t*)(a.ws + WS_Z);
    const bf16_t* KB = (const bf16_t*)((const unsigned char*)a.out + OS_KB) + (size_t)kvb * 65536 + h * 64;
    const bf16_t* VT = (const bf16_t*)((const unsigned char*)a.out + OS_VTB) + (size_t)kvb * 65536 + (size_t)(h * 64) * 256;
    u32x4 kst[4], vst[4];
#pragma unroll
    for (int i = 0; i < 4; ++i) { const int ck = tid + 512 * i;
        kst[i] = *(const u32x4*)(KB + (size_t)(ck >> 3) * 256 + (ck & 7) * 8);
        vst[i] = *(const u32x4*)(VT + (size_t)(ck >> 5) * 256 + (ck & 31) * 8); }
    bf16x8 qf[2];
#pragma unroll
    for (int ks = 0; ks < 2; ++ks) qf[ks] = *(const bf16x8*)(Z + (size_t)(qrow0 + fr) * DIN + 1280 + h * 64 + 32 * ks + 8 * fq);
    __syncthreads();
#pragma unroll
    for (int i = 0; i < 4; ++i) { const int ck = tid + 512 * i;
        *(LAS u32x4*)(lds + (ck >> 3) * 144 + (ck & 7) * 16) = kst[i];
        *(LAS u32x4*)(lds + 36864 + (ck >> 5) * 528 + (ck & 31) * 16) = vst[i]; }
    __syncthreads();
    f32x4 s[16];
#pragma unroll
    for (int t = 0; t < 16; ++t) { s[t] = (f32x4){0.f, 0.f, 0.f, 0.f};
        const int key = 32 * (t >> 1) + 8 * (fr >> 2) + 4 * (t & 1) + (fr & 3);
#pragma unroll
        for (int ks = 0; ks < 2; ++ks) { const bf16x8 kf = *(const LAS bf16x8*)(lds + key * 144 + (32 * ks + 8 * fq) * 2);
            s[t] = __builtin_amdgcn_mfma_f32_16x16x32_bf16(kf, qf[ks], s[t], 0, 0, 0); } }
    float mx = -3.0e38f;
#pragma unroll
    for (int t = 0; t < 16; ++t) mx = fmaxf(mx, fmaxf(fmaxf(s[t][0], s[t][1]), fmaxf(s[t][2], s[t][3])));
    mx = fmaxf(mx, __shfl_xor(mx, 16)); mx = fmaxf(mx, __shfl_xor(mx, 32));
    const float sc = 0.125f * 1.4426950409f; float sum = 0.f;
#pragma unroll
    for (int t = 0; t < 16; ++t)
#pragma unroll
        for (int e = 0; e < 4; ++e) { const float pe = __builtin_amdgcn_exp2f((s[t][e] - mx) * sc); s[t][e] = pe; sum += pe; }
    sum += __shfl_xor(sum, 16); sum += __shfl_xor(sum, 32);
    const float rs = 1.0f / sum;
    f32x4 o[4];
#pragma unroll
    for (int dt = 0; dt < 4; ++dt) o[dt] = (f32x4){0.f, 0.f, 0.f, 0.f};
#pragma unroll
    for (int sk = 0; sk < 8; ++sk) { u32x4 pw; pw.x = pk2(s[2 * sk][0], s[2 * sk][1]); pw.y = pk2(s[2 * sk][2], s[2 * sk][3]); pw.z = pk2(s[2 * sk + 1][0], s[2 * sk + 1][1]); pw.w = pk2(s[2 * sk + 1][2], s[2 * sk + 1][3]);
        const bf16x8 pf = __builtin_bit_cast(bf16x8, pw);
#pragma unroll
        for (int dt = 0; dt < 4; ++dt) { const bf16x8 vf = *(const LAS bf16x8*)(lds + 36864 + (16 * dt + fr) * 528 + (32 * sk + 8 * fq) * 2);
            o[dt] = __builtin_amdgcn_mfma_f32_16x16x32_bf16(vf, pf, o[dt], 0, 0, 0); } }
#pragma unroll
    for (int dt = 0; dt < 4; ++dt) { u32x2 wv; wv.x = pk2(o[dt][0] * rs, o[dt][1] * rs); wv.y = pk2(o[dt][2] * rs, o[dt][3] * rs);
        *(u32x2*)(Z + (size_t)(qrow0 + fr) * DIN + 1280 + h * 64 + 16 * dt + 4 * fq) = wv; }
}
__device__ __forceinline__ void p2_mixers(const Args& a, LAS unsigned char* lds, int tid, int G) {
    const int w = tid >> 6, lane = tid & 63;
    {
        const float* P = (const float*)((const unsigned char*)a.out + OS_P);
        for (int idx = blockIdx.x * 512 + tid; idx < 30720 + 491520; idx += G * 512) {
            if (idx < 30720) { const int b = idx / 3840, rem = idx % 3840; a.out[O_PP + idx] = P[(size_t)(b * 2048 + 2033) * 256 + rem]; }
            else { const int j = idx - 30720, b = j / 3840, rem = j % 3840, s = rem >> 8, cc = rem & 255;
                a.out[O_PS + j] = s < 7 ? a.state_pool[((size_t)b * 15 + 8 + s) * 256 + cc] : P[(size_t)(MP + b * 8 + (s - 7)) * 256 + cc]; } }
    }
    for (int it = blockIdx.x; it < 136; it += G) p2a_unit(a, lds, it, tid);
    { int u0 = ((int)blockIdx.x - 136) % G; if (u0 < 0) u0 += G;
      for (int u = u0; u < 272; u += G) p2b_unit(a, u, tid); }
    { int u0 = ((int)blockIdx.x - 408) % G; if (u0 < 0) u0 += G;
      for (int idx = u0; idx < 576; idx += G) {
        if (idx < 512) { attn_block_prompt(a, lds, idx >> 2, idx & 3, tid); }
        else { const int batch = 2 * (idx - 512) + (w >> 2); attn_wave(a, MP + 8 * batch, 8, 8 + batch, w & 3, lane); } } }
}
__device__ __forceinline__ void p7_final(const Args& a, LAS unsigned char* lds, int tid, int G) {
    const int wave = tid >> 6, lane = tid & 63;
    const f32x4* gr = (const f32x4*)a.g_final + lane;
    const bool split = (G == 256);
    for (int r2 = blockIdx.x * 8 + wave; r2 < (split ? 0 : MT) / 2; r2 += G * 8) {
        f32x4* xa = (f32x4*)(a.out + (size_t)(2 * r2) * DM) + lane; f32x4* xb = xa + DM / 4; f32x4 v[2][4]; float s0 = 0.f, s1 = 0.f;
#pragma unroll
        for (int j = 0; j < 4; ++j) { v[0][j] = xa[64 * j]; v[1][j] = xb[64 * j]; }
#pragma unroll
        for (int j = 0; j < 4; ++j) { s0 += (v[0][j][0] * v[0][j][0] + v[0][j][1] * v[0][j][1]) + (v[0][j][2] * v[0][j][2] + v[0][j][3] * v[0][j][3]);
                                      s1 += (v[1][j][0] * v[1][j][0] + v[1][j][1] * v[1][j][1]) + (v[1][j][2] * v[1][j][2] + v[1][j][3] * v[1][j][3]); }
        const float r0 = 1.0f / sqrtf(wave_sum(s0) * (1.0f / DM) + EPS), r1 = 1.0f / sqrtf(wave_sum(s1) * (1.0f / DM) + EPS);
#pragma unroll
        for (int j = 0; j < 4; ++j) { const f32x4 gg = gr[64 * j]; xa[64 * j] = v[0][j] * r0 * gg; xb[64 * j] = v[1][j] * r1 * gg; }
    }
    if (split) {
        LAS float* red = (LAS float*)lds;
        const int rr = tid >> 7, t7 = tid & 127, c8 = t7 * 8;
        const f32x4 g0 = *(const f32x4*)(a.g_final + c8), g1 = *(const f32x4*)(a.g_final + c8 + 4);
        for (int sr0 = blockIdx.x * 4; sr0 < MS; sr0 += G * 4) { const int sr = sr0 + rr;
            const u32x4 xw = *(const u32x4*)((const bf16_t*)(a.ws + WS_X1B_HI) + (size_t)(MP + sr - X1B_SPLIT * 256) * DM + c8);
            f32x4 pv[16][2];
#pragma unroll
            for (int k = 0; k < 16; ++k) { const f32x4* pp = (const f32x4*)(part_base(a.ws, k) + (size_t)sr * DM + c8); pv[k][0] = pp[0]; pv[k][1] = pp[1]; }
            f32x4 v0 = (f32x4){bf_lo(xw.x), bf_hi(xw.x), bf_lo(xw.y), bf_hi(xw.y)}, v1 = (f32x4){bf_lo(xw.z), bf_hi(xw.z), bf_lo(xw.w), bf_hi(xw.w)};
#pragma unroll
            for (int k = 0; k < 16; ++k) { v0 += pv[k][0]; v1 += pv[k][1]; }
            const float ws_ = wave_sum((v0[0] * v0[0] + v0[1] * v0[1]) + (v0[2] * v0[2] + v0[3] * v0[3]) + (v1[0] * v1[0] + v1[1] * v1[1]) + (v1[2] * v1[2] + v1[3] * v1[3]));
            __syncthreads();
            if (lane == 0) red[wave] = ws_;
            __syncthreads();
            const float rstd = 1.0f / sqrtf((red[2 * rr] + red[2 * rr + 1]) * (1.0f / DM) + EPS);
            float* xo = a.out + (size_t)(MP + sr) * DM + c8;
            __builtin_nontemporal_store(v0 * rstd * g0, (f32x4*)xo); __builtin_nontemporal_store(v1 * rstd * g1, (f32x4*)(xo + 4));
        }
    }
}

#define XB_TMO      128
#define XB_XCNT(j)  (256  + 64 * (j))
#define XB_XSUB(j)  (1280 + 64 * (j))
#define XB_XGEN(j)  (2304 + 64 * (j))
#define XB_TOP      3328
#define XB_TOPGEN   3392
#define XCD_BAR_WORDS 3456
#define XB_SPIN_CAP (1u << 18)
__device__ __forceinline__ unsigned xb_ld(unsigned* p)              { return __hip_atomic_load(p, __ATOMIC_RELAXED, __HIP_MEMORY_SCOPE_AGENT); }
__device__ __forceinline__ unsigned xb_add(unsigned* p, unsigned v) { return __hip_atomic_fetch_add(p, v, __ATOMIC_RELAXED, __HIP_MEMORY_SCOPE_AGENT); }
__device__ __forceinline__ unsigned xb_xcc_id() { return (unsigned)__builtin_amdgcn_s_getreg((3 << 11) | 20) & 0xFu; }
#define XB_SPIN(cond, bar) do { unsigned _sp = 0; while (cond) { __builtin_amdgcn_s_sleep(1); \
    if ((++_sp & 255u) == 0u) { if (xb_ld(&(bar)[XB_TMO])) break; if (_sp > XB_SPIN_CAP) { atomicAdd(&(bar)[XB_TMO], 1u); break; } } } } while (0)
struct XcdBarrier { unsigned* bar; unsigned x; volatile LAS unsigned* st; };
__device__ __forceinline__ XcdBarrier xcd_barrier_post(unsigned* bar, volatile LAS unsigned* st, int wave_s) {
    XcdBarrier b; b.bar = bar; b.x = xb_xcc_id(); b.st = st;
    if (wave_s == 0 && lane_id() == 0) (void)xb_add(&bar[XB_XCNT(b.x)], 1u);
    return b;
}
__device__ __forceinline__ void xcd_barrier_complete(unsigned* bar, unsigned x, unsigned& nloc, unsigned& nx) {
    const unsigned G = gridDim.x * gridDim.y * gridDim.z;
    unsigned sum, cnt, mine, sp = 0u;
    for (;;) {
        sum = 0u; cnt = 0u; mine = 0u;
#pragma unroll
        for (unsigned j = 0; j < 16; ++j) { const unsigned c = xb_ld(&bar[XB_XCNT(j)]); sum += c; cnt += (c > 0u) ? 1u : 0u; mine = (j == x) ? c : mine; }
        if (sum == G) break;
        __builtin_amdgcn_s_sleep(1);
        if ((++sp & 255u) == 0u) { if (xb_ld(&bar[XB_TMO])) break; if (sp > XB_SPIN_CAP) { atomicAdd(&bar[XB_TMO], 1u); break; } }
    }
    nloc = mine > 0u ? mine : 1u; nx = cnt > 0u ? cnt : 1u;
}
__device__ __forceinline__ void xcd_barrier(const XcdBarrier& b, int wave_s) {
    asm volatile("s_waitcnt vmcnt(0)" ::: "memory");
    __syncthreads();
    if (wave_s == 0 && lane_id() == 0) {
        unsigned* bar = b.bar;
        __builtin_amdgcn_s_waitcnt(0);
        unsigned nloc = b.st[0], nx = b.st[1];
        if (nloc == 0u) { xcd_barrier_complete(bar, b.x, nloc, nx); b.st[0] = nloc; b.st[1] = nx; }
        const unsigned old = xb_add(&bar[XB_XSUB(b.x)], 1u);
        const unsigned gen = old / nloc;
        if (old + 1u == (gen + 1u) * nloc) {
            __builtin_amdgcn_fence(__ATOMIC_RELEASE, "agent");
            asm volatile("s_waitcnt vmcnt(0)" ::: "memory");
            const unsigned og = xb_add(&bar[XB_TOP], 1u);
            const unsigned tg = og / nx;
            if (og + 1u == (tg + 1u) * nx) xb_add(&bar[XB_TOPGEN], 1u);
            else XB_SPIN(xb_ld(&bar[XB_TOPGEN]) == tg, bar);
            __builtin_amdgcn_fence(__ATOMIC_ACQUIRE, "agent");
            xb_add(&bar[XB_XGEN(b.x)], 1u);
            asm volatile("s_waitcnt vmcnt(0)" ::: "memory");
        } else {
            XB_SPIN(xb_ld(&bar[XB_XGEN(b.x)]) == gen, bar);
            __builtin_amdgcn_fence(__ATOMIC_ACQUIRE, "agent");
            asm volatile("s_waitcnt vmcnt(0)" ::: "memory");
        }
    }
    __syncthreads();
}

__device__ __forceinline__ void panel_signal(unsigned* cnt, int wave_s) {
    asm volatile("s_waitcnt vmcnt(0)" ::: "memory");
    __syncthreads();
    if (wave_s == 0 && lane_id() == 0) (void)xb_add(cnt, 1u);
}
__device__ __forceinline__ void panel_wait(unsigned* cnt, unsigned want, unsigned* bar, int wave_s) {
    if (wave_s == 0 && lane_id() == 0) { XB_SPIN(xb_ld(cnt) < want, bar); __builtin_amdgcn_fence(__ATOMIC_ACQUIRE, "agent"); asm volatile("s_waitcnt vmcnt(0)" ::: "memory"); }
    __syncthreads();
}

template <bool P3S>
__device__ __forceinline__ void mini_block(const Args& a, LAS unsigned char* lds, int blk, int tid) {
    const int w = tid >> 6, lane = tid & 63, fr = lane & 15, fq = lane >> 4, rb = blk >> 4, cb = blk & 15;
    const int k0 = 128 * w;
    const bf16_t* Ab; int lda, acol;
    if (P3S) { Ab = (const bf16_t*)(a.ws + WS_Z); lda = DIN; acol = k0 + (k0 >= 512 ? 512 : 0); }
    else { Ab = (const bf16_t*)(a.ws + WS_XN); lda = DM; acol = k0; }
    const bf16_t* Bb = (const bf16_t*)(a.ws + (P3S ? WS_WBR : WS_WO));
    bf16x8 af[4][4], bf[4][4];
#pragma unroll
    for (int t = 0; t < 4; ++t)
#pragma unroll
        for (int ks = 0; ks < 4; ++ks) { af[t][ks] = *(const bf16x8*)(Ab + (size_t)(MP + 64 * rb + 16 * t + fr) * lda + acol + 32 * ks + 8 * fq);
                                         bf[t][ks] = *(const bf16x8*)(Bb + (size_t)(64 * cb + 16 * t + fr) * 1024 + k0 + 32 * ks + 8 * fq); }
    f32x4 acc[4][4];
#pragma unroll
    for (int mt = 0; mt < 4; ++mt)
#pragma unroll
        for (int nt = 0; nt < 4; ++nt) acc[mt][nt] = (f32x4){0.f, 0.f, 0.f, 0.f};
#pragma unroll
    for (int ks = 0; ks < 4; ++ks)
#pragma unroll
        for (int mt = 0; mt < 4; ++mt)
#pragma unroll
            for (int nt = 0; nt < 4; ++nt) acc[mt][nt] = __builtin_amdgcn_mfma_f32_16x16x32_bf16(bf[nt][ks], af[mt][ks], acc[mt][nt], 0, 0, 0);
    LAS float* red = (LAS float*)lds;
    __syncthreads();
#pragma unroll
    for (int mt = 0; mt < 4; ++mt)
#pragma unroll
        for (int nt = 0; nt < 4; ++nt) *(LAS f32x4*)(red + (size_t)((w * 64 + 16 * mt + fr) * 68 + 16 * nt + 4 * fq)) = acc[mt][nt];
    __syncthreads();
    const int r = tid >> 3, c8 = (tid & 7) * 8, row = MP + 64 * rb + r, col = 64 * cb + c8;
    f32x4 s0[3], s1[3];
#pragma unroll
    for (int g = 0; g < 3; ++g) { s0[g] = (f32x4){0.f, 0.f, 0.f, 0.f}; s1[g] = s0[g]; }
#pragma unroll
    for (int ww = 0; ww < 8; ++ww) { const int g = P3S ? (ww < 4 ? 0 : (ww < 6 ? 1 : 2)) : 0; const LAS f32x4* pp = (const LAS f32x4*)(red + (size_t)((ww * 64 + r) * 68 + c8)); s0[g] += pp[0]; s1[g] += pp[1]; }
    if (P3S) {
        bf16_t* MG = (bf16_t*)(a.ws + WS_XN);
        const unsigned char* gp = (const unsigned char*)(a.ws + WS_Z) + (size_t)row * (DIN * 2) + 3072 + col;
        const u32x2 qa = *(const u32x2*)gp, qb = *(const u32x2*)(gp + 1024), qc = *(const u32x2*)(gp + 2048); const float k = 1.0f / 255.0f;
        float m[8];
        m[0] = (s0[0][0] * ub0(qa.x) + s0[1][0] * ub0(qb.x) + s0[2][0] * ub0(qc.x)) * k; m[1] = (s0[0][1] * ub1(qa.x) + s0[1][1] * ub1(qb.x) + s0[2][1] * ub1(qc.x)) * k;
        m[2] = (s0[0][2] * ub2(qa.x) + s0[1][2] * ub2(qb.x) + s0[2][2] * ub2(qc.x)) * k; m[3] = (s0[0][3] * ub3(qa.x) + s0[1][3] * ub3(qb.x) + s0[2][3] * ub3(qc.x)) * k;
        m[4] = (s1[0][0] * ub0(qa.y) + s1[1][0] * ub0(qb.y) + s1[2][0] * ub0(qc.y)) * k; m[5] = (s1[0][1] * ub1(qa.y) + s1[1][1] * ub1(qb.y) + s1[2][1] * ub1(qc.y)) * k;
        m[6] = (s1[0][2] * ub2(qa.y) + s1[1][2] * ub2(qb.y) + s1[2][2] * ub2(qc.y)) * k; m[7] = (s1[0][3] * ub3(qa.y) + s1[1][3] * ub3(qb.y) + s1[2][3] * ub3(qc.y)) * k;
        u32x4 o; o.x = pk2(m[0], m[1]); o.y = pk2(m[2], m[3]); o.z = pk2(m[4], m[5]); o.w = pk2(m[6], m[7]);
        *(u32x4*)(MG + (size_t)row * DM + col) = o;
    } else {
        const f32x4* xp = (const f32x4*)(a.x_sample + (size_t)(row - MP) * DM + col);
        const f32x4 v0 = s0[0] + __builtin_nontemporal_load(xp), v1 = s1[0] + __builtin_nontemporal_load(xp + 1);
        u32x4 o; o.x = pk2(v0[0], v0[1]); o.y = pk2(v0[2], v0[3]); o.z = pk2(v1[0], v1[1]); o.w = pk2(v1[2], v1[3]);
        *(u32x4*)((bf16_t*)(a.ws + WS_X1B_HI) + (size_t)(row - X1B_SPLIT * 256) * DM + col) = o;
        float ss = (v0[0] * v0[0] + v0[1] * v0[1]) + (v0[2] * v0[2] + v0[3] * v0[3]) + (v1[0] * v1[0] + v1[1] * v1[1]) + (v1[2] * v1[2] + v1[3] * v1[3]);
        ss += __shfl_xor(ss, 1); ss += __shfl_xor(ss, 2); ss += __shfl_xor(ss, 4);
        if ((tid & 7) == 0) ((float*)(a.ws + WS_SSP))[(size_t)row * 16 + cb] = ss;
    }
    __syncthreads();
}

__global__ void __launch_bounds__(512, 2) fwd_kernel(Args a) {
    extern __shared__ __attribute__((aligned(16))) unsigned char lds_raw[];
    LAS unsigned char* lds = (LAS unsigned char*)lds_raw;
    cg::grid_group grid = cg::this_grid();
    const int wave_s = __builtin_amdgcn_readfirstlane((int)threadIdx.x >> 6);
#define tid (wave_s * 64 + lane_id())
    const int G = gridDim.x, c = blockIdx.x;
    const int lo = a.ph_lo, hi = a.ph_hi;
#define IN(k) (lo <= (k) && (k) < hi)
#define SEAM(k) do { if (IN(k) && IN((k) + 1)) xcd_barrier(bar, wave_s); } while (0)
    if (tid < 64) ((LAS unsigned*)(lds + 147456))[tid] = 0u;
    __syncthreads();
    const XcdBarrier bar = xcd_barrier_post((unsigned*)a.ws, (volatile LAS unsigned*)(lds + 147456), wave_s);
    if (lo < 0) grid.sync();
    bf16_t* XN = (bf16_t*)(a.ws + WS_XN); bf16_t* Z = (bf16_t*)(a.ws + WS_Z); bf16_t* MG = XN; bf16_t* H = Z; bf16_t* X1Blo = (bf16_t*)(a.ws + WS_X1B_LO); bf16_t* X1Bhi = (bf16_t*)(a.ws + WS_X1B_HI);
    float* SSP = (float*)(a.ws + WS_SSP);
    constexpr int REPS[8] = {1, 1, 1, 1, 1, 1, 1, 1};
    if (IN(0)) { for (int rep = 0; rep < REPS[0]; ++rep) p0_prologue(a, lds, tid, G); } SEAM(0);
    if (IN(1)) { for (int rep = 0; rep < REPS[1]; ++rep) { pg8::Gemm g{XN, (const bf16_t*)(a.ws + WS_WIN), 1024, 1024, nullptr, 1 << 30}; SchedP1 S{G, c};
        EpiP1 E{Z, (float*)((unsigned char*)a.out + OS_P), a.out + O_MK, a.out + O_MV, (bf16_t*)((unsigned char*)a.out + OS_KB), (bf16_t*)((unsigned char*)a.out + OS_VTB)};
        pg8::gemm_phase(lds, g, S, E, wave_s); } } SEAM(1);
    if (IN(2)) { p2_mixers(a, lds, tid, G); } SEAM(2);
    if (IN(3)) {
        unsigned* cnt = (unsigned*)a.ws + 8192;
        const pg8::Gemm g3{Z, (const bf16_t*)(a.ws + WS_WBR), DIN, 1024, nullptr, 1 << 30}; const EpiP3 E3{Z, MG, G != 256};
        const pg8::Gemm g4{MG, (const bf16_t*)(a.ws + WS_WO), 1024, 1024, nullptr, 1 << 30}; const EpiP4 E4{a.x_prompt, a.x_sample, a.out, X1Blo, X1Bhi, SSP, (float*)(a.ws + WS_SSP4), lds};
        if (G == 256) {
            int pm, pn; pg8::tile_map(64, 4, c, pm, pn);
            { SchedOne3 S{pm, pn}; pg8::gemm_phase(lds, g3, S, E3, wave_s); }
            mini_block<true>(a, lds, c, tid);
            xcd_barrier(bar, wave_s);
            { SchedOne S{pm, pn, 16}; pg8::gemm_phase(lds, g4, S, E4, wave_s); }
            mini_block<false>(a, lds, c, tid);
        } else {
            for (int L = c; L < 272; L += G) { int pm, pn; tile272(L, pm, pn); SchedOne3 S{pm, pn}; pg8::gemm_phase(lds, g3, S, E3, wave_s); panel_signal(cnt + 64 * pm, wave_s); }
            int L0 = (c - 16) % G; if (L0 < 0) L0 += G;
            for (int L = L0; L < 272; L += G) { int pm, pn; tile272(L, pm, pn); panel_wait(cnt + 64 * pm, 4u, (unsigned*)a.ws, wave_s); SchedOne S{pm, pn, 16}; pg8::gemm_phase(lds, g4, S, E4, wave_s); }
        }
        p0_deferred(a, lds, tid, G);
    } SEAM(4);
    if (IN(5)) { for (int rep = 0; rep < REPS[5]; ++rep) { pg8::Gemm g{X1Blo, (const bf16_t*)(a.ws + WS_WUP), 1024, 1024, X1Bhi, X1B_SPLIT}; SchedT S{68, 16, 16, G, c}; EpiP5 E{SSP, H, (const float*)(a.ws + WS_SSP4), G == 256 ? 64 : 68}; pg8::gemm_phase(lds, g, S, E, wave_s); } } SEAM(5);
    if (IN(6)) { pg8::Gemm g{H, (const bf16_t*)(a.ws + WS_WDN), DFF, DFF, nullptr, 1 << 30}; SchedP6 S{G, c};
        if (G == 256) { EpiP6F E{a.out, a.ws, X1Blo, X1Bhi, a.out + (size_t)MP * DM  , (unsigned*)a.ws + 8192 + 64 * 68, (unsigned*)a.ws, a.g_final, lds}; pg8::gemm_phase(lds, g, S, E, wave_s); }
        else { EpiP6 E{a.out, a.ws, X1Blo, X1Bhi}; pg8::gemm_phase(lds, g, S, E, wave_s); } } SEAM(6);
    if (IN(7)) { p7_final(a, lds, tid, G); }
#undef IN
#undef SEAM
#undef tid
}

extern "C" void kernel_launch(void* const* d_in, const int* in_sizes, int n_in, void* d_out, int out_size, void* d_ws, size_t ws_size, hipStream_t stream) {
    static int grid = 0;
    if (grid == 0) {
        int dev = 0, cus = 0, per_cu = 0;
        if (n_in != 24 || ws_size < 256 * MiB) { fprintf(stderr, "kernel_launch: unexpected n_in %d / ws %zu\n", n_in, ws_size); grid = -1; return; }
        (void)hipGetDevice(&dev);
        (void)hipDeviceGetAttribute(&cus, hipDeviceAttributeMultiprocessorCount, dev);
        if (hipFuncSetAttribute((const void*)fwd_kernel, hipFuncAttributeMaxDynamicSharedMemorySize, LDS_BYTES) != hipSuccess) fprintf(stderr, "kernel_launch: hipFuncSetAttribute failed\n");
        if (hipOccupancyMaxActiveBlocksPerMultiprocessor(&per_cu, (const void*)fwd_kernel, 512, LDS_BYTES) != hipSuccess || per_cu < 1) per_cu = 1;
        (void)hipGetLastError();
        grid = cus * per_cu;
        if (grid <= 0) grid = 256;
    }
    if (grid < 0) return;
    if (hipMemsetAsync(d_ws, 0, 131072, stream) != hipSuccess) { fprintf(stderr, "kernel_launch: memset failed\n"); return; }
    Args a{};
    const float** pp = (const float**)&a;
    for (int i = 0; i < 24; ++i) pp[i] = (const float*)d_in[i];
    a.out = (float*)d_out; a.ws = (unsigned char*)d_ws; a.ph_lo = 0; a.ph_hi = 8;
    void* args[] = {&a};
    hipError_t e = hipLaunchCooperativeKernel((const void*)fwd_kernel, dim3(grid), dim3(512), args, LDS_BYTES, stream);
    if (e != hipSuccess) fprintf(stderr, "kernel_launch: cooperative launch failed: %s (grid %d)\n", hipGetErrorString(e), grid);
}
```

```cpp
#include <hip/hip_runtime.h>
#include <hip/hip_cooperative_groups.h>
#include <cstdio>
#include <cstdint>
namespace cg = cooperative_groups;

#define LAS __attribute__((address_space(3)))
typedef unsigned short bf16_t;
typedef short bf16x8 __attribute__((ext_vector_type(8)));
typedef float f32x4 __attribute__((ext_vector_type(4)));
typedef float f32x2 __attribute__((ext_vector_type(2)));
typedef unsigned u32x4 __attribute__((ext_vector_type(4)));
typedef unsigned u32x2 __attribute__((ext_vector_type(2)));

constexpr int DM = 1024, MP = 16384, MS = 1024, MT = MP + MS  , DIN = 4608, DFF = 4096;
constexpr int MKV = 2048;
constexpr float EPS = 1e-6f;
constexpr size_t MiB = 1u << 20;
constexpr size_t WS_WIN = 1 * MiB;
constexpr size_t WS_WO = 11 * MiB;
constexpr size_t WS_WUP = 13 * MiB;
constexpr size_t WS_WDN = 21 * MiB;
constexpr size_t WS_WBR = 29 * MiB;
constexpr size_t WS_WSB = 31 * MiB;
constexpr size_t WS_SSP4 = 2 * MiB + 256 * 1024;
constexpr size_t WS_SSP = 1 * MiB;
constexpr size_t WS_XN = 48 * MiB;
constexpr size_t WS_Z = 86 * MiB;
constexpr size_t WS_X1B_LO = 239 * MiB, WS_X1B_HI = 31 * MiB;
constexpr int X1B_SPLIT = 34;
constexpr size_t OS_P = 0;
constexpr size_t OS_KB = 17 * MiB;
constexpr size_t OS_VTB = 34 * MiB;
constexpr size_t O_Y = 0, O_MK = 17825792, O_MV = 18350080, O_PP = 18874368, O_PS = 18905088, O_CVP = 19396608, O_CVS = 19920896;
constexpr int LDS_BYTES = 147456 + 256;

__device__ __forceinline__ unsigned f2bf(float f) { unsigned u = __builtin_bit_cast(unsigned, f); return (u + 0x7fffu + ((u >> 16) & 1u)) >> 16; }
__device__ __forceinline__ unsigned pk2(float lo, float hi) { return f2bf(lo) | (f2bf(hi) << 16); }
__device__ __forceinline__ float bf_lo(unsigned w) { return __builtin_bit_cast(float, w << 16); }
__device__ __forceinline__ float bf_hi(unsigned w) { return __builtin_bit_cast(float, w & 0xffff0000u); }
__device__ __forceinline__ unsigned cvt_pk_bf16(float lo, float hi) { unsigned r; asm volatile("v_cvt_pk_bf16_f32 %0, %1, %2" : "=v"(r) : "v"(lo), "v"(hi)); return r; }
__device__ __forceinline__ float gelu_t(float x) {
    const float y = 0.7978845608f * (x + 0.044715f * x * x * x);
    const float e = __builtin_amdgcn_exp2f(-2.885390082f * y);
    return x * __builtin_amdgcn_rcpf(1.0f + e);
}
__device__ __forceinline__ unsigned gate_q(float x) { const float g = __builtin_amdgcn_rcpf(1.0f + __builtin_amdgcn_exp2f(-1.4426950409f * x)); return (unsigned)fminf(fmaxf(g * 255.0f + 0.5f, 1.0f), 255.0f); }
__device__ __forceinline__ float ub0(unsigned w) { return (float)(w & 0xffu); }
__device__ __forceinline__ float ub1(unsigned w) { return (float)((w >> 8) & 0xffu); }
__device__ __forceinline__ float ub2(unsigned w) { return (float)((w >> 16) & 0xffu); }
__device__ __forceinline__ float ub3(unsigned w) { return (float)(w >> 24); }
__device__ __forceinline__ f32x2 gelu_t2(f32x2 x) {
    const f32x2 x2 = x * x, pch = x2 * 0.0356774081f + 0.7978845608f, t = (pch * x) * (-2.885390082f);
    f32x2 e; e.x = __builtin_amdgcn_exp2f(t.x); e.y = __builtin_amdgcn_exp2f(t.y);
    const f32x2 d = e + 1.0f; f32x2 r; r.x = __builtin_amdgcn_rcpf(d.x); r.y = __builtin_amdgcn_rcpf(d.y);
    return x * r;
}

__device__ __forceinline__ int lane_id() { int l; asm volatile("v_mbcnt_lo_u32_b32 %0, -1, 0\n\tv_mbcnt_hi_u32_b32 %0, -1, %0" : "=v"(l)); return l; }
struct Args {
    const float *x_prompt, *x_sample, *mem, *cache_k, *cache_v, *state_pool;
    const float *g_mix, *w_in, *g_v, *b_v, *w_s, *b_s, *w_pool, *pool_scale, *g_mem, *w_kv;
    const float *w_out_a, *w_out_b, *w_out_c, *w_o, *g_ffn, *w_up, *w_down, *g_final;
    float* out; unsigned char* ws; int ph_lo, ph_hi;
};

namespace pg8 {
constexpr int BM = 256, BK = 64, HALF = 128, HTB = HALF * BK * 2, STAGE_BYTES = 8 * HTB;
__device__ __forceinline__ int lds_byte(int r, int c) { const int st = (r >> 4) * 2 + (c >> 5), rr = r & 15, cc = c & 31, ob = rr * 64 + cc * 2; return st * 1024 + (ob ^ (((ob >> 9) & 1) << 5)); }
__device__ __forceinline__ void stage_rc(int b, int& R, int& C) { const int st = b / 1024, sb = b % 1024, swz = sb ^ (((sb >> 9) & 1) << 5); R = (st >> 1) * 16 + swz / 64; C = (st & 1) * 32 + (swz % 64) / 2; }
__device__ __forceinline__ int perm32(int rho) { const int n = rho >> 4, i = rho & 15; return 8 * (i >> 2) + 4 * n + (i & 3); }

struct Unit { int pm, pn, ka, kb, nt, tag; };
struct Gemm { const bf16_t* A; const bf16_t* Bt; int lda, ldb; const bf16_t* A2; int psplit; };

__device__ __forceinline__ void tile_map(int nM, int nN, int L, int& pm, int& pn) {
    const int nwg = nM * nN; int wgid = L;
    { const int q = nwg / 8, r = nwg % 8, xcd = wgid % 8, off = wgid / 8; wgid = (xcd < r ? xcd * (q + 1) : r * (q + 1) + (xcd - r) * q) + off; }
    const int nig = 8 * nN, gid = wgid / nig, fm = gid * 8, gsz = (nM - fm) < 8 ? (nM - fm) : 8;
    pm = fm + ((wgid % nig) % gsz); pn = (wgid % nig) / gsz;
}

template <class Epi, class Sched>
__device__ __forceinline__ void gemm_phase(LAS unsigned char* lds, const Gemm g, const Sched& S, const Epi& E, int wave_s) {
    const int wid = wave_s, lane = lane_id(), tid = wid * 64 + lane, wr = wid >> 2, wc = wid & 3, fr = lane & 15, fq = lane >> 4;
    unsigned voffA[2], voffB[2];
#pragma unroll
    for (int i = 0; i < 2; ++i) { int R, C; stage_rc(tid * 16 + i * 8192, R, C); const int Rb = (R & ~31) + perm32(R & 31);
        voffA[i] = (unsigned)(R * g.lda + C) * 2u; voffB[i] = (unsigned)(Rb * g.ldb + C) * 2u; }
    const size_t kstep = (size_t)(BK * 2);
    const size_t hstepA = (size_t)HALF * g.lda * 2, hstepB = (size_t)HALF * g.ldb * 2;
    const size_t tstepA = 2 * hstepA, tstepB = 2 * hstepB;
    const unsigned ldsw = (unsigned)wid * 1024u;
    const int aoff = lds_byte(wr * 64 + fr, fq * 8), boff = lds_byte(wc * 32 + fr, fq * 8);
#define PG8_SA(b, h) (((b) * 2 + (h)) * HTB)
#define PG8_SB(b, h) ((4 + (b) * 2 + (h)) * HTB)
#define PG8_STAGE(bufoff, gbase, voff) do { _Pragma("unroll") for (int _i = 0; _i < 2; ++_i) \
        __builtin_amdgcn_global_load_lds((const unsigned*)((const char*)(gbase) + (voff)[_i]), (LAS unsigned*)(lds + (bufoff) + ldsw + _i * 8192), 16, 0, 0); } while (0)
#define PG8_LDA(dst, b, h) do { _Pragma("unroll") for (int m = 0; m < 4; ++m) _Pragma("unroll") for (int k = 0; k < 2; ++k) dst[m][k] = *(const LAS bf16x8*)(lds + PG8_SA(b, h) + aoff + m * 2048 + k * 1024); } while (0)
#define PG8_LDB(dst, b, h) do { _Pragma("unroll") for (int n = 0; n < 2; ++n) _Pragma("unroll") for (int k = 0; k < 2; ++k) dst[n][k] = *(const LAS bf16x8*)(lds + PG8_SB(b, h) + boff + n * 2048 + k * 1024); } while (0)
#define PG8_MMA(ai, bj, At, Bt) do { __builtin_amdgcn_s_setprio(1); _Pragma("unroll") for (int m = 0; m < 4; ++m) _Pragma("unroll") for (int n = 0; n < 2; ++n) _Pragma("unroll") for (int k = 0; k < 2; ++k) \
        acc[ai][bj][m][n] = __builtin_amdgcn_mfma_f32_16x16x32_bf16(Bt[n][k], At[m][k], acc[ai][bj][m][n], 0, 0, 0); __builtin_amdgcn_s_setprio(0); } while (0)
#define PG8_WAIT_V(n) asm volatile("s_waitcnt vmcnt(" #n ")" ::: "memory")
#define PG8_WAIT_L(n) asm volatile("s_waitcnt lgkmcnt(" #n ")" ::: "memory")
#define PG8_BAR __builtin_amdgcn_s_barrier()
#define PG8_SCHED __builtin_amdgcn_sched_barrier(0)
    Unit cur, nxt; int ui = 0;
    if (!S.next(0, cur)) return;
    f32x4 acc[2][2][4][2];
#pragma unroll
    for (int a = 0; a < 2; ++a)
#pragma unroll
        for (int b = 0; b < 2; ++b)
#pragma unroll
            for (int m = 0; m < 4; ++m)
#pragma unroll
                for (int n = 0; n < 2; ++n) acc[a][b][m][n] = (f32x4){0.f, 0.f, 0.f, 0.f};
    bf16x8 At[4][2], B0[2][2], B1[2][2];
    const char* cA = (cur.pm < g.psplit ? (const char*)g.A + (size_t)cur.pm * tstepA : (const char*)g.A2 + (size_t)(cur.pm - g.psplit) * tstepA) + cur.ka; const char* cB = (const char*)g.Bt + (size_t)cur.pn * tstepB + cur.kb;
    PG8_STAGE(PG8_SB(0, 0), cB, voffB); PG8_STAGE(PG8_SB(0, 1), cB + hstepB, voffB); PG8_STAGE(PG8_SA(0, 0), cA, voffA); PG8_STAGE(PG8_SA(0, 1), cA + hstepA, voffA);
    if (wr == 1) PG8_BAR;
    PG8_WAIT_V(2); PG8_BAR;
    PG8_STAGE(PG8_SB(1, 0), cB + kstep, voffB); PG8_STAGE(PG8_SA(1, 0), cA + kstep, voffA); PG8_STAGE(PG8_SB(1, 1), cB + hstepB + kstep, voffB);
    PG8_WAIT_V(6); PG8_BAR;
    for (;;) {
        const bool has_next = S.next(ui + 1, nxt);
        const char* nA = has_next ? (nxt.pm < g.psplit ? (const char*)g.A + (size_t)nxt.pm * tstepA : (const char*)g.A2 + (size_t)(nxt.pm - g.psplit) * tstepA) + nxt.ka : cA; const char* nB = has_next ? (const char*)g.Bt + (size_t)nxt.pn * tstepB + nxt.kb : cB;
        const int nt = cur.nt;
        for (int t = 0; t < nt; t += 2) {
            const bool last = (t == nt - 2);
            const char* a1 = cA + (size_t)(t + 1) * kstep;
            const char* a2 = last ? nA : cA + (size_t)(t + 2) * kstep; const char* b2 = last ? nB : cB + (size_t)(t + 2) * kstep;
            const char* a3 = a2 + kstep; const char* b3 = b2 + kstep;
            PG8_LDB(B0, 0, 0); PG8_LDB(B1, 0, 1); PG8_SCHED; PG8_LDA(At, 0, 0); PG8_STAGE(PG8_SA(1, 1), a1 + hstepA, voffA);
            PG8_WAIT_V(8); PG8_WAIT_L(0); PG8_BAR; PG8_MMA(0, 0, At, B0); PG8_MMA(0, 1, At, B1); PG8_BAR; PG8_SCHED;
            PG8_LDA(At, 0, 1); PG8_STAGE(PG8_SB(0, 0), b2, voffB); PG8_STAGE(PG8_SB(0, 1), b2 + hstepB, voffB); PG8_STAGE(PG8_SA(0, 0), a2, voffA);
            PG8_WAIT_V(8); PG8_WAIT_L(0); PG8_BAR; PG8_MMA(1, 0, At, B0); PG8_MMA(1, 1, At, B1); PG8_BAR; PG8_SCHED;
            PG8_LDB(B0, 1, 0); PG8_LDB(B1, 1, 1); PG8_SCHED; PG8_LDA(At, 1, 0); PG8_STAGE(PG8_SA(0, 1), a2 + hstepA, voffA);
            PG8_WAIT_V(8); PG8_WAIT_L(0); PG8_BAR; PG8_MMA(0, 0, At, B0); PG8_MMA(0, 1, At, B1); PG8_BAR; PG8_SCHED;
            PG8_LDA(At, 1, 1); PG8_STAGE(PG8_SB(1, 0), b3, voffB); PG8_STAGE(PG8_SB(1, 1), b3 + hstepB, voffB); PG8_STAGE(PG8_SA(1, 0), a3, voffA);
            PG8_WAIT_V(8); PG8_WAIT_L(0); PG8_BAR; PG8_MMA(1, 0, At, B0); PG8_MMA(1, 1, At, B1); PG8_BAR; PG8_SCHED;
        }
        if (wr == 0) PG8_BAR;
        const bool zero = E(acc, cur, wr, wc, fr, fq);
        if (!has_next) break;
        if (zero) {
#pragma unroll
            for (int a = 0; a < 2; ++a)
#pragma unroll
                for (int b = 0; b < 2; ++b)
#pragma unroll
                    for (int m = 0; m < 4; ++m)
#pragma unroll
                        for (int n = 0; n < 2; ++n) acc[a][b][m][n] = (f32x4){0.f, 0.f, 0.f, 0.f};
        }
        cur = nxt; cA = nA; cB = nB; ++ui;
        if (wr == 1) PG8_BAR;
    }
    PG8_WAIT_V(0);
    PG8_BAR;
#undef PG8_SA
#undef PG8_SB
#undef PG8_STAGE
#undef PG8_LDA
#undef PG8_LDB
#undef PG8_MMA
#undef PG8_WAIT_V
#undef PG8_WAIT_L
#undef PG8_BAR
#undef PG8_SCHED
}
}
using pg8::Unit;

struct SchedP1 {
    int G, c;
    __device__ __forceinline__ bool next(int i, Unit& u) const {
        int L = i * G + c;
        if (L < 1224) { pg8::tile_map(68, 18, L, u.pm, u.pn); u.ka = 0; u.kb = 0; u.nt = 16; u.tag = 0; return true; }
        L -= 1224;
        if (L < 16) { u.pm = 68 + (L & 7); u.pn = 18 + (L >> 3); u.ka = 0; u.kb = 0; u.nt = 16; u.tag = 1; return true; }
        return false;
    }
};
struct SchedT {
    int nM, nN, nt, G, c;
    __device__ __forceinline__ bool next(int i, Unit& u) const {
        const int L = i * G + c; if (L >= nM * nN) return false;
        pg8::tile_map(nM, nN, L, u.pm, u.pn); u.ka = 0; u.kb = 0; u.nt = nt; u.tag = 0; return true;
    }
};
struct SchedP3 {
    int G, c;
    __device__ __forceinline__ bool next(int i, Unit& u) const {
        const int j = i / 3, br = i - 3 * j; const int L = j * G + c; if (L >= 272) return false;
        pg8::tile_map(68, 4, L, u.pm, u.pn);
        u.tag = br; u.nt = br == 0 ? 8 : 4; u.ka = br == 0 ? 0 : (br == 1 ? 2048 : 2560); u.kb = br == 0 ? 0 : (br == 1 ? 1024 : 1536);
        return true;
    }
};

struct SchedOne3 {
    int pm, pn;
    __device__ __forceinline__ bool next(int i, Unit& u) const {
        if (i >= 3) return false;
        u.pm = pm; u.pn = pn; u.tag = i; u.nt = i == 0 ? 8 : 4; u.ka = i == 0 ? 0 : (i == 1 ? 2048 : 2560); u.kb = i == 0 ? 0 : (i == 1 ? 1024 : 1536); return true;
    }
};
struct SchedOne {
    int pm, pn, nt;
    __device__ __forceinline__ bool next(int i, Unit& u) const { if (i >= 1) return false; u.pm = pm; u.pn = pn; u.ka = 0; u.kb = 0; u.nt = nt; u.tag = 0; return true; }
};
__device__ __forceinline__ void tile272(int L, int& pm, int& pn) { if (L < 256) pg8::tile_map(64, 4, L, pm, pn); else { pm = 64 + ((L - 256) >> 2); pn = (L - 256) & 3; } }
struct SchedP6 {
    int G, c;
    __device__ __forceinline__ bool next(int i, Unit& u) const {
        if (G == 256) {
            if (i == 1) { pg8::tile_map(64, 4, c, u.pm, u.pn); u.ka = 0; u.kb = 0; u.nt = 64; u.tag = 0; return true; }
            if (i == 0) { const int j = c >> 4; u.pm = 64 + (j >> 2); u.pn = j & 3; u.ka = (c & 15) * 512; u.kb = u.ka; u.nt = 4; u.tag = 1 + (c & 15); return true; }
            return false;
        }
        const int L = i * G + c; if (L >= 272) return false;
        pg8::tile_map(68, 4, L, u.pm, u.pn); u.ka = 0; u.kb = 0; u.nt = 64; u.tag = 0; return true;
    }
};
__device__ __forceinline__ float* part_base(unsigned char* ws, int s) {
    const size_t mb = s < 8 ? 48 + 4 * (size_t)s : (s < 12 ? 222 + 4 * (size_t)(s - 8) : (s < 14 ? 13 + 4 * (size_t)(s - 12) : 3 + 4 * (size_t)(s - 14)));
    return (float*)(ws + mb * MiB);
}
__device__ __forceinline__ void panel_signal(unsigned* cnt, int wave_s);
__device__ __forceinline__ void panel_wait(unsigned* cnt, unsigned want, unsigned* bar, int wave_s);
#define EPI_ROWS(u) const int row0 = (u).pm * 256 + wr * 64 + fr; const int col0 = (u).pn * 256 + wc * 32 + 8 * fq;
struct EpiP1 {
    bf16_t* Z; float* P; float* outk; float* outv; bf16_t* KB; bf16_t* VTB;
    __device__ __forceinline__ bool operator()(const f32x4 (&acc)[2][2][4][2], const Unit& u, int wr, int wc, int fr, int fq) const {
        EPI_ROWS(u)
        if (u.tag == 0) {
            const int pn = u.pn;
#pragma unroll
            for (int ai = 0; ai < 2; ++ai)
#pragma unroll
                for (int m = 0; m < 4; ++m) { const int row = row0 + ai * 128 + m * 16;
#pragma unroll
                    for (int bj = 0; bj < 2; ++bj) { const int col = col0 + bj * 128; f32x4 v0 = acc[ai][bj][m][0], v1 = acc[ai][bj][m][1];
                        if (pn == 4) { float* p = P + (size_t)row * 256 + (col - 1024); *(f32x4*)p = v0; *(f32x4*)(p + 4) = v1; }
                        else {
                            if (pn < 4) {
                                const f32x2 a0 = gelu_t2((f32x2){v0[0], v0[1]}), a1 = gelu_t2((f32x2){v0[2], v0[3]}), a2 = gelu_t2((f32x2){v1[0], v1[1]}), a3 = gelu_t2((f32x2){v1[2], v1[3]});
                                v0 = (f32x4){a0.x, a0.y, a1.x, a1.y}; v1 = (f32x4){a2.x, a2.y, a3.x, a3.y};
                            } else if (pn >= 6) {
                                u32x2 q; q.x = gate_q(v0[0]) | (gate_q(v0[1]) << 8) | (gate_q(v0[2]) << 16) | (gate_q(v0[3]) << 24); q.y = gate_q(v1[0]) | (gate_q(v1[1]) << 8) | (gate_q(v1[2]) << 16) | (gate_q(v1[3]) << 24);
                                *(u32x2*)((unsigned char*)Z + (size_t)row * (DIN * 2) + 1536 + col) = q; continue;
                            }
                            u32x4 w; w.x = cvt_pk_bf16(v0[0], v0[1]); w.y = cvt_pk_bf16(v0[2], v0[3]); w.z = cvt_pk_bf16(v1[0], v1[1]); w.w = cvt_pk_bf16(v1[2], v1[3]);
                            *(u32x4*)(Z + (size_t)row * DIN + col) = w;
                        } } }
        } else {
            const bool isv = (u.pn == 19);
#pragma unroll
            for (int ai = 0; ai < 2; ++ai)
#pragma unroll
                for (int m = 0; m < 4; ++m) { const int r = row0 - 68 * 256 + ai * 128 + m * 16;
#pragma unroll
                    for (int bj = 0; bj < 2; ++bj) { const int c = wc * 32 + 8 * fq + bj * 128; const f32x4 v0 = acc[ai][bj][m][0], v1 = acc[ai][bj][m][1];
                        float* o = (isv ? outv : outk) + (size_t)r * 256 + c; __builtin_nontemporal_store(v0, (f32x4*)o); __builtin_nontemporal_store(v1, (f32x4*)(o + 4));
                        if (!isv) { u32x4 w; w.x = cvt_pk_bf16(v0[0], v0[1]); w.y = cvt_pk_bf16(v0[2], v0[3]); w.z = cvt_pk_bf16(v1[0], v1[1]); w.w = cvt_pk_bf16(v1[2], v1[3]);
                            *(u32x4*)(KB + (size_t)r * 256 + c) = w; }
                        else { bf16_t* vt = VTB + ((size_t)(r >> 8) * 256 + c) * 256 + (r & 255);
#pragma unroll
                            for (int e = 0; e < 4; ++e) { vt[(size_t)e * 256] = (bf16_t)f2bf(v0[e]); vt[(size_t)(e + 4) * 256] = (bf16_t)f2bf(v1[e]); } }
                    } }
        }
        return true;
    }
};
struct EpiP3 {
    const bf16_t* Z; bf16_t* MG; bool wt;
    __device__ __forceinline__ bool operator()(f32x4 (&acc)[2][2][4][2], const Unit& u, int wr, int wc, int fr, int fq) const {
        EPI_ROWS(u)
        const int br = u.tag;
        u32x2 gn[2][4][2], gd[2][4][2];
#pragma unroll
        for (int ai = 0; ai < 2; ++ai)
#pragma unroll
            for (int m = 0; m < 4; ++m)
#pragma unroll
                for (int bj = 0; bj < 2; ++bj) { const unsigned char* gp = (const unsigned char*)Z + (size_t)(row0 + ai * 128 + m * 16) * (DIN * 2) + 3072 + br * 1024 + col0 + bj * 128;
                    gn[ai][m][bj] = *(const u32x2*)gp; if (br < 2) gd[ai][m][bj] = *(const u32x2*)(gp + 1024); }
        asm volatile("" ::: "memory");
#pragma unroll
        for (int ai = 0; ai < 2; ++ai)
#pragma unroll
            for (int m = 0; m < 4; ++m) { const int row = row0 + ai * 128 + m * 16;
#pragma unroll
                for (int bj = 0; bj < 2; ++bj) { const int col = col0 + bj * 128;
                    const u32x2 g1 = gn[ai][m][bj];
                    float f[8];
                    f[0] = ub0(g1.x); f[1] = ub1(g1.x); f[2] = ub2(g1.x); f[3] = ub3(g1.x); f[4] = ub0(g1.y); f[5] = ub1(g1.y); f[6] = ub2(g1.y); f[7] = ub3(g1.y);
                    if (br < 2) { const u32x2 g2 = gd[ai][m][bj];
                        f[0] *= __builtin_amdgcn_rcpf(ub0(g2.x)); f[1] *= __builtin_amdgcn_rcpf(ub1(g2.x)); f[2] *= __builtin_amdgcn_rcpf(ub2(g2.x)); f[3] *= __builtin_amdgcn_rcpf(ub3(g2.x));
                        f[4] *= __builtin_amdgcn_rcpf(ub0(g2.y)); f[5] *= __builtin_amdgcn_rcpf(ub1(g2.y)); f[6] *= __builtin_amdgcn_rcpf(ub2(g2.y)); f[7] *= __builtin_amdgcn_rcpf(ub3(g2.y)); }
                    else {
#pragma unroll
                        for (int e = 0; e < 8; ++e) f[e] *= (1.0f / 255.0f); }
                    f32x4 v0 = acc[ai][bj][m][0], v1 = acc[ai][bj][m][1];
                    v0[0] *= f[0]; v0[1] *= f[1]; v0[2] *= f[2]; v0[3] *= f[3]; v1[0] *= f[4]; v1[1] *= f[5]; v1[2] *= f[6]; v1[3] *= f[7];
                    if (br < 2) { acc[ai][bj][m][0] = v0; acc[ai][bj][m][1] = v1; }
                    else { u32x4 w; w.x = cvt_pk_bf16(v0[0], v0[1]); w.y = cvt_pk_bf16(v0[2], v0[3]); w.z = cvt_pk_bf16(v1[0], v1[1]); w.w = cvt_pk_bf16(v1[2], v1[3]);
                        if (!wt) *(u32x4*)(MG + (size_t)row * DM + col) = w;
                        else { unsigned long long* mp = (unsigned long long*)(MG + (size_t)row * DM + col);
                            __hip_atomic_store(mp, (unsigned long long)w.x | ((unsigned long long)w.y << 32), __ATOMIC_RELAXED, __HIP_MEMORY_SCOPE_AGENT);
                            __hip_atomic_store(mp + 1, (unsigned long long)w.z | ((unsigned long long)w.w << 32), __ATOMIC_RELAXED, __HIP_MEMORY_SCOPE_AGENT); } }
                } }
        return br == 2;
    }
};
struct EpiP4 {
    const float* xp; const float* xs; float* out; bf16_t* X1Blo; bf16_t* X1Bhi; float* SSP; float* SSP4; LAS unsigned char* lds;
    __device__ __forceinline__ bool operator()(const f32x4 (&acc)[2][2][4][2], const Unit& u, int wr, int wc, int fr, int fq) const {
        EPI_ROWS(u)
        const float* xb = u.pm < 64 ? xp : xs - (size_t)MP * DM;
        bf16_t* X1B = u.pm < X1B_SPLIT ? X1Blo : X1Bhi - (size_t)X1B_SPLIT * 256 * DM;
#pragma unroll
        for (int ai = 0; ai < 2; ++ai) {
            f32x4 xv[4][2][2];
#pragma unroll
            for (int m = 0; m < 4; ++m)
#pragma unroll
                for (int bj = 0; bj < 2; ++bj) { const size_t off = (size_t)(row0 + ai * 128 + m * 16) * DM + col0 + bj * 128; xv[m][bj][0] = __builtin_nontemporal_load((const f32x4*)(xb + off)); xv[m][bj][1] = __builtin_nontemporal_load((const f32x4*)(xb + off + 4)); }
            asm volatile("" ::: "memory");
#pragma unroll
            for (int m = 0; m < 4; ++m) { const int row = row0 + ai * 128 + m * 16; float ss = 0.f;
#pragma unroll
                for (int bj = 0; bj < 2; ++bj) { const int col = col0 + bj * 128; const size_t off = (size_t)row * DM + col;
                    const f32x4 v0 = acc[ai][bj][m][0] + xv[m][bj][0], v1 = acc[ai][bj][m][1] + xv[m][bj][1];
                    u32x4 w; w.x = cvt_pk_bf16(v0[0], v0[1]); w.y = cvt_pk_bf16(v0[2], v0[3]); w.z = cvt_pk_bf16(v1[0], v1[1]); w.w = cvt_pk_bf16(v1[2], v1[3]);
                    *(u32x4*)(X1B + off) = w;
                    ss += (v0[0] * v0[0] + v0[1] * v0[1]) + (v0[2] * v0[2] + v0[3] * v0[3]) + (v1[0] * v1[0] + v1[1] * v1[1]) + (v1[2] * v1[2] + v1[3] * v1[3]); }
                ss += __shfl_xor(ss, 16); ss += __shfl_xor(ss, 32);
                if (fq == 0) { SSP[(size_t)row * 16 + u.pn * 4 + wc] = ss; ((LAS float*)(lds + 131072))[(ai * 128 + wr * 64 + m * 16 + fr) * 4 + wc] = ss; } }
            asm volatile("" ::: "memory");
        }
        __syncthreads();
        { const int t = (wr * 4 + wc) * 64 + fq * 16 + fr;
          if (t < 256) { const f32x4 q = *(const LAS f32x4*)(lds + 131072 + t * 16); SSP4[(size_t)(u.pm * 256 + t) * 4 + u.pn] = (q[0] + q[1]) + (q[2] + q[3]); } }
        __syncthreads();
        return true;
    }
};
struct EpiP5 {
    const float* SSP; bf16_t* H; const float* SSP4; int n4;
    __device__ __forceinline__ bool operator()(const f32x4 (&acc)[2][2][4][2], const Unit& u, int wr, int wc, int fr, int fq) const {
        EPI_ROWS(u)
        if (u.pm < n4) {
            f32x4 sq[2][4];
#pragma unroll
            for (int ai = 0; ai < 2; ++ai)
#pragma unroll
                for (int m = 0; m < 4; ++m) sq[ai][m] = *(const f32x4*)(SSP4 + (size_t)(row0 + ai * 128 + m * 16) * 4);
            asm volatile("" ::: "memory");
#pragma unroll
            for (int ai = 0; ai < 2; ++ai)
#pragma unroll
                for (int m = 0; m < 4; ++m) { const int row = row0 + ai * 128 + m * 16; const f32x4 q = sq[ai][m];
                    const float rstd = 1.0f / sqrtf(((q[0] + q[1]) + (q[2] + q[3])) * (1.0f / DM) + EPS);
#pragma unroll
                    for (int bj = 0; bj < 2; ++bj) { const int col = col0 + bj * 128; f32x4 v0 = acc[ai][bj][m][0] * rstd, v1 = acc[ai][bj][m][1] * rstd;
#pragma unroll
                        for (int e = 0; e < 4; ++e) { const float a = fmaxf(v0[e], 0.f), b = fmaxf(v1[e], 0.f); v0[e] = a * a; v1[e] = b * b; }
                        u32x4 w; w.x = cvt_pk_bf16(v0[0], v0[1]); w.y = cvt_pk_bf16(v0[2], v0[3]); w.z = cvt_pk_bf16(v1[0], v1[1]); w.w = cvt_pk_bf16(v1[2], v1[3]);
                        *(u32x4*)(H + (size_t)row * DFF + col) = w; } }
            return true;
        }
#pragma unroll
        for (int ai = 0; ai < 2; ++ai) {
            f32x4 sv[4][4];
#pragma unroll
            for (int m = 0; m < 4; ++m) { const f32x4* sp = (const f32x4*)(SSP + (size_t)(row0 + ai * 128 + m * 16) * 16);
#pragma unroll
                for (int k = 0; k < 4; ++k) sv[m][k] = sp[k]; }
            asm volatile("" ::: "memory");
#pragma unroll
            for (int m = 0; m < 4; ++m) { const int row = row0 + ai * 128 + m * 16;
                const f32x4 s0 = sv[m][0], s1 = sv[m][1], s2 = sv[m][2], s3 = sv[m][3];
                const float ss = ((s0[0] + s0[1]) + (s0[2] + s0[3])) + ((s1[0] + s1[1]) + (s1[2] + s1[3])) + ((s2[0] + s2[1]) + (s2[2] + s2[3])) + ((s3[0] + s3[1]) + (s3[2] + s3[3]));
                const float rstd = 1.0f / sqrtf(ss * (1.0f / DM) + EPS);
#pragma unroll
                for (int bj = 0; bj < 2; ++bj) { const int col = col0 + bj * 128; f32x4 v0 = acc[ai][bj][m][0] * rstd, v1 = acc[ai][bj][m][1] * rstd;
#pragma unroll
                    for (int e = 0; e < 4; ++e) { const float a = fmaxf(v0[e], 0.f), b = fmaxf(v1[e], 0.f); v0[e] = a * a; v1[e] = b * b; }
                    u32x4 w; w.x = cvt_pk_bf16(v0[0], v0[1]); w.y = cvt_pk_bf16(v0[2], v0[3]); w.z = cvt_pk_bf16(v1[0], v1[1]); w.w = cvt_pk_bf16(v1[2], v1[3]);
                    *(u32x4*)(H + (size_t)row * DFF + col) = w; } }
            asm volatile("" ::: "memory");
        }
        return true;
    }
};
struct EpiP6 {
    float* out; unsigned char* ws; const bf16_t* X1Blo; const bf16_t* X1Bhi;
    __device__ __forceinline__ bool operator()(const f32x4 (&acc)[2][2][4][2], const Unit& u, int wr, int wc, int fr, int fq) const {
        EPI_ROWS(u)
        if (u.tag == 0) {
            const bf16_t* X1B = u.pm < X1B_SPLIT ? X1Blo : X1Bhi - (size_t)X1B_SPLIT * 256 * DM;
#pragma unroll
            for (int ai = 0; ai < 2; ++ai) {
                u32x4 xv[4][2];
#pragma unroll
                for (int m = 0; m < 4; ++m)
#pragma unroll
                    for (int bj = 0; bj < 2; ++bj) xv[m][bj] = *(const u32x4*)(X1B + (size_t)(row0 + ai * 128 + m * 16) * DM + col0 + bj * 128);
                asm volatile("" ::: "memory");
#pragma unroll
                for (int m = 0; m < 4; ++m)
#pragma unroll
                    for (int bj = 0; bj < 2; ++bj) { const size_t off = (size_t)(row0 + ai * 128 + m * 16) * DM + col0 + bj * 128; const u32x4 xw = xv[m][bj];
                        *(f32x4*)(out + off) = acc[ai][bj][m][0] + (f32x4){bf_lo(xw.x), bf_hi(xw.x), bf_lo(xw.y), bf_hi(xw.y)};
                        *(f32x4*)(out + off + 4) = acc[ai][bj][m][1] + (f32x4){bf_lo(xw.z), bf_hi(xw.z), bf_lo(xw.w), bf_hi(xw.w)}; }
                asm volatile("" ::: "memory");
            }
        } else {
            float* pb = part_base(ws, u.tag - 1);
#pragma unroll
            for (int ai = 0; ai < 2; ++ai)
#pragma unroll
                for (int m = 0; m < 4; ++m) { const int row = row0 - MP + ai * 128 + m * 16;
#pragma unroll
                    for (int bj = 0; bj < 2; ++bj) { float* o = pb + (size_t)row * DM + col0 + bj * 128; *(f32x4*)o = acc[ai][bj][m][0]; *(f32x4*)(o + 4) = acc[ai][bj][m][1]; } }
        }
        return true;
    }
};

struct EpiP6F {
    float* out; unsigned char* ws; const bf16_t* X1Blo; const bf16_t* X1Bhi; float* SSP4; unsigned* cnt; unsigned* bar; const float* gfin; LAS unsigned char* lds;
    __device__ __forceinline__ bool operator()(f32x4 (&acc)[2][2][4][2], const Unit& u, int wr, int wc, int fr, int fq) const {
        EPI_ROWS(u)
        if (u.tag != 0) {
            float* pb = part_base(ws, u.tag - 1);
#pragma unroll
            for (int ai = 0; ai < 2; ++ai)
#pragma unroll
                for (int m = 0; m < 4; ++m) { const int row = row0 - MP + ai * 128 + m * 16;
#pragma unroll
                    for (int bj = 0; bj < 2; ++bj) { float* o = pb + (size_t)row * DM + col0 + bj * 128; *(f32x4*)o = acc[ai][bj][m][0]; *(f32x4*)(o + 4) = acc[ai][bj][m][1]; } }
            return true;
        }
        const bf16_t* X1B = u.pm < X1B_SPLIT ? X1Blo : X1Bhi - (size_t)X1B_SPLIT * 256 * DM;
#pragma unroll
        for (int ai = 0; ai < 2; ++ai) {
            u32x4 xv[4][2];
#pragma unroll
            for (int m = 0; m < 4; ++m)
#pragma unroll
                for (int bj = 0; bj < 2; ++bj) xv[m][bj] = __builtin_nontemporal_load((const u32x4*)(X1B + (size_t)(row0 + ai * 128 + m * 16) * DM + col0 + bj * 128));
            asm volatile("" ::: "memory");
#pragma unroll
            for (int m = 0; m < 4; ++m) { const int row = row0 + ai * 128 + m * 16; float ss = 0.f;
#pragma unroll
                for (int bj = 0; bj < 2; ++bj) { const u32x4 xw = xv[m][bj];
                    const f32x4 v0 = acc[ai][bj][m][0] + (f32x4){bf_lo(xw.x), bf_hi(xw.x), bf_lo(xw.y), bf_hi(xw.y)}, v1 = acc[ai][bj][m][1] + (f32x4){bf_lo(xw.z), bf_hi(xw.z), bf_lo(xw.w), bf_hi(xw.w)};
                    acc[ai][bj][m][0] = v0; acc[ai][bj][m][1] = v1;
                    ss += (v0[0] * v0[0] + v0[1] * v0[1]) + (v0[2] * v0[2] + v0[3] * v0[3]) + (v1[0] * v1[0] + v1[1] * v1[1]) + (v1[2] * v1[2] + v1[3] * v1[3]); }
                ss += __shfl_xor(ss, 16); ss += __shfl_xor(ss, 32);
                if (fq == 0) ((LAS float*)(lds + 131072))[(ai * 128 + wr * 64 + m * 16 + fr) * 4 + wc] = ss; (void)row; }
            asm volatile("" ::: "memory");
        }
        __syncthreads();
        { const int t = (wr * 4 + wc) * 64 + fq * 16 + fr;
          if (t < 256) { const f32x4 q = *(const LAS f32x4*)(lds + 131072 + t * 16); __hip_atomic_store(SSP4 + (size_t)(u.pm * 256 + t) * 4 + u.pn, (q[0] + q[1]) + (q[2] + q[3]), __ATOMIC_RELAXED, __HIP_MEMORY_SCOPE_AGENT); } }
        panel_signal(cnt + 64 * u.pm, wr * 4 + wc);
        panel_wait(cnt + 64 * u.pm, 4u, bar, wr * 4 + wc);
        f32x4 sq[2][4];
#pragma unroll
        for (int ai = 0; ai < 2; ++ai)
#pragma unroll
            for (int m = 0; m < 4; ++m) sq[ai][m] = *(const f32x4*)(SSP4 + (size_t)(row0 + ai * 128 + m * 16) * 4);
        asm volatile("" ::: "memory");
#pragma unroll
        for (int ai = 0; ai < 2; ++ai)
#pragma unroll
            for (int m = 0; m < 4; ++m) { const int row = row0 + ai * 128 + m * 16; const f32x4 q = sq[ai][m];
                const float rstd = 1.0f / sqrtf(((q[0] + q[1]) + (q[2] + q[3])) * (1.0f / DM) + EPS);
#pragma unroll
                for (int bj = 0; bj < 2; ++bj) { const size_t off = (size_t)row * DM + col0 + bj * 128;
                    const f32x4 g0 = *(const f32x4*)(gfin + col0 + bj * 128), g1 = *(const f32x4*)(gfin + col0 + bj * 128 + 4);
                    __builtin_nontemporal_store(acc[ai][bj][m][0] * rstd * g0, (f32x4*)(out + off)); __builtin_nontemporal_store(acc[ai][bj][m][1] * rstd * g1, (f32x4*)(out + off + 4)); } }
        return true;
    }
};

__device__ __forceinline__ float wave_sum(float v) {
#pragma unroll
    for (int o = 1; o < 64; o <<= 1) v += __shfl_xor(v, o);
    return v;
}
__device__ __forceinline__ void tr_item(const float* W, int N, bf16_t* WT, int ldt, int col_off, const float* kscale, LAS float* scr, int item, int lane) {
    const int nblk = N / 32, kb = item / nblk, nb = item % nblk, k0 = 64 * kb, n0 = 32 * nb;
    f32x4 t[8];
#pragma unroll
    for (int i = 0; i < 8; ++i) { const int kk = 8 * i + (lane >> 3); t[i] = __builtin_nontemporal_load((const f32x4*)(W + (size_t)(k0 + kk) * N + n0 + 4 * (lane & 7))); }
    if (kscale) {
#pragma unroll
        for (int i = 0; i < 8; ++i) t[i] = t[i] * kscale[k0 + 8 * i + (lane >> 3)];
    }
#pragma unroll
    for (int i = 0; i < 8; ++i) { LAS float* d = scr + (8 * i + (lane >> 3)) * 33 + 4 * (lane & 7); d[0] = t[i][0]; d[1] = t[i][1]; d[2] = t[i][2]; d[3] = t[i][3]; }
    asm volatile("s_waitcnt lgkmcnt(0)" ::: "memory");
    const int c = lane & 7;
#pragma unroll
    for (int j = 0; j < 4; ++j) { const int n = (lane >> 3) + 8 * j; const LAS float* s = scr + (8 * c) * 33 + n;
        u32x4 o; o.x = pk2(s[0 * 33], s[1 * 33]); o.y = pk2(s[2 * 33], s[3 * 33]); o.z = pk2(s[4 * 33], s[5 * 33]); o.w = pk2(s[6 * 33], s[7 * 33]);
        *(u32x4*)(WT + (size_t)(n0 + n) * ldt + col_off + k0 + 8 * c) = o; }
    asm volatile("s_waitcnt lgkmcnt(0)" ::: "memory");
}
__device__ __forceinline__ const float* p0_src_row(const Args& a, int row) { return row < MP ? a.x_prompt + (size_t)row * DM : (row < MT ? a.x_sample + (size_t)(row - MP) * DM : a.mem + (size_t)(row - MT) * DM); }
__device__ __forceinline__ void rms_rows2_to_bf16(const float* x0, const float* x1, const float* g0, const float* g1, bf16_t* o0, bf16_t* o1, int lane) {
    const f32x4* xr0 = (const f32x4*)x0 + lane; const f32x4* xr1 = (const f32x4*)x1 + lane;
    f32x4 v[2][4]; float s0 = 0.f, s1 = 0.f;
#pragma unroll
    for (int j = 0; j < 4; ++j) { v[0][j] = __builtin_nontemporal_load(xr0 + 64 * j); v[1][j] = __builtin_nontemporal_load(xr1 + 64 * j); }
#pragma unroll
    for (int j = 0; j < 4; ++j) { s0 += (v[0][j][0] * v[0][j][0] + v[0][j][1] * v[0][j][1]) + (v[0][j][2] * v[0][j][2] + v[0][j][3] * v[0][j][3]);
                                  s1 += (v[1][j][0] * v[1][j][0] + v[1][j][1] * v[1][j][1]) + (v[1][j][2] * v[1][j][2] + v[1][j][3] * v[1][j][3]); }
    const float r0 = 1.0f / sqrtf(wave_sum(s0) * (1.0f / DM) + EPS), r1 = 1.0f / sqrtf(wave_sum(s1) * (1.0f / DM) + EPS);
    u32x2* p0 = (u32x2*)o0 + lane; u32x2* p1 = (u32x2*)o1 + lane;
#pragma unroll
    for (int j = 0; j < 4; ++j) { const f32x4 ga = ((const f32x4*)g0 + lane)[64 * j], gb = ((const f32x4*)g1 + lane)[64 * j]; u32x2 w;
        w.x = pk2(v[0][j][0] * r0 * ga[0], v[0][j][1] * r0 * ga[1]); w.y = pk2(v[0][j][2] * r0 * ga[2], v[0][j][3] * r0 * ga[3]); p0[64 * j] = w;
        w.x = pk2(v[1][j][0] * r1 * gb[0], v[1][j][1] * r1 * gb[1]); w.y = pk2(v[1][j][2] * r1 * gb[2], v[1][j][3] * r1 * gb[3]); p1[64 * j] = w; }
}
__device__ __forceinline__ void p0_prologue(const Args& a, LAS unsigned char* lds, int tid, int G) {
    const int wave = tid >> 6, lane = tid & 63;
    LAS float* scr = (LAS float*)(lds + wave * 16384);
    const int gw = blockIdx.x * 8 + wave, NGW = G * 8;
    const int gt = blockIdx.x * 512 + tid, NGT = G * 512;
    bf16_t* WinT = (bf16_t*)(a.ws + WS_WIN); bf16_t* WoT = (bf16_t*)(a.ws + WS_WO); bf16_t* WupT = (bf16_t*)(a.ws + WS_WUP); bf16_t* WdnT = (bf16_t*)(a.ws + WS_WDN); bf16_t* WbrT = (bf16_t*)(a.ws + WS_WBR);
    bf16_t* VTB = (bf16_t*)((unsigned char*)a.out + OS_VTB); bf16_t* KB = (bf16_t*)((unsigned char*)a.out + OS_KB);
    constexpr int I_IN = 16 * 144, I_KV = 16 * 16, I_O = 16 * 32, I_UP = 16 * 128, I_DN = 64 * 32, I_A = 8 * 32, I_C = 4 * 32, I_V = 128 * 32;
    constexpr int NITEMS = I_IN + I_KV + I_O + I_A + I_C + I_V;
    for (int it = gw; it < NITEMS; it += NGW) {
        int r = it;
        if (r < I_IN) { tr_item(a.w_in, DIN, WinT, 1024, 0, nullptr, scr, r, lane); continue; } r -= I_IN;
        if (r < I_KV) { tr_item(a.w_kv, 512, WinT + (size_t)4608 * 1024, 1024, 0, nullptr, scr, r, lane); continue; } r -= I_KV;
        if (r < I_O) { tr_item(a.w_o, 1024, WoT, 1024, 0, nullptr, scr, r, lane); continue; } r -= I_O;
        if (r < I_A) { tr_item(a.w_out_a, 1024, WbrT, 1024, 0, nullptr, scr, r, lane); continue; } r -= I_A;
        if (r < I_C) { tr_item(a.w_out_c, 1024, WbrT, 1024, 768, nullptr, scr, r, lane); continue; } r -= I_C;
        { const int b = r >> 5; tr_item(a.cache_v + (size_t)b * 65536, 256, VTB + (size_t)(8 + b) * 65536, 256, 0, nullptr, scr, r & 31, lane); }
    }
    for (int idx = gt; idx < 256 * 1024; idx += NGT) { const int n = idx & 1023, k = idx >> 10, g = k >> 6, kk = k & 63; float s = 0.f;
        const float* wp = a.w_pool + g * 4096 + kk * 64; const float* sc = a.pool_scale + g * 64; const float* wb = a.w_out_b + (size_t)(g * 64) * 1024 + n;
#pragma unroll 32
        for (int e = 0; e < 64; ++e) s += wp[e] * sc[e] * wb[(size_t)e * 1024];
        WbrT[(size_t)n * 1024 + 512 + k] = (bf16_t)f2bf(s); }
    bf16_t* XN = (bf16_t*)(a.ws + WS_XN);
    for (int r2 = gw; r2 < (MT + MKV) / 2; r2 += NGW) { const int row = 2 * r2;
        rms_rows2_to_bf16(p0_src_row(a, row), p0_src_row(a, row + 1), row < MT ? a.g_mix : a.g_mem, row < MT ? a.g_mix : a.g_mem, XN + (size_t)row * DM, XN + (size_t)(row + 1) * DM, lane); }
    bf16_t* WsB = (bf16_t*)(a.ws + WS_WSB);
    for (int idx = gt; idx < 131072; idx += NGT) { const int e = idx & 65535, g = e >> 14, r = (e >> 7) & 127, c = e & 127; float v;
        if (idx < 65536) v = c <= r ? a.w_s[e] : 0.f;
        else v = ((r >> 3) == (c >> 3) && (c & 7) <= (r & 7)) ? a.w_s[g * 16384 + (r & 7) * 128 + (c & 7)] : 0.f;
        WsB[idx] = (bf16_t)f2bf(v); }
}

__device__ __forceinline__ void p0_deferred(const Args& a, LAS unsigned char* lds, int tid, int G) {
    const int wave = tid >> 6, lane = tid & 63;
    LAS float* scr = (LAS float*)(lds + wave * 16384);
    const int nc = G, cc = (int)blockIdx.x;
    bf16_t* WupT = (bf16_t*)(a.ws + WS_WUP); bf16_t* WdnT = (bf16_t*)(a.ws + WS_WDN);
    for (int it = cc * 8 + wave; it < 4096; it += nc * 8) {
        if (it < 2048) tr_item(a.w_up, DFF, WupT, 1024, 0, a.g_ffn, scr, it, lane);
        else tr_item(a.w_down, 1024, WdnT, 4096, 0, nullptr, scr, it - 2048, lane);
    }
}

__device__ __forceinline__ void p2a_unit(const Args& a, LAS unsigned char* lds, int c, int tid) {
    const int w = __builtin_amdgcn_readfirstlane(tid >> 6), l = tid & 63;
    bf16_t* Z = (bf16_t*)(a.ws + WS_Z);
    const int row0 = c * 128;
    const int g = w >> 1, ih = w & 1, fr = l & 15, fq = l >> 4;
    const bf16_t* Wg = (const bf16_t*)(a.ws + WS_WSB) + (c >= 128 ? 65536 : 0) + g * 16384;
    __syncthreads();
    u32x4 v[2][8];
#pragma unroll
    for (int rr = 0; rr < 2; ++rr) { const u32x4* src = (const u32x4*)(Z + (size_t)(row0 + 2 * l + rr) * DIN + 512 + 64 * w);
#pragma unroll
        for (int e = 0; e < 8; ++e) v[rr][e] = src[e]; }
    LAS f32x2* ST = (LAS f32x2*)(lds + 139264);
#pragma unroll
    for (int rr = 0; rr < 2; ++rr) { float s = 0.f, q = 0.f;
#pragma unroll
        for (int e = 0; e < 8; ++e)
#pragma unroll
            for (int d = 0; d < 4; ++d) { const float x0 = bf_lo(v[rr][e][d]), x1 = bf_hi(v[rr][e][d]); s += x0 + x1; q += x0 * x0 + x1 * x1; }
        ST[(2 * l + rr) * 8 + w] = (f32x2){s, q}; }
    __syncthreads();
    float mean[2], rstd[2];
#pragma unroll
    for (int rr = 0; rr < 2; ++rr) { float s = 0.f, q = 0.f;
#pragma unroll
        for (int k = 0; k < 8; ++k) { const f32x2 t = ST[(2 * l + rr) * 8 + k]; s += t[0]; q += t[1]; }
        mean[rr] = s * (1.0f / 512.0f); const float var = fmaxf(q * (1.0f / 512.0f) - mean[rr] * mean[rr], 0.f); rstd[rr] = 1.0f / sqrtf(var + EPS); }
    const bool wout = (c >= 128) || ((c & 15) == 15);
    float* op = c >= 128 ? a.out + O_CVS + (size_t)((c - 128) * 128 + 2 * l) * 512 : a.out + O_CVP + (size_t)((c >> 4) * 128 + 2 * l) * 512;
#pragma unroll
    for (int e = 0; e < 8; ++e) { float y[2][8];
#pragma unroll
        for (int d = 0; d < 4; ++d) { const int ch = 64 * w + 8 * e + 2 * d; const float g0 = a.g_v[ch], g1 = a.g_v[ch + 1], b0 = a.b_v[ch], b1 = a.b_v[ch + 1];
            y[0][2 * d] = (bf_lo(v[0][e][d]) - mean[0]) * rstd[0] * g0 + b0; y[0][2 * d + 1] = (bf_hi(v[0][e][d]) - mean[0]) * rstd[0] * g1 + b1;
            y[1][2 * d] = (bf_lo(v[1][e][d]) - mean[1]) * rstd[1] * g0 + b0; y[1][2 * d + 1] = (bf_hi(v[1][e][d]) - mean[1]) * rstd[1] * g1 + b1;
            *(LAS unsigned*)(lds + ch * 272 + 4 * l) = pk2(y[0][2 * d], y[1][2 * d]);
            *(LAS unsigned*)(lds + (ch + 1) * 272 + 4 * l) = pk2(y[0][2 * d + 1], y[1][2 * d + 1]); }
        if (wout) {
#pragma unroll
            for (int rr = 0; rr < 2; ++rr) { float* o = op + rr * 512 + 64 * w + 8 * e; __builtin_nontemporal_store((f32x4){y[rr][0], y[rr][1], y[rr][2], y[rr][3]}, (f32x4*)o); __builtin_nontemporal_store((f32x4){y[rr][4], y[rr][5], y[rr][6], y[rr][7]}, (f32x4*)(o + 4)); } }
    }
    bf16x8 wf[4][4];
#pragma unroll
    for (int mt = 0; mt < 4; ++mt)
#pragma unroll
        for (int ks = 0; ks < 4; ++ks) wf[mt][ks] = *(const bf16x8*)(Wg + (64 * ih + 16 * mt + fr) * 128 + 32 * ks + 8 * fq);
    __syncthreads();
    const int nks = ih ? 4 : 2;
    for (int np = 0; np < 2; ++np) {
        u32x2 uu[4][4];
#pragma unroll
        for (int mt = 0; mt < 4; ++mt)
#pragma unroll
            for (int nt = 0; nt < 4; ++nt) uu[mt][nt] = *(const u32x2*)(Z + (size_t)(row0 + 64 * ih + 16 * mt + fr) * DIN + g * 128 + np * 64 + nt * 16 + 4 * fq);
        f32x4 acc[4][4];
#pragma unroll
        for (int i = 0; i < 4; ++i)
#pragma unroll
            for (int j = 0; j < 4; ++j) acc[i][j] = (f32x4){0.f, 0.f, 0.f, 0.f};
#pragma unroll
        for (int ks = 0; ks < 4; ++ks) if (ks < nks) {
            bf16x8 vf[4];
#pragma unroll
            for (int nt = 0; nt < 4; ++nt) vf[nt] = *(const LAS bf16x8*)(lds + (g * 128 + np * 64 + nt * 16 + fr) * 272 + (32 * ks + 8 * fq) * 2);
#pragma unroll
            for (int mt = 0; mt < 4; ++mt)
#pragma unroll
                for (int nt = 0; nt < 4; ++nt) acc[mt][nt] = __builtin_amdgcn_mfma_f32_16x16x32_bf16(vf[nt], wf[mt][ks], acc[mt][nt], 0, 0, 0);
        }
#pragma unroll
        for (int mt = 0; mt < 4; ++mt) { const int i = 64 * ih + 16 * mt + fr; const float bias = a.b_s[g * 128 + (c >= 128 ? (i & 7) : i)];
#pragma unroll
            for (int nt = 0; nt < 4; ++nt) { bf16_t* up = Z + (size_t)(row0 + i) * DIN + g * 128 + np * 64 + nt * 16 + 4 * fq;
                const u32x2 u2 = uu[mt][nt]; u32x2 o;
                o.x = pk2(bf_lo(u2.x) * (acc[mt][nt][0] + bias), bf_hi(u2.x) * (acc[mt][nt][1] + bias));
                o.y = pk2(bf_lo(u2.y) * (acc[mt][nt][2] + bias), bf_hi(u2.y) * (acc[mt][nt][3] + bias));
                *(u32x2*)up = o; } }
    }
}
template <int WIN, bool SAMPLE>
__device__ __forceinline__ void p2b_rows(const Args& a, const float* P, bf16_t* Z, int grow0, int ch) {
#pragma unroll 1
    for (int r4 = 0; r4 < 32; r4 += 4) {
        float v[4][WIN];
#pragma unroll
        for (int i = 0; i < 4; ++i) { const int grow = grow0 + r4 + i;
            if (!SAMPLE) { const int t = grow & 2047;
#pragma unroll
                for (int k = 0; k < WIN; ++k) v[i][k] = (t - k >= 0) ? P[(size_t)(grow - k) * 256 + ch] : 0.f;
            } else { const int sr = grow - MP, b = sr >> 3, t = sr & 7;
#pragma unroll
                for (int k = 0; k < WIN; ++k) v[i][k] = (t - k >= 0) ? P[(size_t)(grow - k) * 256 + ch] : a.state_pool[((size_t)b * 15 + 15 + t - k) * 256 + ch];
            } }
#pragma unroll
        for (int i = 0; i < 4; ++i) { const int grow = grow0 + r4 + i; float sum = 0.f;
#pragma unroll
            for (int k = 0; k < WIN; ++k) sum += v[i][k];
            float inv = 1.0f / (float)WIN;
            if (!SAMPLE) { const int t = grow & 2047; if (t + 1 < WIN) inv = 1.0f / (float)(t + 1); }
            Z[(size_t)grow * DIN + 1024 + ch] = (bf16_t)f2bf(sum * inv - v[i][0]); }
    }
}
template <int WIN>
__device__ __forceinline__ void p2b_rows_prompt(const float* P, bf16_t* Z, int grow0, int ch) {
    const int t0 = grow0 & 2047;
    float x[32 + WIN - 1];
#pragma unroll
    for (int j = 0; j < 32 + WIN - 1; ++j) { const int d = j - (WIN - 1); x[j] = (t0 + d >= 0) ? P[(size_t)(grow0 + d) * 256 + ch] : 0.f; }
    float sum = 0.f;
#pragma unroll
    for (int j = 0; j < WIN; ++j) sum += x[j];
#pragma unroll
    for (int i = 0; i < 32; ++i) {
        if (i > 0) sum += x[i + WIN - 1] - x[i - 1];
        const int t = t0 + i; const float inv = (t + 1 < WIN) ? 1.0f / (float)(t + 1) : 1.0f / (float)WIN;
        Z[(size_t)(grow0 + i) * DIN + 1024 + ch] = (bf16_t)f2bf(sum * inv - x[i + WIN - 1]);
    }
}
template <int WIN>
__device__ __forceinline__ void p2b_rows_sample(const Args& a, const float* P, bf16_t* Z, int grow0, int ch) {
    float x[4][8 + WIN - 1];
#pragma unroll
    for (int q = 0; q < 4; ++q) { const int b = (grow0 - MP) / 8 + q;
#pragma unroll
        for (int j = 0; j < 8 + WIN - 1; ++j) { const int d = j - (WIN - 1);
            x[q][j] = d >= 0 ? P[(size_t)(grow0 + 8 * q + d) * 256 + ch] : a.state_pool[((size_t)b * 15 + 15 + d) * 256 + ch]; } }
#pragma unroll
    for (int q = 0; q < 4; ++q) { float sum = 0.f;
#pragma unroll
        for (int j = 0; j < WIN; ++j) sum += x[q][j];
#pragma unroll
        for (int i = 0; i < 8; ++i) { if (i > 0) sum += x[q][i + WIN - 1] - x[q][i - 1];
            Z[(size_t)(grow0 + 8 * q + i) * DIN + 1024 + ch] = (bf16_t)f2bf(sum * (1.0f / (float)WIN) - x[q][i + WIN - 1]); } }
}
__device__ __forceinline__ void p2b_unit(const Args& a, int u, int tid) {
    bf16_t* Z = (bf16_t*)(a.ws + WS_Z);
    const float* P = (const float*)((const unsigned char*)a.out + OS_P);
    const int ch = tid & 255, grow0 = u * 64 + (tid >> 8) * 32, gi = __builtin_amdgcn_readfirstlane(ch >> 6);
    if (grow0 < MP) { if (gi == 0) p2b_rows_prompt<2>(P, Z, grow0, ch); else if (gi == 1) p2b_rows_prompt<4>(P, Z, grow0, ch); else if (gi == 2) p2b_rows_prompt<8>(P, Z, grow0, ch); else p2b_rows_prompt<16>(P, Z, grow0, ch); }
    else { if (gi == 0) p2b_rows_sample<2>(a, P, Z, grow0, ch); else if (gi == 1) p2b_rows_sample<4>(a, P, Z, grow0, ch); else if (gi == 2) p2b_rows_sample<8>(a, P, Z, grow0, ch); else p2b_rows_sample<16>(a, P, Z, grow0, ch); }
}
__device__ __forceinline__ void attn_wave(const Args& a, int qrow0, int valid, int kvb, int h, int lane) {
    bf16_t* Z = (bf16_t*)(a.ws + WS_Z);
    const bf16_t* KB = (const bf16_t*)((const unsigned char*)a.out + OS_KB) + (size_t)kvb * 65536 + h * 64;
    const bf16_t* VT = (const bf16_t*)((const unsigned char*)a.out + OS_VTB) + (size_t)kvb * 65536 + (size_t)(h * 64) * 256;
    const int fr = lane & 15, fq = lane >> 4;
    const int qr = qrow0 + (fr < valid ? fr : valid - 1);
    bf16x8 qf[2];
#pragma unroll
    for (int ks = 0; ks < 2; ++ks) qf[ks] = *(const bf16x8*)(Z + (size_t)qr * DIN + 1280 + h * 64 + 32 * ks + 8 * fq);
    f32x4 s[16];
#pragma unroll
    for (int t = 0; t < 16; ++t) { s[t] = (f32x4){0.f, 0.f, 0.f, 0.f};
        const int key = 32 * (t >> 1) + 8 * (fr >> 2) + 4 * (t & 1) + (fr & 3);
#pragma unroll
        for (int ks = 0; ks < 2; ++ks) { bf16x8 kf;
            if (kvb < 8) kf = *(const bf16x8*)(KB + (size_t)key * 256 + 32 * ks + 8 * fq);
            else { const f32x4* kp = (const f32x4*)(a.cache_k + (size_t)(kvb - 8) * 65536 + (size_t)key * 256 + h * 64 + 32 * ks + 8 * fq); const f32x4 k0 = __builtin_nontemporal_load(kp), k1 = __builtin_nontemporal_load(kp + 1);
                u32x4 kw; kw.x = pk2(k0[0], k0[1]); kw.y = pk2(k0[2], k0[3]); kw.z = pk2(k1[0], k1[1]); kw.w = pk2(k1[2], k1[3]); kf = __builtin_bit_cast(bf16x8, kw); }
            s[t] = __builtin_amdgcn_mfma_f32_16x16x32_bf16(kf, qf[ks], s[t], 0, 0, 0); } }
    float mx = -3.0e38f;
#pragma unroll
    for (int t = 0; t < 16; ++t) mx = fmaxf(mx, fmaxf(fmaxf(s[t][0], s[t][1]), fmaxf(s[t][2], s[t][3])));
    mx = fmaxf(mx, __shfl_xor(mx, 16)); mx = fmaxf(mx, __shfl_xor(mx, 32));
    const float sc = 0.125f * 1.4426950409f; float sum = 0.f;
#pragma unroll
    for (int t = 0; t < 16; ++t)
#pragma unroll
        for (int e = 0; e < 4; ++e) { const float p = __builtin_amdgcn_exp2f((s[t][e] - mx) * sc); s[t][e] = p; sum += p; }
    sum += __shfl_xor(sum, 16); sum += __shfl_xor(sum, 32);
    const float rs = 1.0f / sum;
    f32x4 o[4];
#pragma unroll
    for (int dt = 0; dt < 4; ++dt) o[dt] = (f32x4){0.f, 0.f, 0.f, 0.f};
#pragma unroll
    for (int sk = 0; sk < 8; ++sk) { u32x4 pw; pw.x = pk2(s[2 * sk][0], s[2 * sk][1]); pw.y = pk2(s[2 * sk][2], s[2 * sk][3]); pw.z = pk2(s[2 * sk + 1][0], s[2 * sk + 1][1]); pw.w = pk2(s[2 * sk + 1][2], s[2 * sk + 1][3]);
        const bf16x8 pf = __builtin_bit_cast(bf16x8, pw);
#pragma unroll
        for (int dt = 0; dt < 4; ++dt) { const bf16x8 vf = *(const bf16x8*)(VT + (size_t)(16 * dt + fr) * 256 + 32 * sk + 8 * fq);
            o[dt] = __builtin_amdgcn_mfma_f32_16x16x32_bf16(vf, pf, o[dt], 0, 0, 0); } }
    if (fr < valid) {
#pragma unroll
        for (int dt = 0; dt < 4; ++dt) { u32x2 w; w.x = pk2(o[dt][0] * rs, o[dt][1] * rs); w.y = pk2(o[dt][2] * rs, o[dt][3] * rs);
            *(u32x2*)(Z + (size_t)(qrow0 + fr) * DIN + 1280 + h * 64 + 16 * dt + 4 * fq) = w; } }
}
__device__ __forceinline__ void attn_block_prompt(const Args& a, LAS unsigned char* lds, int c, int h, int tid) {
    const int w = tid >> 6, lane = tid & 63, fr = lane & 15, fq = lane >> 4, kvb = c >> 4, qrow0 = c * 128 + 16 * w;
    bf16_t* Z = (bf16_t*)(a.ws + WS_Z);
    const bf16_t* KB = (const bf16_t*)((const unsigned char*)a.out + OS_KB) + (size_t)kvb * 65536 + h * 64;
    const bf16_t* VT = (const bf16_t*)((const unsigned char*)a.out + OS_VTB) + (size_t)kvb * 65536 + (size_t)(h * 64) * 256;
    u32x4 kst[4], vst[4];
#pragma unroll
    for (int i = 0; i < 4; ++i) { const int ck = tid + 512 * i;
        kst[i] = *(const u32x4*)(KB + (size_t)(ck >> 3) * 256 + (ck & 7) * 8);
        vst[i] = *(const u32x4*)(VT + (size_t)(ck >> 5) * 256 + (ck & 31) * 8); }
    bf16x8 qf[2];
#pragma unroll
    for (int ks = 0; ks < 2; ++ks) qf[ks] = *(const bf16x8*)(Z + (size_t)(qrow0 + fr) * DIN + 1280 + h * 64 + 32 * ks + 8 * fq);
    __syncthreads();
#pragma unroll
    for (int i = 0; i < 4; ++i) { const int ck = tid + 512 * i;
        *(LAS u32x4*)(lds + (ck >> 3) * 144 + (ck & 7) * 16) = kst[i];
        *(LAS u32x4*)(lds + 36864 + (ck >> 5) * 528 + (ck & 31) * 16) = vst[i]; }
    __syncthreads();
    f32x4 s[16];
#pragma unroll
    for (int t = 0; t < 16; ++t) { s[t] = (f32x4){0.f, 0.f, 0.f, 0.f};
        const int key = 32 * (t >> 1) + 8 * (fr >> 2) + 4 * (t & 1) + (fr & 3);
#pragma unroll
        for (int ks = 0; ks < 2; ++ks) { const bf16x8 kf = *(const LAS bf16x8*)(lds + key * 144 + (32 * ks + 8 * fq) * 2);
            s[t] = __builtin_amdgcn_mfma_f32_16x16x32_bf16(kf, qf[ks], s[t], 0, 0, 0); } }
    float mx = -3.0e38f;
#pragma unroll
    for (int t = 0; t < 16; ++t) mx = fmaxf(mx, fmaxf(fmaxf(s[t][0], s[t][1]), fmaxf(s[t][2], s[t][3])));
    mx = fmaxf(mx, __shfl_xor(mx, 16)); mx = fmaxf(mx, __shfl_xor(mx, 32));
    const float sc = 0.125f * 1.4426950409f; float sum = 0.f;
#pragma unroll
    for (int t = 0; t < 16; ++t)
#pragma unroll
        for (int e = 0; e < 4; ++e) { const float pe = __builtin_amdgcn_exp2f((s[t][e] - mx) * sc); s[t][e] = pe; sum += pe; }
    sum += __shfl_xor(sum, 16); sum += __shfl_xor(sum, 32);
    const float rs = 1.0f / sum;
    f32x4 o[4];
#pragma unroll
    for (int dt = 0; dt < 4; ++dt) o[dt] = (f32x4){0.f, 0.f, 0.f, 0.f};
#pragma unroll
    for (int sk = 0; sk < 8; ++sk) { u32x4 pw; pw.x = pk2(s[2 * sk][0], s[2 * sk][1]); pw.y = pk2(s[2 * sk][2], s[2 * sk][3]); pw.z = pk2(s[2 * sk + 1][0], s[2 * sk + 1][1]); pw.w = pk2(s[2 * sk + 1][2], s[2 * sk + 1][3]);
        const bf16x8 pf = __builtin_bit_cast(bf16x8, pw);
#pragma unroll
        for (int dt = 0; dt < 4; ++dt) { const bf16x8 vf = *(const LAS bf16x8*)(lds + 36864 + (16 * dt + fr) * 528 + (32 * sk + 8 * fq) * 2);
            o[dt] = __builtin_amdgcn_mfma_f32_16x16x32_bf16(vf, pf, o[dt], 0, 0, 0); } }
#pragma unroll
    for (int dt = 0; dt < 4; ++dt) { u32x2 wv; wv.x = pk2(o[dt][0] * rs, o[dt][1] * rs); wv.y = pk2(o[dt][2] * rs, o[dt][3] * rs);
        *(u32x2*)(Z + (size_t)(qrow0 + fr) * DIN + 1280 + h * 64 + 16 * dt + 4 * fq) = wv; }
}
__device__ __forceinline__ void p2_mixers(const Args& a, LAS unsigned char* lds, int tid, int G) {
    const int w = tid >> 6, lane = tid & 63;
    {
        const float* P = (const float*)((const unsigned char*)a.out + OS_P);
        for (int idx = blockIdx.x * 512 + tid; idx < 30720 + 491520; idx += G * 512) {
            if (idx < 30720) { const int b = idx / 3840, rem = idx % 3840; a.out[O_PP + idx] = P[(size_t)(b * 2048 + 2033) * 256 + rem]; }
            else { const int j = idx - 30720, b = j / 3840, rem = j % 3840, s = rem >> 8, cc = rem & 255;
                a.out[O_PS + j] = s < 7 ? a.state_pool[((size_t)b * 15 + 8 + s) * 256 + cc] : P[(size_t)(MP + b * 8 + (s - 7)) * 256 + cc]; } }
    }
    for (int it = blockIdx.x; it < 136; it += G) p2a_unit(a, lds, it, tid);
    { int u0 = ((int)blockIdx.x - 136) % G; if (u0 < 0) u0 += G;
      for (int u = u0; u < 272; u += G) p2b_unit(a, u, tid); }
    { int u0 = ((int)blockIdx.x - 408) % G; if (u0 < 0) u0 += G;
      for (int idx = u0; idx < 576; idx += G) {
        if (idx < 512) { attn_block_prompt(a, lds, idx >> 2, idx & 3, tid); }
        else { const int batch = 2 * (idx - 512) + (w >> 2); attn_wave(a, MP + 8 * batch, 8, 8 + batch, w & 3, lane); } } }
}
__device__ __forceinline__ void p7_final(const Args& a, LAS unsigned char* lds, int tid, int G) {
    const int wave = tid >> 6, lane = tid & 63;
    const f32x4* gr = (const f32x4*)a.g_final + lane;
    const bool split = (G == 256);
    for (int r2 = blockIdx.x * 8 + wave; r2 < (split ? 0 : MT) / 2; r2 += G * 8) {
        f32x4* xa = (f32x4*)(a.out + (size_t)(2 * r2) * DM) + lane; f32x4* xb = xa + DM / 4; f32x4 v[2][4]; float s0 = 0.f, s1 = 0.f;
#pragma unroll
        for (int j = 0; j < 4; ++j) { v[0][j] = xa[64 * j]; v[1][j] = xb[64 * j]; }
#pragma unroll
        for (int j = 0; j < 4; ++j) { s0 += (v[0][j][0] * v[0][j][0] + v[0][j][1] * v[0][j][1]) + (v[0][j][2] * v[0][j][2] + v[0][j][3] * v[0][j][3]);
                                      s1 += (v[1][j][0] * v[1][j][0] + v[1][j][1] * v[1][j][1]) + (v[1][j][2] * v[1][j][2] + v[1][j][3] * v[1][j][3]); }
        const float r0 = 1.0f / sqrtf(wave_sum(s0) * (1.0f / DM) + EPS), r1 = 1.0f / sqrtf(wave_sum(s1) * (1.0f / DM) + EPS);
#pragma unroll
        for (int j = 0; j < 4; ++j) { const f32x4 gg = gr[64 * j]; xa[64 * j] = v[0][j] * r0 * gg; xb[64 * j] = v[1][j] * r1 * gg; }
    }
    if (split) {
        LAS float* red = (LAS float*)lds;
        const int rr = tid >> 7, t7 = tid & 127, c8 = t7 * 8;
        const f32x4 g0 = *(const f32x4*)(a.g_final + c8), g1 = *(const f32x4*)(a.g_final + c8 + 4);
        for (int sr0 = blockIdx.x * 4; sr0 < MS; sr0 += G * 4) { const int sr = sr0 + rr;
            const u32x4 xw = __builtin_nontemporal_load((const u32x4*)((const bf16_t*)(a.ws + WS_X1B_HI) + (size_t)(MP + sr - X1B_SPLIT * 256) * DM + c8));
            f32x4 pv[16][2];
#pragma unroll
            for (int k = 0; k < 16; ++k) { const f32x4* pp = (const f32x4*)(part_base(a.ws, k) + (size_t)sr * DM + c8); pv[k][0] = pp[0]; pv[k][1] = pp[1]; }
            f32x4 v0 = (f32x4){bf_lo(xw.x), bf_hi(xw.x), bf_lo(xw.y), bf_hi(xw.y)}, v1 = (f32x4){bf_lo(xw.z), bf_hi(xw.z), bf_lo(xw.w), bf_hi(xw.w)};
#pragma unroll
            for (int k = 0; k < 16; ++k) { v0 += pv[k][0]; v1 += pv[k][1]; }
            const float ws_ = wave_sum((v0[0] * v0[0] + v0[1] * v0[1]) + (v0[2] * v0[2] + v0[3] * v0[3]) + (v1[0] * v1[0] + v1[1] * v1[1]) + (v1[2] * v1[2] + v1[3] * v1[3]));
            __syncthreads();
            if (lane == 0) red[wave] = ws_;
            __syncthreads();
            const float rstd = 1.0f / sqrtf((red[2 * rr] + red[2 * rr + 1]) * (1.0f / DM) + EPS);
            float* xo = a.out + (size_t)(MP + sr) * DM + c8;
            __builtin_nontemporal_store(v0 * rstd * g0, (f32x4*)xo); __builtin_nontemporal_store(v1 * rstd * g1, (f32x4*)(xo + 4));
        }
    }
}

#define XB_TMO      128
#define XB_XCNT(j)  (256  + 64 * (j))
#define XB_XSUB(j)  (1280 + 64 * (j))
#define XB_XGEN(j)  (2304 + 64 * (j))
#define XB_TOP      3328
#define XB_TOPGEN   3392
#define XCD_BAR_WORDS 3456
#define XB_SPIN_CAP (1u << 18)
__device__ __forceinline__ unsigned xb_ld(unsigned* p)              { return __hip_atomic_load(p, __ATOMIC_RELAXED, __HIP_MEMORY_SCOPE_AGENT); }
__device__ __forceinline__ unsigned xb_add(unsigned* p, unsigned v) { return __hip_atomic_fetch_add(p, v, __ATOMIC_RELAXED, __HIP_MEMORY_SCOPE_AGENT); }
__device__ __forceinline__ unsigned xb_xcc_id() { return (unsigned)__builtin_amdgcn_s_getreg((3 << 11) | 20) & 0xFu; }
#define XB_SPIN(cond, bar) do { unsigned _sp = 0; while (cond) { __builtin_amdgcn_s_sleep(1); \
    if ((++_sp & 255u) == 0u) { if (xb_ld(&(bar)[XB_TMO])) break; if (_sp > XB_SPIN_CAP) { atomicAdd(&(bar)[XB_TMO], 1u); break; } } } } while (0)
struct XcdBarrier { unsigned* bar; unsigned x; volatile LAS unsigned* st; };
__device__ __forceinline__ XcdBarrier xcd_barrier_post(unsigned* bar, volatile LAS unsigned* st, int wave_s) {
    XcdBarrier b; b.bar = bar; b.x = xb_xcc_id(); b.st = st;
    if (wave_s == 0 && lane_id() == 0) (void)xb_add(&bar[XB_XCNT(b.x)], 1u);
    return b;
}
__device__ __forceinline__ void xcd_barrier_complete(unsigned* bar, unsigned x, unsigned& nloc, unsigned& nx) {
    const unsigned G = gridDim.x * gridDim.y * gridDim.z;
    unsigned sum, cnt, mine, sp = 0u;
    for (;;) {
        sum = 0u; cnt = 0u; mine = 0u;
#pragma unroll
        for (unsigned j = 0; j < 16; ++j) { const unsigned c = xb_ld(&bar[XB_XCNT(j)]); sum += c; cnt += (c > 0u) ? 1u : 0u; mine = (j == x) ? c : mine; }
        if (sum == G) break;
        __builtin_amdgcn_s_sleep(1);
        if ((++sp & 255u) == 0u) { if (xb_ld(&bar[XB_TMO])) break; if (sp > XB_SPIN_CAP) { atomicAdd(&bar[XB_TMO], 1u); break; } }
    }
    nloc = mine > 0u ? mine : 1u; nx = cnt > 0u ? cnt : 1u;
}
__device__ __forceinline__ void xcd_barrier(const XcdBarrier& b, int wave_s) {
    asm volatile("s_waitcnt vmcnt(0)" ::: "memory");
    __syncthreads();
    if (wave_s == 0 && lane_id() == 0) {
        unsigned* bar = b.bar;
        __builtin_amdgcn_s_waitcnt(0);
        unsigned nloc = b.st[0], nx = b.st[1];
        if (nloc == 0u) { xcd_barrier_complete(bar, b.x, nloc, nx); b.st[0] = nloc; b.st[1] = nx; }
        const unsigned old = xb_add(&bar[XB_XSUB(b.x)], 1u);
        const unsigned gen = old / nloc;
        if (old + 1u == (gen + 1u) * nloc) {
            __builtin_amdgcn_fence(__ATOMIC_RELEASE, "agent");
            asm volatile("s_waitcnt vmcnt(0)" ::: "memory");
            const unsigned og = xb_add(&bar[XB_TOP], 1u);
            const unsigned tg = og / nx;
            if (og + 1u == (tg + 1u) * nx) xb_add(&bar[XB_TOPGEN], 1u);
            else XB_SPIN(xb_ld(&bar[XB_TOPGEN]) == tg, bar);
            __builtin_amdgcn_fence(__ATOMIC_ACQUIRE, "agent");
            xb_add(&bar[XB_XGEN(b.x)], 1u);
            asm volatile("s_waitcnt vmcnt(0)" ::: "memory");
        } else {
            XB_SPIN(xb_ld(&bar[XB_XGEN(b.x)]) == gen, bar);
            __builtin_amdgcn_fence(__ATOMIC_ACQUIRE, "agent");
            asm volatile("s_waitcnt vmcnt(0)" ::: "memory");
        }
    }
    __syncthreads();
}

__device__ __forceinline__ void panel_signal(unsigned* cnt, int wave_s) {
    asm volatile("s_waitcnt vmcnt(0)" ::: "memory");
    __syncthreads();
    if (wave_s == 0 && lane_id() == 0) (void)xb_add(cnt, 1u);
}
__device__ __forceinline__ void panel_wait(unsigned* cnt, unsigned want, unsigned* bar, int wave_s) {
    if (wave_s == 0 && lane_id() == 0) { XB_SPIN(xb_ld(cnt) < want, bar); __builtin_amdgcn_fence(__ATOMIC_ACQUIRE, "agent"); asm volatile("s_waitcnt vmcnt(0)" ::: "memory"); }
    __syncthreads();
}

template <bool P3S>
__device__ __forceinline__ void mini_block(const Args& a, LAS unsigned char* lds, int blk, int tid) {
    const int w = tid >> 6, lane = tid & 63, fr = lane & 15, fq = lane >> 4, rb = blk >> 4, cb = blk & 15;
    const int k0 = 128 * w;
    const bf16_t* Ab; int lda, acol;
    if (P3S) { Ab = (const bf16_t*)(a.ws + WS_Z); lda = DIN; acol = k0 + (k0 >= 512 ? 512 : 0); }
    else { Ab = (const bf16_t*)(a.ws + WS_XN); lda = DM; acol = k0; }
    const bf16_t* Bb = (const bf16_t*)(a.ws + (P3S ? WS_WBR : WS_WO));
    bf16x8 af[4][4], bf[4][4];
#pragma unroll
    for (int t = 0; t < 4; ++t)
#pragma unroll
        for (int ks = 0; ks < 4; ++ks) { af[t][ks] = *(const bf16x8*)(Ab + (size_t)(MP + 64 * rb + 16 * t + fr) * lda + acol + 32 * ks + 8 * fq);
                                         bf[t][ks] = *(const bf16x8*)(Bb + (size_t)(64 * cb + 16 * t + fr) * 1024 + k0 + 32 * ks + 8 * fq); }
    f32x4 acc[4][4];
#pragma unroll
    for (int mt = 0; mt < 4; ++mt)
#pragma unroll
        for (int nt = 0; nt < 4; ++nt) acc[mt][nt] = (f32x4){0.f, 0.f, 0.f, 0.f};
#pragma unroll
    for (int ks = 0; ks < 4; ++ks)
#pragma unroll
        for (int mt = 0; mt < 4; ++mt)
#pragma unroll
            for (int nt = 0; nt < 4; ++nt) acc[mt][nt] = __builtin_amdgcn_mfma_f32_16x16x32_bf16(bf[nt][ks], af[mt][ks], acc[mt][nt], 0, 0, 0);
    LAS float* red = (LAS float*)lds;
    __syncthreads();
#pragma unroll
    for (int mt = 0; mt < 4; ++mt)
#pragma unroll
        for (int nt = 0; nt < 4; ++nt) *(LAS f32x4*)(red + (size_t)((w * 64 + 16 * mt + fr) * 68 + 16 * nt + 4 * fq)) = acc[mt][nt];
    __syncthreads();
    const int r = tid >> 3, c8 = (tid & 7) * 8, row = MP + 64 * rb + r, col = 64 * cb + c8;
    f32x4 s0[3], s1[3];
#pragma unroll
    for (int g = 0; g < 3; ++g) { s0[g] = (f32x4){0.f, 0.f, 0.f, 0.f}; s1[g] = s0[g]; }
#pragma unroll
    for (int ww = 0; ww < 8; ++ww) { const int g = P3S ? (ww < 4 ? 0 : (ww < 6 ? 1 : 2)) : 0; const LAS f32x4* pp = (const LAS f32x4*)(red + (size_t)((ww * 64 + r) * 68 + c8)); s0[g] += pp[0]; s1[g] += pp[1]; }
    if (P3S) {
        bf16_t* MG = (bf16_t*)(a.ws + WS_XN);
        const unsigned char* gp = (const unsigned char*)(a.ws + WS_Z) + (size_t)row * (DIN * 2) + 3072 + col;
        const u32x2 qa = *(const u32x2*)gp, qb = *(const u32x2*)(gp + 1024), qc = *(const u32x2*)(gp + 2048); const float k = 1.0f / 255.0f;
        float m[8];
        m[0] = (s0[0][0] * ub0(qa.x) + s0[1][0] * ub0(qb.x) + s0[2][0] * ub0(qc.x)) * k; m[1] = (s0[0][1] * ub1(qa.x) + s0[1][1] * ub1(qb.x) + s0[2][1] * ub1(qc.x)) * k;
        m[2] = (s0[0][2] * ub2(qa.x) + s0[1][2] * ub2(qb.x) + s0[2][2] * ub2(qc.x)) * k; m[3] = (s0[0][3] * ub3(qa.x) + s0[1][3] * ub3(qb.x) + s0[2][3] * ub3(qc.x)) * k;
        m[4] = (s1[0][0] * ub0(qa.y) + s1[1][0] * ub0(qb.y) + s1[2][0] * ub0(qc.y)) * k; m[5] = (s1[0][1] * ub1(qa.y) + s1[1][1] * ub1(qb.y) + s1[2][1] * ub1(qc.y)) * k;
        m[6] = (s1[0][2] * ub2(qa.y) + s1[1][2] * ub2(qb.y) + s1[2][2] * ub2(qc.y)) * k; m[7] = (s1[0][3] * ub3(qa.y) + s1[1][3] * ub3(qb.y) + s1[2][3] * ub3(qc.y)) * k;
        u32x4 o; o.x = pk2(m[0], m[1]); o.y = pk2(m[2], m[3]); o.z = pk2(m[4], m[5]); o.w = pk2(m[6], m[7]);
        *(u32x4*)(MG + (size_t)row * DM + col) = o;
    } else {
        const f32x4* xp = (const f32x4*)(a.x_sample + (size_t)(row - MP) * DM + col);
        const f32x4 v0 = s0[0] + __builtin_nontemporal_load(xp), v1 = s1[0] + __builtin_nontemporal_load(xp + 1);
        u32x4 o; o.x = pk2(v0[0], v0[1]); o.y = pk2(v0[2], v0[3]); o.z = pk2(v1[0], v1[1]); o.w = pk2(v1[2], v1[3]);
        *(u32x4*)((bf16_t*)(a.ws + WS_X1B_HI) + (size_t)(row - X1B_SPLIT * 256) * DM + col) = o;
        float ss = (v0[0] * v0[0] + v0[1] * v0[1]) + (v0[2] * v0[2] + v0[3] * v0[3]) + (v1[0] * v1[0] + v1[1] * v1[1]) + (v1[2] * v1[2] + v1[3] * v1[3]);
        ss += __shfl_xor(ss, 1); ss += __shfl_xor(ss, 2); ss += __shfl_xor(ss, 4);
        if ((tid & 7) == 0) ((float*)(a.ws + WS_SSP))[(size_t)row * 16 + cb] = ss;
    }
    __syncthreads();
}

__global__ void __launch_bounds__(512, 2) fwd_kernel(Args a) {
    extern __shared__ __attribute__((aligned(16))) unsigned char lds_raw[];
    LAS unsigned char* lds = (LAS unsigned char*)lds_raw;
    cg::grid_group grid = cg::this_grid();
    const int wave_s = __builtin_amdgcn_readfirstlane((int)threadIdx.x >> 6);
#define tid (wave_s * 64 + lane_id())
    const int G = gridDim.x, c = blockIdx.x;
    const int lo = a.ph_lo, hi = a.ph_hi;
#define IN(k) (lo <= (k) && (k) < hi)
#define SEAM(k) do { if (IN(k) && IN((k) + 1)) xcd_barrier(bar, wave_s); } while (0)
    if (tid < 64) ((LAS unsigned*)(lds + 147456))[tid] = 0u;
    __syncthreads();
    const XcdBarrier bar = xcd_barrier_post((unsigned*)a.ws, (volatile LAS unsigned*)(lds + 147456), wave_s);
    if (lo < 0) grid.sync();
    bf16_t* XN = (bf16_t*)(a.ws + WS_XN); bf16_t* Z = (bf16_t*)(a.ws + WS_Z); bf16_t* MG = XN; bf16_t* H = Z; bf16_t* X1Blo = (bf16_t*)(a.ws + WS_X1B_LO); bf16_t* X1Bhi = (bf16_t*)(a.ws + WS_X1B_HI);
    float* SSP = (float*)(a.ws + WS_SSP);
    constexpr int REPS[8] = {1, 1, 1, 1, 1, 1, 1, 1};
    if (IN(0)) { for (int rep = 0; rep < REPS[0]; ++rep) p0_prologue(a, lds, tid, G); } SEAM(0);
    if (IN(1)) { for (int rep = 0; rep < REPS[1]; ++rep) { pg8::Gemm g{XN, (const bf16_t*)(a.ws + WS_WIN), 1024, 1024, nullptr, 1 << 30}; SchedP1 S{G, c};
        EpiP1 E{Z, (float*)((unsigned char*)a.out + OS_P), a.out + O_MK, a.out + O_MV, (bf16_t*)((unsigned char*)a.out + OS_KB), (bf16_t*)((unsigned char*)a.out + OS_VTB)};
        pg8::gemm_phase(lds, g, S, E, wave_s); } } SEAM(1);
    if (IN(2)) { p2_mixers(a, lds, tid, G); } SEAM(2);
    if (IN(3)) {
        unsigned* cnt = (unsigned*)a.ws + 8192;
        const pg8::Gemm g3{Z, (const bf16_t*)(a.ws + WS_WBR), DIN, 1024, nullptr, 1 << 30}; const EpiP3 E3{Z, MG, G != 256};
        const pg8::Gemm g4{MG, (const bf16_t*)(a.ws + WS_WO), 1024, 1024, nullptr, 1 << 30}; const EpiP4 E4{a.x_prompt, a.x_sample, a.out, X1Blo, X1Bhi, SSP, (float*)(a.ws + WS_SSP4), lds};
        if (G == 256) {
            int pm, pn; pg8::tile_map(64, 4, c, pm, pn);
            { SchedOne3 S{pm, pn}; pg8::gemm_phase(lds, g3, S, E3, wave_s); }
            mini_block<true>(a, lds, c, tid);
            xcd_barrier(bar, wave_s);
            { SchedOne S{pm, pn, 16}; pg8::gemm_phase(lds, g4, S, E4, wave_s); }
            mini_block<false>(a, lds, c, tid);
        } else {
            for (int L = c; L < 272; L += G) { int pm, pn; tile272(L, pm, pn); SchedOne3 S{pm, pn}; pg8::gemm_phase(lds, g3, S, E3, wave_s); panel_signal(cnt + 64 * pm, wave_s); }
            int L0 = (c - 16) % G; if (L0 < 0) L0 += G;
            for (int L = L0; L < 272; L += G) { int pm, pn; tile272(L, pm, pn); panel_wait(cnt + 64 * pm, 4u, (unsigned*)a.ws, wave_s); SchedOne S{pm, pn, 16}; pg8::gemm_phase(lds, g4, S, E4, wave_s); }
        }
        p0_deferred(a, lds, tid, G);
    } SEAM(4);
    if (IN(5)) { for (int rep = 0; rep < REPS[5]; ++rep) { pg8::Gemm g{X1Blo, (const bf16_t*)(a.ws + WS_WUP), 1024, 1024, X1Bhi, X1B_SPLIT}; SchedT S{68, 16, 16, G, c}; EpiP5 E{SSP, H, (const float*)(a.ws + WS_SSP4), G == 256 ? 64 : 68}; pg8::gemm_phase(lds, g, S, E, wave_s); } } SEAM(5);
    if (IN(6)) { pg8::Gemm g{H, (const bf16_t*)(a.ws + WS_WDN), DFF, DFF, nullptr, 1 << 30}; SchedP6 S{G, c};
        if (G == 256) { EpiP6F E{a.out, a.ws, X1Blo, X1Bhi, a.out + (size_t)MP * DM  , (unsigned*)a.ws + 8192 + 64 * 68, (unsigned*)a.ws, a.g_final, lds}; pg8::gemm_phase(lds, g, S, E, wave_s); }
        else { EpiP6 E{a.out, a.ws, X1Blo, X1Bhi}; pg8::gemm_phase(lds, g, S, E, wave_s); } } SEAM(6);
    if (IN(7)) { p7_final(a, lds, tid, G); }
#undef IN
#undef SEAM
#undef tid
}

extern "C" void kernel_launch(void* const* d_in, const int* in_sizes, int n_in, void* d_out, int out_size, void* d_ws, size_t ws_size, hipStream_t stream) {
    static int grid = 0;
    if (grid == 0) {
        int dev = 0, cus = 0, per_cu = 0;
        if (n_in != 24 || ws_size < 256 * MiB) { fprintf(stderr, "kernel_launch: unexpected n_in %d / ws %zu\n", n_in, ws_size); grid = -1; return; }
        (void)hipGetDevice(&dev);
        (void)hipDeviceGetAttribute(&cus, hipDeviceAttributeMultiprocessorCount, dev);
        if (hipFuncSetAttribute((const void*)fwd_kernel, hipFuncAttributeMaxDynamicSharedMemorySize, LDS_BYTES) != hipSuccess) fprintf(stderr, "kernel_launch: hipFuncSetAttribute failed\n");
        if (hipOccupancyMaxActiveBlocksPerMultiprocessor(&per_cu, (const void*)fwd_kernel, 512, LDS_BYTES) != hipSuccess || per_cu < 1) per_cu = 1;
        (void)hipGetLastError();
        grid = cus * per_cu;
        if (grid <= 0) grid = 256;
    }
    if (grid < 0) return;
    if (hipMemsetAsync(d_ws, 0, 131072, stream) != hipSuccess) { fprintf(stderr, "kernel_launch: memset failed\n"); return; }
    Args a{};
    const float** pp = (const float**)&a;
    for (int i = 0; i < 24; ++i) pp[i] = (const float*)d_in[i];
    a.out = (float*)d_out; a.ws = (unsigned char*)d_ws; a.ph_lo = 0; a.ph_hi = 8;
    void* args[] = {&a};
    hipError_t e = hipLaunchCooperativeKernel((const void*)fwd_kernel, dim3(grid), dim3(512), args, LDS_BYTES, stream);
    if (e != hipSuccess) fprintf(stderr, "kernel_launch: cooperative launch failed: %s (grid %d)\n", hipGetErrorString(e), grid);
}
```

```cpp
#include <hip/hip_runtime.h>
#include <hip/hip_cooperative_groups.h>
#include <cstdio>
#include <cstdint>
namespace cg = cooperative_groups;

#define LAS __attribute__((address_space(3)))
typedef unsigned short bf16_t;
typedef short bf16x8 __attribute__((ext_vector_type(8)));
typedef float f32x4 __attribute__((ext_vector_type(4)));
typedef float f32x2 __attribute__((ext_vector_type(2)));
typedef unsigned u32x4 __attribute__((ext_vector_type(4)));
typedef unsigned u32x2 __attribute__((ext_vector_type(2)));

constexpr int DM = 1024, MP = 16384, MS = 1024, MT = MP + MS  , DIN = 4608, DFF = 4096;
constexpr int MKV = 2048;
constexpr float EPS = 1e-6f;
constexpr size_t MiB = 1u << 20;
constexpr size_t WS_WIN = 1 * MiB;
constexpr size_t WS_WO = 11 * MiB;
constexpr size_t WS_WUP = 13 * MiB;
constexpr size_t WS_WDN = 21 * MiB;
constexpr size_t WS_WBR = 29 * MiB;
constexpr size_t WS_WSB = 31 * MiB;
constexpr size_t WS_SSP4 = 2 * MiB + 256 * 1024;
constexpr size_t WS_SSP = 1 * MiB;
constexpr size_t WS_XN = 48 * MiB;
constexpr size_t WS_Z = 86 * MiB;
constexpr size_t WS_X1B_LO = 239 * MiB, WS_X1B_HI = 31 * MiB;
constexpr int X1B_SPLIT = 34;
constexpr size_t OS_P = 0;
constexpr size_t OS_KB = 17 * MiB;
constexpr size_t OS_VTB = 34 * MiB;
constexpr size_t O_Y = 0, O_MK = 17825792, O_MV = 18350080, O_PP = 18874368, O_PS = 18905088, O_CVP = 19396608, O_CVS = 19920896;
constexpr int LDS_BYTES = 147456 + 256;

__device__ __forceinline__ unsigned f2bf(float f) { unsigned u = __builtin_bit_cast(unsigned, f); return (u + 0x7fffu + ((u >> 16) & 1u)) >> 16; }
__device__ __forceinline__ unsigned pk2(float lo, float hi) { return f2bf(lo) | (f2bf(hi) << 16); }
__device__ __forceinline__ float bf_lo(unsigned w) { return __builtin_bit_cast(float, w << 16); }
__device__ __forceinline__ float bf_hi(unsigned w) { return __builtin_bit_cast(float, w & 0xffff0000u); }
__device__ __forceinline__ unsigned cvt_pk_bf16(float lo, float hi) { unsigned r; asm volatile("v_cvt_pk_bf16_f32 %0, %1, %2" : "=v"(r) : "v"(lo), "v"(hi)); return r; }
__device__ __forceinline__ float gelu_t(float x) {
    const float y = 0.7978845608f * (x + 0.044715f * x * x * x);
    const float e = __builtin_amdgcn_exp2f(-2.885390082f * y);
    return x * __builtin_amdgcn_rcpf(1.0f + e);
}
__device__ __forceinline__ unsigned gate_q(float x) { const float g = __builtin_amdgcn_rcpf(1.0f + __builtin_amdgcn_exp2f(-1.4426950409f * x)); return (unsigned)fminf(fmaxf(g * 255.0f + 0.5f, 1.0f), 255.0f); }
__device__ __forceinline__ float ub0(unsigned w) { return (float)(w & 0xffu); }
__device__ __forceinline__ float ub1(unsigned w) { return (float)((w >> 8) & 0xffu); }
__device__ __forceinline__ float ub2(unsigned w) { return (float)((w >> 16) & 0xffu); }
__device__ __forceinline__ float ub3(unsigned w) { return (float)(w >> 24); }
__device__ __forceinline__ f32x2 gelu_t2(f32x2 x) {
    const f32x2 x2 = x * x, pch = x2 * 0.0356774081f + 0.7978845608f, t = (pch * x) * (-2.885390082f);
    f32x2 e; e.x = __builtin_amdgcn_exp2f(t.x); e.y = __builtin_amdgcn_exp2f(t.y);
    const f32x2 d = e + 1.0f; f32x2 r; r.x = __builtin_amdgcn_rcpf(d.x); r.y = __builtin_amdgcn_rcpf(d.y);
    return x * r;
}

__device__ __forceinline__ int lane_id() { int l; asm volatile("v_mbcnt_lo_u32_b32 %0, -1, 0\n\tv_mbcnt_hi_u32_b32 %0, -1, %0" : "=v"(l)); return l; }
struct Args {
    const float *x_prompt, *x_sample, *mem, *cache_k, *cache_v, *state_pool;
    const float *g_mix, *w_in, *g_v, *b_v, *w_s, *b_s, *w_pool, *pool_scale, *g_mem, *w_kv;
    const float *w_out_a, *w_out_b, *w_out_c, *w_o, *g_ffn, *w_up, *w_down, *g_final;
    float* out; unsigned char* ws; int ph_lo, ph_hi;
};

namespace pg8 {
constexpr int BM = 256, BK = 64, HALF = 128, HTB = HALF * BK * 2, STAGE_BYTES = 8 * HTB;
__device__ __forceinline__ int lds_byte(int r, int c) { const int st = (r >> 4) * 2 + (c >> 5), rr = r & 15, cc = c & 31, ob = rr * 64 + cc * 2; return st * 1024 + (ob ^ (((ob >> 9) & 1) << 5)); }
__device__ __forceinline__ void stage_rc(int b, int& R, int& C) { const int st = b / 1024, sb = b % 1024, swz = sb ^ (((sb >> 9) & 1) << 5); R = (st >> 1) * 16 + swz / 64; C = (st & 1) * 32 + (swz % 64) / 2; }
__device__ __forceinline__ int perm32(int rho) { const int n = rho >> 4, i = rho & 15; return 8 * (i >> 2) + 4 * n + (i & 3); }

struct Unit { int pm, pn, ka, kb, nt, tag; };
struct Gemm { const bf16_t* A; const bf16_t* Bt; int lda, ldb; const bf16_t* A2; int psplit; };

__device__ __forceinline__ void tile_map(int nM, int nN, int L, int& pm, int& pn) {
    const int nwg = nM * nN; int wgid = L;
    { const int q = nwg / 8, r = nwg % 8, xcd = wgid % 8, off = wgid / 8; wgid = (xcd < r ? xcd * (q + 1) : r * (q + 1) + (xcd - r) * q) + off; }
    const int nig = 8 * nN, gid = wgid / nig, fm = gid * 8, gsz = (nM - fm) < 8 ? (nM - fm) : 8;
    pm = fm + ((wgid % nig) % gsz); pn = (wgid % nig) / gsz;
}

template <class Epi, class Sched>
__device__ __forceinline__ void gemm_phase(LAS unsigned char* lds, const Gemm g, const Sched& S, const Epi& E, int wave_s) {
    const int wid = wave_s, lane = lane_id(), tid = wid * 64 + lane, wr = wid >> 2, wc = wid & 3, fr = lane & 15, fq = lane >> 4;
    unsigned voffA[2], voffB[2];
#pragma unroll
    for (int i = 0; i < 2; ++i) { int R, C; stage_rc(tid * 16 + i * 8192, R, C); const int Rb = (R & ~31) + perm32(R & 31);
        voffA[i] = (unsigned)(R * g.lda + C) * 2u; voffB[i] = (unsigned)(Rb * g.ldb + C) * 2u; }
    const size_t kstep = (size_t)(BK * 2);
    const size_t hstepA = (size_t)HALF * g.lda * 2, hstepB = (size_t)HALF * g.ldb * 2;
    const size_t tstepA = 2 * hstepA, tstepB = 2 * hstepB;
    const unsigned ldsw = (unsigned)wid * 1024u;
    const int aoff = lds_byte(wr * 64 + fr, fq * 8), boff = lds_byte(wc * 32 + fr, fq * 8);
#define PG8_SA(b, h) (((b) * 2 + (h)) * HTB)
#define PG8_SB(b, h) ((4 + (b) * 2 + (h)) * HTB)
#define PG8_STAGE(bufoff, gbase, voff) do { _Pragma("unroll") for (int _i = 0; _i < 2; ++_i) \
        __builtin_amdgcn_global_load_lds((const unsigned*)((const char*)(gbase) + (voff)[_i]), (LAS unsigned*)(lds + (bufoff) + ldsw + _i * 8192), 16, 0, 0); } while (0)
#define PG8_LDA(dst, b, h) do { _Pragma("unroll") for (int m = 0; m < 4; ++m) _Pragma("unroll") for (int k = 0; k < 2; ++k) dst[m][k] = *(const LAS bf16x8*)(lds + PG8_SA(b, h) + aoff + m * 2048 + k * 1024); } while (0)
#define PG8_LDB(dst, b, h) do { _Pragma("unroll") for (int n = 0; n < 2; ++n) _Pragma("unroll") for (int k = 0; k < 2; ++k) dst[n][k] = *(const LAS bf16x8*)(lds + PG8_SB(b, h) + boff + n * 2048 + k * 1024); } while (0)
#define PG8_MMA(ai, bj, At, Bt) do { __builtin_amdgcn_s_setprio(1); _Pragma("unroll") for (int m = 0; m < 4; ++m) _Pragma("unroll") for (int n = 0; n < 2; ++n) _Pragma("unroll") for (int k = 0; k < 2; ++k) \
        acc[ai][bj][m][n] = __builtin_amdgcn_mfma_f32_16x16x32_bf16(Bt[n][k], At[m][k], acc[ai][bj][m][n], 0, 0, 0); __builtin_amdgcn_s_setprio(0); } while (0)
#define PG8_WAIT_V(n) asm volatile("s_waitcnt vmcnt(" #n ")" ::: "memory")
#define PG8_WAIT_L(n) asm volatile("s_waitcnt lgkmcnt(" #n ")" ::: "memory")
#define PG8_BAR __builtin_amdgcn_s_barrier()
#define PG8_SCHED __builtin_amdgcn_sched_barrier(0)
    Unit cur, nxt; int ui = 0;
    if (!S.next(0, cur)) return;
    f32x4 acc[2][2][4][2];
#pragma unroll
    for (int a = 0; a < 2; ++a)
#pragma unroll
        for (int b = 0; b < 2; ++b)
#pragma unroll
            for (int m = 0; m < 4; ++m)
#pragma unroll
                for (int n = 0; n < 2; ++n) acc[a][b][m][n] = (f32x4){0.f, 0.f, 0.f, 0.f};
    bf16x8 At[4][2], B0[2][2], B1[2][2];
    const char* cA = (cur.pm < g.psplit ? (const char*)g.A + (size_t)cur.pm * tstepA : (const char*)g.A2 + (size_t)(cur.pm - g.psplit) * tstepA) + cur.ka; const char* cB = (const char*)g.Bt + (size_t)cur.pn * tstepB + cur.kb;
    PG8_STAGE(PG8_SB(0, 0), cB, voffB); PG8_STAGE(PG8_SB(0, 1), cB + hstepB, voffB); PG8_STAGE(PG8_SA(0, 0), cA, voffA); PG8_STAGE(PG8_SA(0, 1), cA + hstepA, voffA);
    if (wr == 1) PG8_BAR;
    PG8_WAIT_V(2); PG8_BAR;
    PG8_STAGE(PG8_SB(1, 0), cB + kstep, voffB); PG8_STAGE(PG8_SA(1, 0), cA + kstep, voffA); PG8_STAGE(PG8_SB(1, 1), cB + hstepB + kstep, voffB);
    PG8_WAIT_V(6); PG8_BAR;
    for (;;) {
        const bool has_next = S.next(ui + 1, nxt);
        const char* nA = has_next ? (nxt.pm < g.psplit ? (const char*)g.A + (size_t)nxt.pm * tstepA : (const char*)g.A2 + (size_t)(nxt.pm - g.psplit) * tstepA) + nxt.ka : cA; const char* nB = has_next ? (const char*)g.Bt + (size_t)nxt.pn * tstepB + nxt.kb : cB;
        const int nt = cur.nt;
        for (int t = 0; t < nt; t += 2) {
            const bool last = (t == nt - 2);
            const char* a1 = cA + (size_t)(t + 1) * kstep;
            const char* a2 = last ? nA : cA + (size_t)(t + 2) * kstep; const char* b2 = last ? nB : cB + (size_t)(t + 2) * kstep;
            const char* a3 = a2 + kstep; const char* b3 = b2 + kstep;
            PG8_LDB(B0, 0, 0); PG8_LDB(B1, 0, 1); PG8_SCHED; PG8_LDA(At, 0, 0); PG8_STAGE(PG8_SA(1, 1), a1 + hstepA, voffA);
            PG8_WAIT_V(8); PG8_WAIT_L(0); PG8_BAR; PG8_MMA(0, 0, At, B0); PG8_MMA(0, 1, At, B1); PG8_BAR; PG8_SCHED;
            PG8_LDA(At, 0, 1); PG8_STAGE(PG8_SB(0, 0), b2, voffB); PG8_STAGE(PG8_SB(0, 1), b2 + hstepB, voffB); PG8_STAGE(PG8_SA(0, 0), a2, voffA);
            PG8_WAIT_V(8); PG8_WAIT_L(0); PG8_BAR; PG8_MMA(1, 0, At, B0); PG8_MMA(1, 1, At, B1); PG8_BAR; PG8_SCHED;
            PG8_LDB(B0, 1, 0); PG8_LDB(B1, 1, 1); PG8_SCHED; PG8_LDA(At, 1, 0); PG8_STAGE(PG8_SA(0, 1), a2 + hstepA, voffA);
            PG8_WAIT_V(8); PG8_WAIT_L(0); PG8_BAR; PG8_MMA(0, 0, At, B0); PG8_MMA(0, 1, At, B1); PG8_BAR; PG8_SCHED;
            PG8_LDA(At, 1, 1); PG8_STAGE(PG8_SB(1, 0), b3, voffB); PG8_STAGE(PG8_SB(1, 1), b3 + hstepB, voffB); PG8_STAGE(PG8_SA(1, 0), a3, voffA);
            PG8_WAIT_V(8); PG8_WAIT_L(0); PG8_BAR; PG8_MMA(1, 0, At, B0); PG8_MMA(1, 1, At, B1); PG8_BAR; PG8_SCHED;
        }
        if (wr == 0) PG8_BAR;
        const bool zero = E(acc, cur, wr, wc, fr, fq);
        if (!has_next) break;
        if (zero) {
#pragma unroll
            for (int a = 0; a < 2; ++a)
#pragma unroll
                for (int b = 0; b < 2; ++b)
#pragma unroll
                    for (int m = 0; m < 4; ++m)
#pragma unroll
                        for (int n = 0; n < 2; ++n) acc[a][b][m][n] = (f32x4){0.f, 0.f, 0.f, 0.f};
        }
        cur = nxt; cA = nA; cB = nB; ++ui;
        if (wr == 1) PG8_BAR;
    }
    PG8_WAIT_V(0);
    PG8_BAR;
#undef PG8_SA
#undef PG8_SB
#undef PG8_STAGE
#undef PG8_LDA
#undef PG8_LDB
#undef PG8_MMA
#undef PG8_WAIT_V
#undef PG8_WAIT_L
#undef PG8_BAR
#undef PG8_SCHED
}
}
using pg8::Unit;

struct SchedP1 {
    int G, c;
    __device__ __forceinline__ bool next(int i, Unit& u) const {
        int L = i * G + c;
        if (L < 1224) { pg8::tile_map(68, 18, L, u.pm, u.pn); u.ka = 0; u.kb = 0; u.nt = 16; u.tag = 0; return true; }
        L -= 1224;
        if (L < 16) { u.pm = 68 + (L & 7); u.pn = 18 + (L >> 3); u.ka = 0; u.kb = 0; u.nt = 16; u.tag = 1; return true; }
        return false;
    }
};
struct SchedT {
    int nM, nN, nt, G, c;
    __device__ __forceinline__ bool next(int i, Unit& u) const {
        const int L = i * G + c; if (L >= nM * nN) return false;
        pg8::tile_map(nM, nN, L, u.pm, u.pn); u.ka = 0; u.kb = 0; u.nt = nt; u.tag = 0; return true;
    }
};
struct SchedP3 {
    int G, c;
    __device__ __forceinline__ bool next(int i, Unit& u) const {
        const int j = i / 3, br = i - 3 * j; const int L = j * G + c; if (L >= 272) return false;
        pg8::tile_map(68, 4, L, u.pm, u.pn);
        u.tag = br; u.nt = br == 0 ? 8 : 4; u.ka = br == 0 ? 0 : (br == 1 ? 2048 : 2560); u.kb = br == 0 ? 0 : (br == 1 ? 1024 : 1536);
        return true;
    }
};

struct SchedOne3 {
    int pm, pn;
    __device__ __forceinline__ bool next(int i, Unit& u) const {
        if (i >= 3) return false;
        u.pm = pm; u.pn = pn; u.tag = i; u.nt = i == 0 ? 8 : 4; u.ka = i == 0 ? 0 : (i == 1 ? 2048 : 2560); u.kb = i == 0 ? 0 : (i == 1 ? 1024 : 1536); return true;
    }
};
struct SchedOne {
    int pm, pn, nt;
    __device__ __forceinline__ bool next(int i, Unit& u) const { if (i >= 1) return false; u.pm = pm; u.pn = pn; u.ka = 0; u.kb = 0; u.nt = nt; u.tag = 0; return true; }
};
__device__ __forceinline__ void tile272(int L, int& pm, int& pn) { if (L < 256) pg8::tile_map(64, 4, L, pm, pn); else { pm = 64 + ((L - 256) >> 2); pn = (L - 256) & 3; } }
struct SchedP6 {
    int G, c;
    __device__ __forceinline__ bool next(int i, Unit& u) const {
        if (G == 256) {
            if (i == 1) { pg8::tile_map(64, 4, c, u.pm, u.pn); u.ka = 0; u.kb = 0; u.nt = 64; u.tag = 0; return true; }
            if (i == 0) { const int j = c >> 4; u.pm = 64 + (j >> 2); u.pn = j & 3; u.ka = (c & 15) * 512; u.kb = u.ka; u.nt = 4; u.tag = 1 + (c & 15); return true; }
            return false;
        }
        const int L = i * G + c; if (L >= 272) return false;
        pg8::tile_map(68, 4, L, u.pm, u.pn); u.ka = 0; u.kb = 0; u.nt = 64; u.tag = 0; return true;
    }
};
__device__ __forceinline__ float* part_base(unsigned char* ws, int s) {
    const size_t mb = s < 8 ? 48 + 4 * (size_t)s : (s < 12 ? 222 + 4 * (size_t)(s - 8) : (s < 14 ? 13 + 4 * (size_t)(s - 12) : 3 + 4 * (size_t)(s - 14)));
    return (float*)(ws + mb * MiB);
}
__device__ __forceinline__ void panel_signal(unsigned* cnt, int wave_s);
__device__ __forceinline__ void panel_wait(unsigned* cnt, unsigned want, unsigned* bar, int wave_s);
#define EPI_ROWS(u) const int row0 = (u).pm * 256 + wr * 64 + fr; const int col0 = (u).pn * 256 + wc * 32 + 8 * fq;
struct EpiP1 {
    bf16_t* Z; float* P; float* outk; float* outv; bf16_t* KB; bf16_t* VTB;
    __device__ __forceinline__ bool operator()(const f32x4 (&acc)[2][2][4][2], const Unit& u, int wr, int wc, int fr, int fq) const {
        EPI_ROWS(u)
        if (u.tag == 0 && u.pn >= 6) {
#pragma unroll
            for (int ai = 0; ai < 2; ++ai)
#pragma unroll
                for (int m = 0; m < 4; ++m) { const int row = row0 + ai * 128 + m * 16; u32x4 q;
                    { const f32x4 v0 = acc[ai][0][m][0], v1 = acc[ai][0][m][1]; q.x = gate_q(v0[0]) | (gate_q(v0[1]) << 8) | (gate_q(v0[2]) << 16) | (gate_q(v0[3]) << 24); q.y = gate_q(v1[0]) | (gate_q(v1[1]) << 8) | (gate_q(v1[2]) << 16) | (gate_q(v1[3]) << 24); }
                    { const f32x4 v0 = acc[ai][1][m][0], v1 = acc[ai][1][m][1]; q.z = gate_q(v0[0]) | (gate_q(v0[1]) << 8) | (gate_q(v0[2]) << 16) | (gate_q(v0[3]) << 24); q.w = gate_q(v1[0]) | (gate_q(v1[1]) << 8) | (gate_q(v1[2]) << 16) | (gate_q(v1[3]) << 24); }
                    *(u32x4*)((unsigned char*)Z + (size_t)row * (DIN * 2) + 3072 + (u.pn - 6) * 256 + (wc * 4 + fq) * 16) = q; }
            return true;
        }
        if (u.tag == 0) {
            const int pn = u.pn;
#pragma unroll
            for (int ai = 0; ai < 2; ++ai)
#pragma unroll
                for (int m = 0; m < 4; ++m) { const int row = row0 + ai * 128 + m * 16;
#pragma unroll
                    for (int bj = 0; bj < 2; ++bj) { const int col = col0 + bj * 128; f32x4 v0 = acc[ai][bj][m][0], v1 = acc[ai][bj][m][1];
                        if (pn == 4) { float* p = P + (size_t)row * 256 + (col - 1024); *(f32x4*)p = v0; *(f32x4*)(p + 4) = v1; }
                        else {
                            if (pn < 4) {
                                const f32x2 a0 = gelu_t2((f32x2){v0[0], v0[1]}), a1 = gelu_t2((f32x2){v0[2], v0[3]}), a2 = gelu_t2((f32x2){v1[0], v1[1]}), a3 = gelu_t2((f32x2){v1[2], v1[3]});
                                v0 = (f32x4){a0.x, a0.y, a1.x, a1.y}; v1 = (f32x4){a2.x, a2.y, a3.x, a3.y};
                            } else if (pn >= 6) {
                                u32x2 q; q.x = gate_q(v0[0]) | (gate_q(v0[1]) << 8) | (gate_q(v0[2]) << 16) | (gate_q(v0[3]) << 24); q.y = gate_q(v1[0]) | (gate_q(v1[1]) << 8) | (gate_q(v1[2]) << 16) | (gate_q(v1[3]) << 24);
                                *(u32x2*)((unsigned char*)Z + (size_t)row * (DIN * 2) + 1536 + col) = q; continue;
                            }
                            u32x4 w; w.x = cvt_pk_bf16(v0[0], v0[1]); w.y = cvt_pk_bf16(v0[2], v0[3]); w.z = cvt_pk_bf16(v1[0], v1[1]); w.w = cvt_pk_bf16(v1[2], v1[3]);
                            *(u32x4*)(Z + (size_t)row * DIN + col) = w;
                        } } }
        } else {
            const bool isv = (u.pn == 19);
#pragma unroll
            for (int ai = 0; ai < 2; ++ai)
#pragma unroll
                for (int m = 0; m < 4; ++m) { const int r = row0 - 68 * 256 + ai * 128 + m * 16;
#pragma unroll
                    for (int bj = 0; bj < 2; ++bj) { const int c = wc * 32 + 8 * fq + bj * 128; const f32x4 v0 = acc[ai][bj][m][0], v1 = acc[ai][bj][m][1];
                        float* o = (isv ? outv : outk) + (size_t)r * 256 + c; __builtin_nontemporal_store(v0, (f32x4*)o); __builtin_nontemporal_store(v1, (f32x4*)(o + 4));
                        if (!isv) { u32x4 w; w.x = cvt_pk_bf16(v0[0], v0[1]); w.y = cvt_pk_bf16(v0[2], v0[3]); w.z = cvt_pk_bf16(v1[0], v1[1]); w.w = cvt_pk_bf16(v1[2], v1[3]);
                            *(u32x4*)(KB + (size_t)r * 256 + c) = w; }
                        else { bf16_t* vt = VTB + ((size_t)(r >> 8) * 256 + c) * 256 + (r & 255);
#pragma unroll
                            for (int e = 0; e < 4; ++e) { vt[(size_t)e * 256] = (bf16_t)f2bf(v0[e]); vt[(size_t)(e + 4) * 256] = (bf16_t)f2bf(v1[e]); } }
                    } }
        }
        return true;
    }
};
struct EpiP3 {
    const bf16_t* Z; bf16_t* MG; bool wt;
    __device__ __forceinline__ bool operator()(f32x4 (&acc)[2][2][4][2], const Unit& u, int wr, int wc, int fr, int fq) const {
        EPI_ROWS(u)
        const int br = u.tag;
        u32x4 gn[2][4], gd[2][4];
#pragma unroll
        for (int ai = 0; ai < 2; ++ai)
#pragma unroll
            for (int m = 0; m < 4; ++m) { const unsigned char* gp = (const unsigned char*)Z + (size_t)(row0 + ai * 128 + m * 16) * (DIN * 2) + 3072 + br * 1024 + u.pn * 256 + (wc * 4 + fq) * 16;
                gn[ai][m] = *(const u32x4*)gp; if (br < 2) gd[ai][m] = *(const u32x4*)(gp + 1024); }
        asm volatile("" ::: "memory");
#pragma unroll
        for (int ai = 0; ai < 2; ++ai)
#pragma unroll
            for (int m = 0; m < 4; ++m) { const int row = row0 + ai * 128 + m * 16;
#pragma unroll
                for (int bj = 0; bj < 2; ++bj) { const int col = col0 + bj * 128;
                    u32x2 g1; g1.x = bj == 0 ? gn[ai][m].x : gn[ai][m].z; g1.y = bj == 0 ? gn[ai][m].y : gn[ai][m].w;
                    float f[8];
                    f[0] = ub0(g1.x); f[1] = ub1(g1.x); f[2] = ub2(g1.x); f[3] = ub3(g1.x); f[4] = ub0(g1.y); f[5] = ub1(g1.y); f[6] = ub2(g1.y); f[7] = ub3(g1.y);
                    if (br < 2) { u32x2 g2; g2.x = bj == 0 ? gd[ai][m].x : gd[ai][m].z; g2.y = bj == 0 ? gd[ai][m].y : gd[ai][m].w;
                        f[0] *= __builtin_amdgcn_rcpf(ub0(g2.x)); f[1] *= __builtin_amdgcn_rcpf(ub1(g2.x)); f[2] *= __builtin_amdgcn_rcpf(ub2(g2.x)); f[3] *= __builtin_amdgcn_rcpf(ub3(g2.x));
                        f[4] *= __builtin_amdgcn_rcpf(ub0(g2.y)); f[5] *= __builtin_amdgcn_rcpf(ub1(g2.y)); f[6] *= __builtin_amdgcn_rcpf(ub2(g2.y)); f[7] *= __builtin_amdgcn_rcpf(ub3(g2.y)); }
                    else {
#pragma unroll
                        for (int e = 0; e < 8; ++e) f[e] *= (1.0f / 255.0f); }
                    f32x4 v0 = acc[ai][bj][m][0], v1 = acc[ai][bj][m][1];
                    v0[0] *= f[0]; v0[1] *= f[1]; v0[2] *= f[2]; v0[3] *= f[3]; v1[0] *= f[4]; v1[1] *= f[5]; v1[2] *= f[6]; v1[3] *= f[7];
                    if (br < 2) { acc[ai][bj][m][0] = v0; acc[ai][bj][m][1] = v1; }
                    else { u32x4 w; w.x = cvt_pk_bf16(v0[0], v0[1]); w.y = cvt_pk_bf16(v0[2], v0[3]); w.z = cvt_pk_bf16(v1[0], v1[1]); w.w = cvt_pk_bf16(v1[2], v1[3]);
                        if (!wt) *(u32x4*)(MG + (size_t)row * DM + col) = w;
                        else { unsigned long long* mp = (unsigned long long*)(MG + (size_t)row * DM + col);
                            __hip_atomic_store(mp, (unsigned long long)w.x | ((unsigned long long)w.y << 32), __ATOMIC_RELAXED, __HIP_MEMORY_SCOPE_AGENT);
                            __hip_atomic_store(mp + 1, (unsigned long long)w.z | ((unsigned long long)w.w << 32), __ATOMIC_RELAXED, __HIP_MEMORY_SCOPE_AGENT); } }
                } }
        return br == 2;
    }
};
struct EpiP4 {
    const float* xp; const float* xs; float* out; bf16_t* X1Blo; bf16_t* X1Bhi; float* SSP; float* SSP4; LAS unsigned char* lds;
    __device__ __forceinline__ bool operator()(const f32x4 (&acc)[2][2][4][2], const Unit& u, int wr, int wc, int fr, int fq) const {
        EPI_ROWS(u)
        const float* xb = u.pm < 64 ? xp : xs - (size_t)MP * DM;
        bf16_t* X1B = u.pm < X1B_SPLIT ? X1Blo : X1Bhi - (size_t)X1B_SPLIT * 256 * DM;
#pragma unroll
        for (int ai = 0; ai < 2; ++ai) {
            f32x4 xv[4][2][2];
#pragma unroll
            for (int m = 0; m < 4; ++m)
#pragma unroll
                for (int bj = 0; bj < 2; ++bj) { const size_t off = (size_t)(row0 + ai * 128 + m * 16) * DM + col0 + bj * 128; xv[m][bj][0] = __builtin_nontemporal_load((const f32x4*)(xb + off)); xv[m][bj][1] = __builtin_nontemporal_load((const f32x4*)(xb + off + 4)); }
            asm volatile("" ::: "memory");
#pragma unroll
            for (int m = 0; m < 4; ++m) { const int row = row0 + ai * 128 + m * 16; float ss = 0.f;
#pragma unroll
                for (int bj = 0; bj < 2; ++bj) { const int col = col0 + bj * 128; const size_t off = (size_t)row * DM + col;
                    const f32x4 v0 = acc[ai][bj][m][0] + xv[m][bj][0], v1 = acc[ai][bj][m][1] + xv[m][bj][1];
                    u32x4 w; w.x = cvt_pk_bf16(v0[0], v0[1]); w.y = cvt_pk_bf16(v0[2], v0[3]); w.z = cvt_pk_bf16(v1[0], v1[1]); w.w = cvt_pk_bf16(v1[2], v1[3]);
                    *(u32x4*)(X1B + off) = w;
                    ss += (v0[0] * v0[0] + v0[1] * v0[1]) + (v0[2] * v0[2] + v0[3] * v0[3]) + (v1[0] * v1[0] + v1[1] * v1[1]) + (v1[2] * v1[2] + v1[3] * v1[3]); }
                ss += __shfl_xor(ss, 16); ss += __shfl_xor(ss, 32);
                if (fq == 0) { SSP[(size_t)row * 16 + u.pn * 4 + wc] = ss; ((LAS float*)(lds + 131072))[(ai * 128 + wr * 64 + m * 16 + fr) * 4 + wc] = ss; } }
            asm volatile("" ::: "memory");
        }
        __syncthreads();
        { const int t = (wr * 4 + wc) * 64 + fq * 16 + fr;
          if (t < 256) { const f32x4 q = *(const LAS f32x4*)(lds + 131072 + t * 16); SSP4[(size_t)(u.pm * 256 + t) * 4 + u.pn] = (q[0] + q[1]) + (q[2] + q[3]); } }
        __syncthreads();
        return true;
    }
};
struct EpiP5 {
    const float* SSP; bf16_t* H; const float* SSP4; int n4;
    __device__ __forceinline__ bool operator()(const f32x4 (&acc)[2][2][4][2], const Unit& u, int wr, int wc, int fr, int fq) const {
        EPI_ROWS(u)
        if (u.pm < n4) {
            f32x4 sq[2][4];
#pragma unroll
            for (int ai = 0; ai < 2; ++ai)
#pragma unroll
                for (int m = 0; m < 4; ++m) sq[ai][m] = *(const f32x4*)(SSP4 + (size_t)(row0 + ai * 128 + m * 16) * 4);
            asm volatile("" ::: "memory");
#pragma unroll
            for (int ai = 0; ai < 2; ++ai)
#pragma unroll
                for (int m = 0; m < 4; ++m) { const int row = row0 + ai * 128 + m * 16; const f32x4 q = sq[ai][m];
                    const float rstd = 1.0f / sqrtf(((q[0] + q[1]) + (q[2] + q[3])) * (1.0f / DM) + EPS);
#pragma unroll
                    for (int bj = 0; bj < 2; ++bj) { const int col = col0 + bj * 128; f32x4 v0 = acc[ai][bj][m][0] * rstd, v1 = acc[ai][bj][m][1] * rstd;
#pragma unroll
                        for (int e = 0; e < 4; ++e) { const float a = fmaxf(v0[e], 0.f), b = fmaxf(v1[e], 0.f); v0[e] = a * a; v1[e] = b * b; }
                        u32x4 w; w.x = cvt_pk_bf16(v0[0], v0[1]); w.y = cvt_pk_bf16(v0[2], v0[3]); w.z = cvt_pk_bf16(v1[0], v1[1]); w.w = cvt_pk_bf16(v1[2], v1[3]);
                        *(u32x4*)(H + (size_t)row * DFF + col) = w; } }
            return true;
        }
#pragma unroll
        for (int ai = 0; ai < 2; ++ai) {
            f32x4 sv[4][4];
#pragma unroll
            for (int m = 0; m < 4; ++m) { const f32x4* sp = (const f32x4*)(SSP + (size_t)(row0 + ai * 128 + m * 16) * 16);
#pragma unroll
                for (int k = 0; k < 4; ++k) sv[m][k] = sp[k]; }
            asm volatile("" ::: "memory");
#pragma unroll
            for (int m = 0; m < 4; ++m) { const int row = row0 + ai * 128 + m * 16;
                const f32x4 s0 = sv[m][0], s1 = sv[m][1], s2 = sv[m][2], s3 = sv[m][3];
                const float ss = ((s0[0] + s0[1]) + (s0[2] + s0[3])) + ((s1[0] + s1[1]) + (s1[2] + s1[3])) + ((s2[0] + s2[1]) + (s2[2] + s2[3])) + ((s3[0] + s3[1]) + (s3[2] + s3[3]));
                const float rstd = 1.0f / sqrtf(ss * (1.0f / DM) + EPS);
#pragma unroll
                for (int bj = 0; bj < 2; ++bj) { const int col = col0 + bj * 128; f32x4 v0 = acc[ai][bj][m][0] * rstd, v1 = acc[ai][bj][m][1] * rstd;
#pragma unroll
                    for (int e = 0; e < 4; ++e) { const float a = fmaxf(v0[e], 0.f), b = fmaxf(v1[e], 0.f); v0[e] = a * a; v1[e] = b * b; }
                    u32x4 w; w.x = cvt_pk_bf16(v0[0], v0[1]); w.y = cvt_pk_bf16(v0[2], v0[3]); w.z = cvt_pk_bf16(v1[0], v1[1]); w.w = cvt_pk_bf16(v1[2], v1[3]);
                    *(u32x4*)(H + (size_t)row * DFF + col) = w; } }
            asm volatile("" ::: "memory");
        }
        return true;
    }
};
struct EpiP6 {
    float* out; unsigned char* ws; const bf16_t* X1Blo; const bf16_t* X1Bhi;
    __device__ __forceinline__ bool operator()(const f32x4 (&acc)[2][2][4][2], const Unit& u, int wr, int wc, int fr, int fq) const {
        EPI_ROWS(u)
        if (u.tag == 0) {
            const bf16_t* X1B = u.pm < X1B_SPLIT ? X1Blo : X1Bhi - (size_t)X1B_SPLIT * 256 * DM;
#pragma unroll
            for (int ai = 0; ai < 2; ++ai) {
                u32x4 xv[4][2];
#pragma unroll
                for (int m = 0; m < 4; ++m)
#pragma unroll
                    for (int bj = 0; bj < 2; ++bj) xv[m][bj] = *(const u32x4*)(X1B + (size_t)(row0 + ai * 128 + m * 16) * DM + col0 + bj * 128);
                asm volatile("" ::: "memory");
#pragma unroll
                for (int m = 0; m < 4; ++m)
#pragma unroll
                    for (int bj = 0; bj < 2; ++bj) { const size_t off = (size_t)(row0 + ai * 128 + m * 16) * DM + col0 + bj * 128; const u32x4 xw = xv[m][bj];
                        *(f32x4*)(out + off) = acc[ai][bj][m][0] + (f32x4){bf_lo(xw.x), bf_hi(xw.x), bf_lo(xw.y), bf_hi(xw.y)};
                        *(f32x4*)(out + off + 4) = acc[ai][bj][m][1] + (f32x4){bf_lo(xw.z), bf_hi(xw.z), bf_lo(xw.w), bf_hi(xw.w)}; }
                asm volatile("" ::: "memory");
            }
        } else {
            float* pb = part_base(ws, u.tag - 1);
#pragma unroll
            for (int ai = 0; ai < 2; ++ai)
#pragma unroll
                for (int m = 0; m < 4; ++m) { const int row = row0 - MP + ai * 128 + m * 16;
#pragma unroll
                    for (int bj = 0; bj < 2; ++bj) { float* o = pb + (size_t)row * DM + col0 + bj * 128; *(f32x4*)o = acc[ai][bj][m][0]; *(f32x4*)(o + 4) = acc[ai][bj][m][1]; } }
        }
        return true;
    }
};

struct EpiP6F {
    float* out; unsigned char* ws; const bf16_t* X1Blo; const bf16_t* X1Bhi; float* SSP4; unsigned* cnt; unsigned* bar; const float* gfin; LAS unsigned char* lds;
    __device__ __forceinline__ bool operator()(f32x4 (&acc)[2][2][4][2], const Unit& u, int wr, int wc, int fr, int fq) const {
        EPI_ROWS(u)
        if (u.tag != 0) {
            float* pb = part_base(ws, u.tag - 1);
#pragma unroll
            for (int ai = 0; ai < 2; ++ai)
#pragma unroll
                for (int m = 0; m < 4; ++m) { const int row = row0 - MP + ai * 128 + m * 16;
#pragma unroll
                    for (int bj = 0; bj < 2; ++bj) { float* o = pb + (size_t)row * DM + col0 + bj * 128; *(f32x4*)o = acc[ai][bj][m][0]; *(f32x4*)(o + 4) = acc[ai][bj][m][1]; } }
            return true;
        }
        const bf16_t* X1B = u.pm < X1B_SPLIT ? X1Blo : X1Bhi - (size_t)X1B_SPLIT * 256 * DM;
#pragma unroll
        for (int ai = 0; ai < 2; ++ai) {
            u32x4 xv[4][2];
#pragma unroll
            for (int m = 0; m < 4; ++m)
#pragma unroll
                for (int bj = 0; bj < 2; ++bj) xv[m][bj] = __builtin_nontemporal_load((const u32x4*)(X1B + (size_t)(row0 + ai * 128 + m * 16) * DM + col0 + bj * 128));
            asm volatile("" ::: "memory");
#pragma unroll
            for (int m = 0; m < 4; ++m) { const int row = row0 + ai * 128 + m * 16; float ss = 0.f;
#pragma unroll
                for (int bj = 0; bj < 2; ++bj) { const u32x4 xw = xv[m][bj];
                    const f32x4 v0 = acc[ai][bj][m][0] + (f32x4){bf_lo(xw.x), bf_hi(xw.x), bf_lo(xw.y), bf_hi(xw.y)}, v1 = acc[ai][bj][m][1] + (f32x4){bf_lo(xw.z), bf_hi(xw.z), bf_lo(xw.w), bf_hi(xw.w)};
                    acc[ai][bj][m][0] = v0; acc[ai][bj][m][1] = v1;
                    ss += (v0[0] * v0[0] + v0[1] * v0[1]) + (v0[2] * v0[2] + v0[3] * v0[3]) + (v1[0] * v1[0] + v1[1] * v1[1]) + (v1[2] * v1[2] + v1[3] * v1[3]); }
                ss += __shfl_xor(ss, 16); ss += __shfl_xor(ss, 32);
                if (fq == 0) ((LAS float*)(lds + 131072))[(ai * 128 + wr * 64 + m * 16 + fr) * 4 + wc] = ss; (void)row; }
            asm volatile("" ::: "memory");
        }
        __syncthreads();
        { const int t = (wr * 4 + wc) * 64 + fq * 16 + fr;
          if (t < 256) { const f32x4 q = *(const LAS f32x4*)(lds + 131072 + t * 16); __hip_atomic_store(SSP4 + (size_t)(u.pm * 256 + t) * 4 + u.pn, (q[0] + q[1]) + (q[2] + q[3]), __ATOMIC_RELAXED, __HIP_MEMORY_SCOPE_AGENT); } }
        panel_signal(cnt + 64 * u.pm, wr * 4 + wc);
        panel_wait(cnt + 64 * u.pm, 4u, bar, wr * 4 + wc);
        f32x4 sq[2][4];
#pragma unroll
        for (int ai = 0; ai < 2; ++ai)
#pragma unroll
            for (int m = 0; m < 4; ++m) sq[ai][m] = *(const f32x4*)(SSP4 + (size_t)(row0 + ai * 128 + m * 16) * 4);
        asm volatile("" ::: "memory");
#pragma unroll
        for (int ai = 0; ai < 2; ++ai)
#pragma unroll
            for (int m = 0; m < 4; ++m) { const int row = row0 + ai * 128 + m * 16; const f32x4 q = sq[ai][m];
                const float rstd = 1.0f / sqrtf(((q[0] + q[1]) + (q[2] + q[3])) * (1.0f / DM) + EPS);
#pragma unroll
                for (int bj = 0; bj < 2; ++bj) { const size_t off = (size_t)row * DM + col0 + bj * 128;
                    const f32x4 g0 = *(const f32x4*)(gfin + col0 + bj * 128), g1 = *(const f32x4*)(gfin + col0 + bj * 128 + 4);
                    __builtin_nontemporal_store(acc[ai][bj][m][0] * rstd * g0, (f32x4*)(out + off)); __builtin_nontemporal_store(acc[ai][bj][m][1] * rstd * g1, (f32x4*)(out + off + 4)); } }
        return true;
    }
};

__device__ __forceinline__ float wave_sum(float v) {
#pragma unroll
    for (int o = 1; o < 64; o <<= 1) v += __shfl_xor(v, o);
    return v;
}
__device__ __forceinline__ void tr_item(const float* W, int N, bf16_t* WT, int ldt, int col_off, const float* kscale, LAS float* scr, int item, int lane) {
    const int nblk = N / 32, kb = item / nblk, nb = item % nblk, k0 = 64 * kb, n0 = 32 * nb;
    f32x4 t[8];
#pragma unroll
    for (int i = 0; i < 8; ++i) { const int kk = 8 * i + (lane >> 3); t[i] = __builtin_nontemporal_load((const f32x4*)(W + (size_t)(k0 + kk) * N + n0 + 4 * (lane & 7))); }
    if (kscale) {
#pragma unroll
        for (int i = 0; i < 8; ++i) t[i] = t[i] * kscale[k0 + 8 * i + (lane >> 3)];
    }
#pragma unroll
    for (int i = 0; i < 8; ++i) { LAS float* d = scr + (8 * i + (lane >> 3)) * 33 + 4 * (lane & 7); d[0] = t[i][0]; d[1] = t[i][1]; d[2] = t[i][2]; d[3] = t[i][3]; }
    asm volatile("s_waitcnt lgkmcnt(0)" ::: "memory");
    const int c = lane & 7;
#pragma unroll
    for (int j = 0; j < 4; ++j) { const int n = (lane >> 3) + 8 * j; const LAS float* s = scr + (8 * c) * 33 + n;
        u32x4 o; o.x = pk2(s[0 * 33], s[1 * 33]); o.y = pk2(s[2 * 33], s[3 * 33]); o.z = pk2(s[4 * 33], s[5 * 33]); o.w = pk2(s[6 * 33], s[7 * 33]);
        *(u32x4*)(WT + (size_t)(n0 + n) * ldt + col_off + k0 + 8 * c) = o; }
    asm volatile("s_waitcnt lgkmcnt(0)" ::: "memory");
}
__device__ __forceinline__ const float* p0_src_row(const Args& a, int row) { return row < MP ? a.x_prompt + (size_t)row * DM : (row < MT ? a.x_sample + (size_t)(row - MP) * DM : a.mem + (size_t)(row - MT) * DM); }
__device__ __forceinline__ void rms_rows2_to_bf16(const float* x0, const float* x1, const float* g0, const float* g1, bf16_t* o0, bf16_t* o1, int lane) {
    const f32x4* xr0 = (const f32x4*)x0 + lane; const f32x4* xr1 = (const f32x4*)x1 + lane;
    f32x4 v[2][4]; float s0 = 0.f, s1 = 0.f;
#pragma unroll
    for (int j = 0; j < 4; ++j) { v[0][j] = __builtin_nontemporal_load(xr0 + 64 * j); v[1][j] = __builtin_nontemporal_load(xr1 + 64 * j); }
#pragma unroll
    for (int j = 0; j < 4; ++j) { s0 += (v[0][j][0] * v[0][j][0] + v[0][j][1] * v[0][j][1]) + (v[0][j][2] * v[0][j][2] + v[0][j][3] * v[0][j][3]);
                                  s1 += (v[1][j][0] * v[1][j][0] + v[1][j][1] * v[1][j][1]) + (v[1][j][2] * v[1][j][2] + v[1][j][3] * v[1][j][3]); }
    const float r0 = 1.0f / sqrtf(wave_sum(s0) * (1.0f / DM) + EPS), r1 = 1.0f / sqrtf(wave_sum(s1) * (1.0f / DM) + EPS);
    u32x2* p0 = (u32x2*)o0 + lane; u32x2* p1 = (u32x2*)o1 + lane;
#pragma unroll
    for (int j = 0; j < 4; ++j) { const f32x4 ga = ((const f32x4*)g0 + lane)[64 * j], gb = ((const f32x4*)g1 + lane)[64 * j]; u32x2 w;
        w.x = pk2(v[0][j][0] * r0 * ga[0], v[0][j][1] * r0 * ga[1]); w.y = pk2(v[0][j][2] * r0 * ga[2], v[0][j][3] * r0 * ga[3]); p0[64 * j] = w;
        w.x = pk2(v[1][j][0] * r1 * gb[0], v[1][j][1] * r1 * gb[1]); w.y = pk2(v[1][j][2] * r1 * gb[2], v[1][j][3] * r1 * gb[3]); p1[64 * j] = w; }
}
__device__ __forceinline__ void p0_prologue(const Args& a, LAS unsigned char* lds, int tid, int G) {
    const int wave = tid >> 6, lane = tid & 63;
    LAS float* scr = (LAS float*)(lds + wave * 16384);
    const int gw = blockIdx.x * 8 + wave, NGW = G * 8;
    const int gt = blockIdx.x * 512 + tid, NGT = G * 512;
    bf16_t* WinT = (bf16_t*)(a.ws + WS_WIN); bf16_t* WoT = (bf16_t*)(a.ws + WS_WO); bf16_t* WupT = (bf16_t*)(a.ws + WS_WUP); bf16_t* WdnT = (bf16_t*)(a.ws + WS_WDN); bf16_t* WbrT = (bf16_t*)(a.ws + WS_WBR);
    bf16_t* VTB = (bf16_t*)((unsigned char*)a.out + OS_VTB); bf16_t* KB = (bf16_t*)((unsigned char*)a.out + OS_KB);
    constexpr int I_IN = 16 * 144, I_KV = 16 * 16, I_O = 16 * 32, I_UP = 16 * 128, I_DN = 64 * 32, I_A = 8 * 32, I_C = 4 * 32, I_V = 128 * 32;
    constexpr int NITEMS = I_IN + I_KV + I_O + I_A + I_C + I_V;
    for (int it = gw; it < NITEMS; it += NGW) {
        int r = it;
        if (r < I_IN) { tr_item(a.w_in, DIN, WinT, 1024, 0, nullptr, scr, r, lane); continue; } r -= I_IN;
        if (r < I_KV) { tr_item(a.w_kv, 512, WinT + (size_t)4608 * 1024, 1024, 0, nullptr, scr, r, lane); continue; } r -= I_KV;
        if (r < I_O) { tr_item(a.w_o, 1024, WoT, 1024, 0, nullptr, scr, r, lane); continue; } r -= I_O;
        if (r < I_A) { tr_item(a.w_out_a, 1024, WbrT, 1024, 0, nullptr, scr, r, lane); continue; } r -= I_A;
        if (r < I_C) { tr_item(a.w_out_c, 1024, WbrT, 1024, 768, nullptr, scr, r, lane); continue; } r -= I_C;
        { const int b = r >> 5; tr_item(a.cache_v + (size_t)b * 65536, 256, VTB + (size_t)(8 + b) * 65536, 256, 0, nullptr, scr, r & 31, lane); }
    }
    for (int idx = gt; idx < 256 * 1024; idx += NGT) { const int n = idx & 1023, k = idx >> 10, g = k >> 6, kk = k & 63; float s = 0.f;
        const float* wp = a.w_pool + g * 4096 + kk * 64; const float* sc = a.pool_scale + g * 64; const float* wb = a.w_out_b + (size_t)(g * 64) * 1024 + n;
#pragma unroll 32
        for (int e = 0; e < 64; ++e) s += wp[e] * sc[e] * wb[(size_t)e * 1024];
        WbrT[(size_t)n * 1024 + 512 + k] = (bf16_t)f2bf(s); }
    bf16_t* XN = (bf16_t*)(a.ws + WS_XN);
    for (int r2 = gw; r2 < (MT + MKV) / 2; r2 += NGW) { const int row = 2 * r2;
        rms_rows2_to_bf16(p0_src_row(a, row), p0_src_row(a, row + 1), row < MT ? a.g_mix : a.g_mem, row < MT ? a.g_mix : a.g_mem, XN + (size_t)row * DM, XN + (size_t)(row + 1) * DM, lane); }
    bf16_t* WsB = (bf16_t*)(a.ws + WS_WSB);
    for (int idx = gt; idx < 131072; idx += NGT) { const int e = idx & 65535, g = e >> 14, r = (e >> 7) & 127, c = e & 127; float v;
        if (idx < 65536) v = c <= r ? a.w_s[e] : 0.f;
        else v = ((r >> 3) == (c >> 3) && (c & 7) <= (r & 7)) ? a.w_s[g * 16384 + (r & 7) * 128 + (c & 7)] : 0.f;
        WsB[idx] = (bf16_t)f2bf(v); }
}

__device__ __forceinline__ void p0_deferred(const Args& a, LAS unsigned char* lds, int tid, int G) {
    const int wave = tid >> 6, lane = tid & 63;
    LAS float* scr = (LAS float*)(lds + wave * 16384);
    const int nc = G, cc = (int)blockIdx.x;
    bf16_t* WupT = (bf16_t*)(a.ws + WS_WUP); bf16_t* WdnT = (bf16_t*)(a.ws + WS_WDN);
    for (int it = cc * 8 + wave; it < 4096; it += nc * 8) {
        if (it < 2048) tr_item(a.w_up, DFF, WupT, 1024, 0, a.g_ffn, scr, it, lane);
        else tr_item(a.w_down, 1024, WdnT, 4096, 0, nullptr, scr, it - 2048, lane);
    }
}

__device__ __forceinline__ void p2a_unit(const Args& a, LAS unsigned char* lds, int c, int tid) {
    const int w = __builtin_amdgcn_readfirstlane(tid >> 6), l = tid & 63;
    bf16_t* Z = (bf16_t*)(a.ws + WS_Z);
    const int row0 = c * 128;
    const int g = w >> 1, ih = w & 1, fr = l & 15, fq = l >> 4;
    const bf16_t* Wg = (const bf16_t*)(a.ws + WS_WSB) + (c >= 128 ? 65536 : 0) + g * 16384;
    __syncthreads();
    u32x4 v[2][8];
#pragma unroll
    for (int rr = 0; rr < 2; ++rr) { const u32x4* src = (const u32x4*)(Z + (size_t)(row0 + 2 * l + rr) * DIN + 512 + 64 * w);
#pragma unroll
        for (int e = 0; e < 8; ++e) v[rr][e] = src[e]; }
    LAS f32x2* ST = (LAS f32x2*)(lds + 139264);
#pragma unroll
    for (int rr = 0; rr < 2; ++rr) { float s = 0.f, q = 0.f;
#pragma unroll
        for (int e = 0; e < 8; ++e)
#pragma unroll
            for (int d = 0; d < 4; ++d) { const float x0 = bf_lo(v[rr][e][d]), x1 = bf_hi(v[rr][e][d]); s += x0 + x1; q += x0 * x0 + x1 * x1; }
        ST[(2 * l + rr) * 8 + w] = (f32x2){s, q}; }
    __syncthreads();
    float mean[2], rstd[2];
#pragma unroll
    for (int rr = 0; rr < 2; ++rr) { float s = 0.f, q = 0.f;
#pragma unroll
        for (int k = 0; k < 8; ++k) { const f32x2 t = ST[(2 * l + rr) * 8 + k]; s += t[0]; q += t[1]; }
        mean[rr] = s * (1.0f / 512.0f); const float var = fmaxf(q * (1.0f / 512.0f) - mean[rr] * mean[rr], 0.f); rstd[rr] = 1.0f / sqrtf(var + EPS); }
    const bool wout = (c >= 128) || ((c & 15) == 15);
    float* op = c >= 128 ? a.out + O_CVS + (size_t)((c - 128) * 128 + 2 * l) * 512 : a.out + O_CVP + (size_t)((c >> 4) * 128 + 2 * l) * 512;
#pragma unroll
    for (int e = 0; e < 8; ++e) { float y[2][8];
#pragma unroll
        for (int d = 0; d < 4; ++d) { const int ch = 64 * w + 8 * e + 2 * d; const float g0 = a.g_v[ch], g1 = a.g_v[ch + 1], b0 = a.b_v[ch], b1 = a.b_v[ch + 1];
            y[0][2 * d] = (bf_lo(v[0][e][d]) - mean[0]) * rstd[0] * g0 + b0; y[0][2 * d + 1] = (bf_hi(v[0][e][d]) - mean[0]) * rstd[0] * g1 + b1;
            y[1][2 * d] = (bf_lo(v[1][e][d]) - mean[1]) * rstd[1] * g0 + b0; y[1][2 * d + 1] = (bf_hi(v[1][e][d]) - mean[1]) * rstd[1] * g1 + b1;
            *(LAS unsigned*)(lds + ch * 272 + 4 * l) = pk2(y[0][2 * d], y[1][2 * d]);
            *(LAS unsigned*)(lds + (ch + 1) * 272 + 4 * l) = pk2(y[0][2 * d + 1], y[1][2 * d + 1]); }
        if (wout) {
#pragma unroll
            for (int rr = 0; rr < 2; ++rr) { float* o = op + rr * 512 + 64 * w + 8 * e; __builtin_nontemporal_store((f32x4){y[rr][0], y[rr][1], y[rr][2], y[rr][3]}, (f32x4*)o); __builtin_nontemporal_store((f32x4){y[rr][4], y[rr][5], y[rr][6], y[rr][7]}, (f32x4*)(o + 4)); } }
    }
    bf16x8 wf[4][4];
#pragma unroll
    for (int mt = 0; mt < 4; ++mt)
#pragma unroll
        for (int ks = 0; ks < 4; ++ks) wf[mt][ks] = *(const bf16x8*)(Wg + (64 * ih + 16 * mt + fr) * 128 + 32 * ks + 8 * fq);
    __syncthreads();
    const int nks = ih ? 4 : 2;
    for (int np = 0; np < 2; ++np) {
        u32x2 uu[4][4];
#pragma unroll
        for (int mt = 0; mt < 4; ++mt)
#pragma unroll
            for (int nt = 0; nt < 4; ++nt) uu[mt][nt] = *(const u32x2*)(Z + (size_t)(row0 + 64 * ih + 16 * mt + fr) * DIN + g * 128 + np * 64 + nt * 16 + 4 * fq);
        f32x4 acc[4][4];
#pragma unroll
        for (int i = 0; i < 4; ++i)
#pragma unroll
            for (int j = 0; j < 4; ++j) acc[i][j] = (f32x4){0.f, 0.f, 0.f, 0.f};
#pragma unroll
        for (int ks = 0; ks < 4; ++ks) if (ks < nks) {
            bf16x8 vf[4];
#pragma unroll
            for (int nt = 0; nt < 4; ++nt) vf[nt] = *(const LAS bf16x8*)(lds + (g * 128 + np * 64 + nt * 16 + fr) * 272 + (32 * ks + 8 * fq) * 2);
#pragma unroll
            for (int mt = 0; mt < 4; ++mt)
#pragma unroll
                for (int nt = 0; nt < 4; ++nt) acc[mt][nt] = __builtin_amdgcn_mfma_f32_16x16x32_bf16(vf[nt], wf[mt][ks], acc[mt][nt], 0, 0, 0);
        }
#pragma unroll
        for (int mt = 0; mt < 4; ++mt) { const int i = 64 * ih + 16 * mt + fr; const float bias = a.b_s[g * 128 + (c >= 128 ? (i & 7) : i)];
#pragma unroll
            for (int nt = 0; nt < 4; ++nt) { bf16_t* up = Z + (size_t)(row0 + i) * DIN + g * 128 + np * 64 + nt * 16 + 4 * fq;
                const u32x2 u2 = uu[mt][nt]; u32x2 o;
                o.x = pk2(bf_lo(u2.x) * (acc[mt][nt][0] + bias), bf_hi(u2.x) * (acc[mt][nt][1] + bias));
                o.y = pk2(bf_lo(u2.y) * (acc[mt][nt][2] + bias), bf_hi(u2.y) * (acc[mt][nt][3] + bias));
                *(u32x2*)up = o; } }
    }
}
template <int WIN, bool SAMPLE>
__device__ __forceinline__ void p2b_rows(const Args& a, const float* P, bf16_t* Z, int grow0, int ch) {
#pragma unroll 1
    for (int r4 = 0; r4 < 32; r4 += 4) {
        float v[4][WIN];
#pragma unroll
        for (int i = 0; i < 4; ++i) { const int grow = grow0 + r4 + i;
            if (!SAMPLE) { const int t = grow & 2047;
#pragma unroll
                for (int k = 0; k < WIN; ++k) v[i][k] = (t - k >= 0) ? P[(size_t)(grow - k) * 256 + ch] : 0.f;
            } else { const int sr = grow - MP, b = sr >> 3, t = sr & 7;
#pragma unroll
                for (int k = 0; k < WIN; ++k) v[i][k] = (t - k >= 0) ? P[(size_t)(grow - k) * 256 + ch] : a.state_pool[((size_t)b * 15 + 15 + t - k) * 256 + ch];
            } }
#pragma unroll
        for (int i = 0; i < 4; ++i) { const int grow = grow0 + r4 + i; float sum = 0.f;
#pragma unroll
            for (int k = 0; k < WIN; ++k) sum += v[i][k];
            float inv = 1.0f / (float)WIN;
            if (!SAMPLE) { const int t = grow & 2047; if (t + 1 < WIN) inv = 1.0f / (float)(t + 1); }
            Z[(size_t)grow * DIN + 1024 + ch] = (bf16_t)f2bf(sum * inv - v[i][0]); }
    }
}
template <int WIN>
__device__ __forceinline__ void p2b_rows_prompt(const float* P, bf16_t* Z, int grow0, int ch) {
    const int t0 = grow0 & 2047;
    float x[32 + WIN - 1];
#pragma unroll
    for (int j = 0; j < 32 + WIN - 1; ++j) { const int d = j - (WIN - 1); x[j] = (t0 + d >= 0) ? P[(size_t)(grow0 + d) * 256 + ch] : 0.f; }
    float sum = 0.f;
#pragma unroll
    for (int j = 0; j < WIN; ++j) sum += x[j];
#pragma unroll
    for (int i = 0; i < 32; ++i) {
        if (i > 0) sum += x[i + WIN - 1] - x[i - 1];
        const int t = t0 + i; const float inv = (t + 1 < WIN) ? 1.0f / (float)(t + 1) : 1.0f / (float)WIN;
        Z[(size_t)(grow0 + i) * DIN + 1024 + ch] = (bf16_t)f2bf(sum * inv - x[i + WIN - 1]);
    }
}
template <int WIN>
__device__ __forceinline__ void p2b_rows_sample(const Args& a, const float* P, bf16_t* Z, int grow0, int ch) {
    float x[4][8 + WIN - 1];
#pragma unroll
    for (int q = 0; q < 4; ++q) { const int b = (grow0 - MP) / 8 + q;
#pragma unroll
        for (int j = 0; j < 8 + WIN - 1; ++j) { const int d = j - (WIN - 1);
            x[q][j] = d >= 0 ? P[(size_t)(grow0 + 8 * q + d) * 256 + ch] : a.state_pool[((size_t)b * 15 + 15 + d) * 256 + ch]; } }
#pragma unroll
    for (int q = 0; q < 4; ++q) { float sum = 0.f;
#pragma unroll
        for (int j = 0; j < WIN; ++j) sum += x[q][j];
#pragma unroll
        for (int i = 0; i < 8; ++i) { if (i > 0) sum += x[q][i + WIN - 1] - x[q][i - 1];
            Z[(size_t)(grow0 + 8 * q + i) * DIN + 1024 + ch] = (bf16_t)f2bf(sum * (1.0f / (float)WIN) - x[q][i + WIN - 1]); } }
}
__device__ __forceinline__ void p2b_unit(const Args& a, int u, int tid) {
    bf16_t* Z = (bf16_t*)(a.ws + WS_Z);
    const float* P = (const float*)((const unsigned char*)a.out + OS_P);
    const int ch = tid & 255, grow0 = u * 64 + (tid >> 8) * 32, gi = __builtin_amdgcn_readfirstlane(ch >> 6);
    if (grow0 < MP) { if (gi == 0) p2b_rows_prompt<2>(P, Z, grow0, ch); else if (gi == 1) p2b_rows_prompt<4>(P, Z, grow0, ch); else if (gi == 2) p2b_rows_prompt<8>(P, Z, grow0, ch); else p2b_rows_prompt<16>(P, Z, grow0, ch); }
    else { if (gi == 0) p2b_rows_sample<2>(a, P, Z, grow0, ch); else if (gi == 1) p2b_rows_sample<4>(a, P, Z, grow0, ch); else if (gi == 2) p2b_rows_sample<8>(a, P, Z, grow0, ch); else p2b_rows_sample<16>(a, P, Z, grow0, ch); }
}
__device__ __forceinline__ void attn_wave(const Args& a, int qrow0, int valid, int kvb, int h, int lane) {
    bf16_t* Z = (bf16_t*)(a.ws + WS_Z);
    const bf16_t* KB = (const bf16_t*)((const unsigned char*)a.out + OS_KB) + (size_t)kvb * 65536 + h * 64;
    const bf16_t* VT = (const bf16_t*)((const unsigned char*)a.out + OS_VTB) + (size_t)kvb * 65536 + (size_t)(h * 64) * 256;
    const int fr = lane & 15, fq = lane >> 4;
    const int qr = qrow0 + (fr < valid ? fr : valid - 1);
    bf16x8 qf[2];
#pragma unroll
    for (int ks = 0; ks < 2; ++ks) qf[ks] = *(const bf16x8*)(Z + (size_t)qr * DIN + 1280 + h * 64 + 32 * ks + 8 * fq);
    f32x4 s[16];
#pragma unroll
    for (int t = 0; t < 16; ++t) { s[t] = (f32x4){0.f, 0.f, 0.f, 0.f};
        const int key = 32 * (t >> 1) + 8 * (fr >> 2) + 4 * (t & 1) + (fr & 3);
#pragma unroll
        for (int ks = 0; ks < 2; ++ks) { bf16x8 kf;
            if (kvb < 8) kf = *(const bf16x8*)(KB + (size_t)key * 256 + 32 * ks + 8 * fq);
            else { const f32x4* kp = (const f32x4*)(a.cache_k + (size_t)(kvb - 8) * 65536 + (size_t)key * 256 + h * 64 + 32 * ks + 8 * fq); const f32x4 k0 = __builtin_nontemporal_load(kp), k1 = __builtin_nontemporal_load(kp + 1);
                u32x4 kw; kw.x = pk2(k0[0], k0[1]); kw.y = pk2(k0[2], k0[3]); kw.z = pk2(k1[0], k1[1]); kw.w = pk2(k1[2], k1[3]); kf = __builtin_bit_cast(bf16x8, kw); }
            s[t] = __builtin_amdgcn_mfma_f32_16x16x32_bf16(kf, qf[ks], s[t], 0, 0, 0); } }
    float mx = -3.0e38f;
#pragma unroll
    for (int t = 0; t < 16; ++t) mx = fmaxf(mx, fmaxf(fmaxf(s[t][0], s[t][1]), fmaxf(s[t][2], s[t][3])));
    mx = fmaxf(mx, __shfl_xor(mx, 16)); mx = fmaxf(mx, __shfl_xor(mx, 32));
    const float sc = 0.125f * 1.4426950409f; float sum = 0.f;
#pragma unroll
    for (int t = 0; t < 16; ++t)
#pragma unroll
        for (int e = 0; e < 4; ++e) { const float p = __builtin_amdgcn_exp2f((s[t][e] - mx) * sc); s[t][e] = p; sum += p; }
    sum += __shfl_xor(sum, 16); sum += __shfl_xor(sum, 32);
    const float rs = 1.0f / sum;
    f32x4 o[4];
#pragma unroll
    for (int dt = 0; dt < 4; ++dt) o[dt] = (f32x4){0.f, 0.f, 0.f, 0.f};
#pragma unroll
    for (int sk = 0; sk < 8; ++sk) { u32x4 pw; pw.x = pk2(s[2 * sk][0], s[2 * sk][1]); pw.y = pk2(s[2 * sk][2], s[2 * sk][3]); pw.z = pk2(s[2 * sk + 1][0], s[2 * sk + 1][1]); pw.w = pk2(s[2 * sk + 1][2], s[2 * sk + 1][3]);
        const bf16x8 pf = __builtin_bit_cast(bf16x8, pw);
#pragma unroll
        for (int dt = 0; dt < 4; ++dt) { const bf16x8 vf = *(const bf16x8*)(VT + (size_t)(16 * dt + fr) * 256 + 32 * sk + 8 * fq);
            o[dt] = __builtin_amdgcn_mfma_f32_16x16x32_bf16(vf, pf, o[dt], 0, 0, 0); } }
    if (fr < valid) {
#pragma unroll
        for (int dt = 0; dt < 4; ++dt) { u32x2 w; w.x = pk2(o[dt][0] * rs, o[dt][1] * rs); w.y = pk2(o[dt][2] * rs, o[dt][3] * rs);
            *(u32x2*)(Z + (size_t)(qrow0 + fr) * DIN + 1280 + h * 64 + 16 * dt + 4 * fq) = w; } }
}
__device__ __forceinline__ void attn_block_prompt(const Args& a, LAS unsigned char* lds, int c, int h, int tid) {
    const int w = tid >> 6, lane = tid & 63, fr = lane & 15, fq = lane >> 4, kvb = c >> 4, qrow0 = c * 128 + 16 * w;
    bf16_t* Z = (bf16_t*)(a.ws + WS_Z);
    const bf16_t* KB = (const bf16_t*)((const unsigned char*)a.out + OS_KB) + (size_t)kvb * 65536 + h * 64;
    const bf16_t* VT = (const bf16_t*)((const unsigned char*)a.out + OS_VTB) + (size_t)kvb * 65536 + (size_t)(h * 64) * 256;
    u32x4 kst[4], vst[4];
#pragma unroll
    for (int i = 0; i < 4; ++i) { const int ck = tid + 512 * i;
        kst[i] = *(const u32x4*)(KB + (size_t)(ck >> 3) * 256 + (ck & 7) * 8);
        vst[i] = *(const u32x4*)(VT + (size_t)(ck >> 5) * 256 + (ck & 31) * 8); }
    bf16x8 qf[2];
#pragma unroll
    for (int ks = 0; ks < 2; ++ks) qf[ks] = *(const bf16x8*)(Z + (size_t)(qrow0 + fr) * DIN + 1280 + h * 64 + 32 * ks + 8 * fq);
    __syncthreads();
#pragma unroll
    for (int i = 0; i < 4; ++i) { const int ck = tid + 512 * i;
        *(LAS u32x4*)(lds + (ck >> 3) * 144 + (ck & 7) * 16) = kst[i];
        *(LAS u32x4*)(lds + 36864 + (ck >> 5) * 528 + (ck & 31) * 16) = vst[i]; }
    __syncthreads();
    f32x4 s[16];
#pragma unroll
    for (int t = 0; t < 16; ++t) { s[t] = (f32x4){0.f, 0.f, 0.f, 0.f};
        const int key = 32 * (t >> 1) + 8 * (fr >> 2) + 4 * (t & 1) + (fr & 3);
#pragma unroll
        for (int ks = 0; ks < 2; ++ks) { const bf16x8 kf = *(const LAS bf16x8*)(lds + key * 144 + (32 * ks + 8 * fq) * 2);
            s[t] = __builtin_amdgcn_mfma_f32_16x16x32_bf16(kf, qf[ks], s[t], 0, 0, 0); } }
    float mx = -3.0e38f;
#pragma unroll
    for (int t = 0; t < 16; ++t) mx = fmaxf(mx, fmaxf(fmaxf(s[t][0], s[t][1]), fmaxf(s[t][2], s[t][3])));
    mx = fmaxf(mx, __shfl_xor(mx, 16)); mx = fmaxf(mx, __shfl_xor(mx, 32));
    const float sc = 0.125f * 1.4426950409f; float sum = 0.f;
#pragma unroll
    for (int t = 0; t < 16; ++t)
#pragma unroll
        for (int e = 0; e < 4; ++e) { const float pe = __builtin_amdgcn_exp2f((s[t][e] - mx) * sc); s[t][e] = pe; sum += pe; }
    sum += __shfl_xor(sum, 16); sum += __shfl_xor(sum, 32);
    const float rs = 1.0f / sum;
    f32x4 o[4];
#pragma unroll
    for (int dt = 0; dt < 4; ++dt) o[dt] = (f32x4){0.f, 0.f, 0.f, 0.f};
#pragma unroll
    for (int sk = 0; sk < 8; ++sk) { u32x4 pw; pw.x = pk2(s[2 * sk][0], s[2 * sk][1]); pw.y = pk2(s[2 * sk][2], s[2 * sk][3]); pw.z = pk2(s[2 * sk + 1][0], s[2 * sk + 1][1]); pw.w = pk2(s[2 * sk + 1][2], s[2 * sk + 1][3]);
        const bf16x8 pf = __builtin_bit_cast(bf16x8, pw);
#pragma unroll
        for (int dt = 0; dt < 4; ++dt) { const bf16x8 vf = *(const LAS bf16x8*)(lds + 36864 + (16 * dt + fr) * 528 + (32 * sk + 8 * fq) * 2);
            o[dt] = __builtin_amdgcn_mfma_f32_16x16x32_bf16(vf, pf, o[dt], 0, 0, 0); } }
#pragma unroll
    for (int dt = 0; dt < 4; ++dt) { u32x2 wv; wv.x = pk2(o[dt][0] * rs, o[dt][1] * rs); wv.y = pk2(o[dt][2] * rs, o[dt][3] * rs);
        *(u32x2*)(Z + (size_t)(qrow0 + fr) * DIN + 1280 + h * 64 + 16 * dt + 4 * fq) = wv; }
}
__device__ __forceinline__ void p2_mixers(const Args& a, LAS unsigned char* lds, int tid, int G) {
    const int w = tid >> 6, lane = tid & 63;
    {
        const float* P = (const float*)((const unsigned char*)a.out + OS_P);
        for (int idx = blockIdx.x * 512 + tid; idx < 30720 + 491520; idx += G * 512) {
            if (idx < 30720) { const int b = idx / 3840, rem = idx % 3840; a.out[O_PP + idx] = P[(size_t)(b * 2048 + 2033) * 256 + rem]; }
            else { const int j = idx - 30720, b = j / 3840, rem = j % 3840, s = rem >> 8, cc = rem & 255;
                a.out[O_PS + j] = s < 7 ? a.state_pool[((size_t)b * 15 + 8 + s) * 256 + cc] : P[(size_t)(MP + b * 8 + (s - 7)) * 256 + cc]; } }
    }
    for (int it = blockIdx.x; it < 136; it += G) p2a_unit(a, lds, it, tid);
    { int u0 = ((int)blockIdx.x - 136) % G; if (u0 < 0) u0 += G;
      for (int u = u0; u < 272; u += G) p2b_unit(a, u, tid); }
    { int u0 = ((int)blockIdx.x - 408) % G; if (u0 < 0) u0 += G;
      for (int idx = u0; idx < 576; idx += G) {
        if (idx < 512) { attn_block_prompt(a, lds, idx >> 2, idx & 3, tid); }
        else { const int batch = 2 * (idx - 512) + (w >> 2); attn_wave(a, MP + 8 * batch, 8, 8 + batch, w & 3, lane); } } }
}
__device__ __forceinline__ void p7_final(const Args& a, LAS unsigned char* lds, int tid, int G) {
    const int wave = tid >> 6, lane = tid & 63;
    const f32x4* gr = (const f32x4*)a.g_final + lane;
    const bool split = (G == 256);
    for (int r2 = blockIdx.x * 8 + wave; r2 < (split ? 0 : MT) / 2; r2 += G * 8) {
        f32x4* xa = (f32x4*)(a.out + (size_t)(2 * r2) * DM) + lane; f32x4* xb = xa + DM / 4; f32x4 v[2][4]; float s0 = 0.f, s1 = 0.f;
#pragma unroll
        for (int j = 0; j < 4; ++j) { v[0][j] = xa[64 * j]; v[1][j] = xb[64 * j]; }
#pragma unroll
        for (int j = 0; j < 4; ++j) { s0 += (v[0][j][0] * v[0][j][0] + v[0][j][1] * v[0][j][1]) + (v[0][j][2] * v[0][j][2] + v[0][j][3] * v[0][j][3]);
                                      s1 += (v[1][j][0] * v[1][j][0] + v[1][j][1] * v[1][j][1]) + (v[1][j][2] * v[1][j][2] + v[1][j][3] * v[1][j][3]); }
        const float r0 = 1.0f / sqrtf(wave_sum(s0) * (1.0f / DM) + EPS), r1 = 1.0f / sqrtf(wave_sum(s1) * (1.0f / DM) + EPS);
#pragma unroll
        for (int j = 0; j < 4; ++j) { const f32x4 gg = gr[64 * j]; xa[64 * j] = v[0][j] * r0 * gg; xb[64 * j] = v[1][j] * r1 * gg; }
    }
    if (split) {
        LAS float* red = (LAS float*)lds;
        const int rr = tid >> 7, t7 = tid & 127, c8 = t7 * 8;
        const f32x4 g0 = *(const f32x4*)(a.g_final + c8), g1 = *(const f32x4*)(a.g_final + c8 + 4);
        for (int sr0 = blockIdx.x * 4; sr0 < MS; sr0 += G * 4) { const int sr = sr0 + rr;
            const u32x4 xw = __builtin_nontemporal_load((const u32x4*)((const bf16_t*)(a.ws + WS_X1B_HI) + (size_t)(MP + sr - X1B_SPLIT * 256) * DM + c8));
            f32x4 pv[16][2];
#pragma unroll
            for (int k = 0; k < 16; ++k) { const f32x4* pp = (const f32x4*)(part_base(a.ws, k) + (size_t)sr * DM + c8); pv[k][0] = pp[0]; pv[k][1] = pp[1]; }
            f32x4 v0 = (f32x4){bf_lo(xw.x), bf_hi(xw.x), bf_lo(xw.y), bf_hi(xw.y)}, v1 = (f32x4){bf_lo(xw.z), bf_hi(xw.z), bf_lo(xw.w), bf_hi(xw.w)};
#pragma unroll
            for (int k = 0; k < 16; ++k) { v0 += pv[k][0]; v1 += pv[k][1]; }
            const float ws_ = wave_sum((v0[0] * v0[0] + v0[1] * v0[1]) + (v0[2] * v0[2] + v0[3] * v0[3]) + (v1[0] * v1[0] + v1[1] * v1[1]) + (v1[2] * v1[2] + v1[3] * v1[3]));
            __syncthreads();
            if (lane == 0) red[wave] = ws_;
            __syncthreads();
            const float rstd = 1.0f / sqrtf((red[2 * rr] + red[2 * rr + 1]) * (1.0f / DM) + EPS);
            float* xo = a.out + (size_t)(MP + sr) * DM + c8;
            __builtin_nontemporal_store(v0 * rstd * g0, (f32x4*)xo); __builtin_nontemporal_store(v1 * rstd * g1, (f32x4*)(xo + 4));
        }
    }
}

#define XB_TMO      128
#define XB_XCNT(j)  (256  + 64 * (j))
#define XB_XSUB(j)  (1280 + 64 * (j))
#define XB_XGEN(j)  (2304 + 64 * (j))
#define XB_TOP      3328
#define XB_TOPGEN   3392
#define XCD_BAR_WORDS 3456
#define XB_SPIN_CAP (1u << 18)
__device__ __forceinline__ unsigned xb_ld(unsigned* p)              { return __hip_atomic_load(p, __ATOMIC_RELAXED, __HIP_MEMORY_SCOPE_AGENT); }
__device__ __forceinline__ unsigned xb_add(unsigned* p, unsigned v) { return __hip_atomic_fetch_add(p, v, __ATOMIC_RELAXED, __HIP_MEMORY_SCOPE_AGENT); }
__device__ __forceinline__ unsigned xb_xcc_id() { return (unsigned)__builtin_amdgcn_s_getreg((3 << 11) | 20) & 0xFu; }
#define XB_SPIN(cond, bar) do { unsigned _sp = 0; while (cond) { __builtin_amdgcn_s_sleep(1); \
    if ((++_sp & 255u) == 0u) { if (xb_ld(&(bar)[XB_TMO])) break; if (_sp > XB_SPIN_CAP) { atomicAdd(&(bar)[XB_TMO], 1u); break; } } } } while (0)
struct XcdBarrier { unsigned* bar; unsigned x; volatile LAS unsigned* st; };
__device__ __forceinline__ XcdBarrier xcd_barrier_post(unsigned* bar, volatile LAS unsigned* st, int wave_s) {
    XcdBarrier b; b.bar = bar; b.x = xb_xcc_id(); b.st = st;
    if (wave_s == 0 && lane_id() == 0) (void)xb_add(&bar[XB_XCNT(b.x)], 1u);
    return b;
}
__device__ __forceinline__ void xcd_barrier_complete(unsigned* bar, unsigned x, unsigned& nloc, unsigned& nx) {
    const unsigned G = gridDim.x * gridDim.y * gridDim.z;
    unsigned sum, cnt, mine, sp = 0u;
    for (;;) {
        sum = 0u; cnt = 0u; mine = 0u;
#pragma unroll
        for (unsigned j = 0; j < 16; ++j) { const unsigned c = xb_ld(&bar[XB_XCNT(j)]); sum += c; cnt += (c > 0u) ? 1u : 0u; mine = (j == x) ? c : mine; }
        if (sum == G) break;
        __builtin_amdgcn_s_sleep(1);
        if ((++sp & 255u) == 0u) { if (xb_ld(&bar[XB_TMO])) break; if (sp > XB_SPIN_CAP) { atomicAdd(&bar[XB_TMO], 1u); break; } }
    }
    nloc = mine > 0u ? mine : 1u; nx = cnt > 0u ? cnt : 1u;
}
__device__ __forceinline__ void xcd_barrier(const XcdBarrier& b, int wave_s) {
    asm volatile("s_waitcnt vmcnt(0)" ::: "memory");
    __syncthreads();
    if (wave_s == 0 && lane_id() == 0) {
        unsigned* bar = b.bar;
        __builtin_amdgcn_s_waitcnt(0);
        unsigned nloc = b.st[0], nx = b.st[1];
        if (nloc == 0u) { xcd_barrier_complete(bar, b.x, nloc, nx); b.st[0] = nloc; b.st[1] = nx; }
        const unsigned old = xb_add(&bar[XB_XSUB(b.x)], 1u);
        const unsigned gen = old / nloc;
        if (old + 1u == (gen + 1u) * nloc) {
            __builtin_amdgcn_fence(__ATOMIC_RELEASE, "agent");
            asm volatile("s_waitcnt vmcnt(0)" ::: "memory");
            const unsigned og = xb_add(&bar[XB_TOP], 1u);
            const unsigned tg = og / nx;
            if (og + 1u == (tg + 1u) * nx) xb_add(&bar[XB_TOPGEN], 1u);
            else XB_SPIN(xb_ld(&bar[XB_TOPGEN]) == tg, bar);
            __builtin_amdgcn_fence(__ATOMIC_ACQUIRE, "agent");
            xb_add(&bar[XB_XGEN(b.x)], 1u);
            asm volatile("s_waitcnt vmcnt(0)" ::: "memory");
        } else {
            XB_SPIN(xb_ld(&bar[XB_XGEN(b.x)]) == gen, bar);
            __builtin_amdgcn_fence(__ATOMIC_ACQUIRE, "agent");
            asm volatile("s_waitcnt vmcnt(0)" ::: "memory");
        }
    }
    __syncthreads();
}

__device__ __forceinline__ void panel_signal(unsigned* cnt, int wave_s) {
    asm volatile("s_waitcnt vmcnt(0)" ::: "memory");
    __syncthreads();
    if (wave_s == 0 && lane_id() == 0) (void)xb_add(cnt, 1u);
}
__device__ __forceinline__ void panel_wait(unsigned* cnt, unsigned want, unsigned* bar, int wave_s) {
    if (wave_s == 0 && lane_id() == 0) { XB_SPIN(xb_ld(cnt) < want, bar); __builtin_amdgcn_fence(__ATOMIC_ACQUIRE, "agent"); asm volatile("s_waitcnt vmcnt(0)" ::: "memory"); }
    __syncthreads();
}

template <bool P3S>
__device__ __forceinline__ void mini_block(const Args& a, LAS unsigned char* lds, int blk, int tid) {
    const int w = tid >> 6, lane = tid & 63, fr = lane & 15, fq = lane >> 4, rb = blk >> 4, cb = blk & 15;
    const int k0 = 128 * w;
    const bf16_t* Ab; int lda, acol;
    if (P3S) { Ab = (const bf16_t*)(a.ws + WS_Z); lda = DIN; acol = k0 + (k0 >= 512 ? 512 : 0); }
    else { Ab = (const bf16_t*)(a.ws + WS_XN); lda = DM; acol = k0; }
    const bf16_t* Bb = (const bf16_t*)(a.ws + (P3S ? WS_WBR : WS_WO));
    bf16x8 af[4][4], bf[4][4];
#pragma unroll
    for (int t = 0; t < 4; ++t)
#pragma unroll
        for (int ks = 0; ks < 4; ++ks) { af[t][ks] = *(const bf16x8*)(Ab + (size_t)(MP + 64 * rb + 16 * t + fr) * lda + acol + 32 * ks + 8 * fq);
                                         bf[t][ks] = *(const bf16x8*)(Bb + (size_t)(64 * cb + 16 * t + fr) * 1024 + k0 + 32 * ks + 8 * fq); }
    f32x4 acc[4][4];
#pragma unroll
    for (int mt = 0; mt < 4; ++mt)
#pragma unroll
        for (int nt = 0; nt < 4; ++nt) acc[mt][nt] = (f32x4){0.f, 0.f, 0.f, 0.f};
#pragma unroll
    for (int ks = 0; ks < 4; ++ks)
#pragma unroll
        for (int mt = 0; mt < 4; ++mt)
#pragma unroll
            for (int nt = 0; nt < 4; ++nt) acc[mt][nt] = __builtin_amdgcn_mfma_f32_16x16x32_bf16(bf[nt][ks], af[mt][ks], acc[mt][nt], 0, 0, 0);
    LAS float* red = (LAS float*)lds;
    __syncthreads();
#pragma unroll
    for (int mt = 0; mt < 4; ++mt)
#pragma unroll
        for (int nt = 0; nt < 4; ++nt) *(LAS f32x4*)(red + (size_t)((w * 64 + 16 * mt + fr) * 68 + 16 * nt + 4 * fq)) = acc[mt][nt];
    __syncthreads();
    const int r = tid >> 3, c8 = (tid & 7) * 8, row = MP + 64 * rb + r, col = 64 * cb + c8;
    f32x4 s0[3], s1[3];
#pragma unroll
    for (int g = 0; g < 3; ++g) { s0[g] = (f32x4){0.f, 0.f, 0.f, 0.f}; s1[g] = s0[g]; }
#pragma unroll
    for (int ww = 0; ww < 8; ++ww) { const int g = P3S ? (ww < 4 ? 0 : (ww < 6 ? 1 : 2)) : 0; const LAS f32x4* pp = (const LAS f32x4*)(red + (size_t)((ww * 64 + r) * 68 + c8)); s0[g] += pp[0]; s1[g] += pp[1]; }
    if (P3S) {
        bf16_t* MG = (bf16_t*)(a.ws + WS_XN);
        const unsigned char* gp = (const unsigned char*)(a.ws + WS_Z) + (size_t)row * (DIN * 2) + 3072 + (col & ~255) + ((col & 127) >> 3) * 16 + ((col >> 7) & 1) * 8;
        const u32x2 qa = *(const u32x2*)gp, qb = *(const u32x2*)(gp + 1024), qc = *(const u32x2*)(gp + 2048); const float k = 1.0f / 255.0f;
        float m[8];
        m[0] = (s0[0][0] * ub0(qa.x) + s0[1][0] * ub0(qb.x) + s0[2][0] * ub0(qc.x)) * k; m[1] = (s0[0][1] * ub1(qa.x) + s0[1][1] * ub1(qb.x) + s0[2][1] * ub1(qc.x)) * k;
        m[2] = (s0[0][2] * ub2(qa.x) + s0[1][2] * ub2(qb.x) + s0[2][2] * ub2(qc.x)) * k; m[3] = (s0[0][3] * ub3(qa.x) + s0[1][3] * ub3(qb.x) + s0[2][3] * ub3(qc.x)) * k;
        m[4] = (s1[0][0] * ub0(qa.y) + s1[1][0] * ub0(qb.y) + s1[2][0] * ub0(qc.y)) * k; m[5] = (s1[0][1] * ub1(qa.y) + s1[1][1] * ub1(qb.y) + s1[2][1] * ub1(qc.y)) * k;
        m[6] = (s1[0][2] * ub2(qa.y) + s1[1][2] * ub2(qb.y) + s1[2][2] * ub2(qc.y)) * k; m[7] = (s1[0][3] * ub3(qa.y) + s1[1][3] * ub3(qb.y) + s1[2][3] * ub3(qc.y)) * k;
        u32x4 o; o.x = pk2(m[0], m[1]); o.y = pk2(m[2], m[3]); o.z = pk2(m[4], m[5]); o.w = pk2(m[6], m[7]);
        *(u32x4*)(MG + (size_t)row * DM + col) = o;
    } else {
        const f32x4* xp = (const f32x4*)(a.x_sample + (size_t)(row - MP) * DM + col);
        const f32x4 v0 = s0[0] + __builtin_nontemporal_load(xp), v1 = s1[0] + __builtin_nontemporal_load(xp + 1);
        u32x4 o; o.x = pk2(v0[0], v0[1]); o.y = pk2(v0[2], v0[3]); o.z = pk2(v1[0], v1[1]); o.w = pk2(v1[2], v1[3]);
        *(u32x4*)((bf16_t*)(a.ws + WS_X1B_HI) + (size_t)(row - X1B_SPLIT * 256) * DM + col) = o;
        float ss = (v0[0] * v0[0] + v0[1] * v0[1]) + (v0[2] * v0[2] + v0[3] * v0[3]) + (v1[0] * v1[0] + v1[1] * v1[1]) + (v1[2] * v1[2] + v1[3] * v1[3]);
        ss += __shfl_xor(ss, 1); ss += __shfl_xor(ss, 2); ss += __shfl_xor(ss, 4);
        if ((tid & 7) == 0) ((float*)(a.ws + WS_SSP))[(size_t)row * 16 + cb] = ss;
    }
    __syncthreads();
}

__global__ void __launch_bounds__(512, 2) fwd_kernel(Args a) {
    extern __shared__ __attribute__((aligned(16))) unsigned char lds_raw[];
    LAS unsigned char* lds = (LAS unsigned char*)lds_raw;
    cg::grid_group grid = cg::this_grid();
    const int wave_s = __builtin_amdgcn_readfirstlane((int)threadIdx.x >> 6);
#define tid (wave_s * 64 + lane_id())
    const int G = gridDim.x, c = blockIdx.x;
    const int lo = a.ph_lo, hi = a.ph_hi;
#define IN(k) (lo <= (k) && (k) < hi)
#define SEAM(k) do { if (IN(k) && IN((k) + 1)) xcd_barrier(bar, wave_s); } while (0)
    if (tid < 64) ((LAS unsigned*)(lds + 147456))[tid] = 0u;
    __syncthreads();
    const XcdBarrier bar = xcd_barrier_post((unsigned*)a.ws, (volatile LAS unsigned*)(lds + 147456), wave_s);
    if (lo < 0) grid.sync();
    bf16_t* XN = (bf16_t*)(a.ws + WS_XN); bf16_t* Z = (bf16_t*)(a.ws + WS_Z); bf16_t* MG = XN; bf16_t* H = Z; bf16_t* X1Blo = (bf16_t*)(a.ws + WS_X1B_LO); bf16_t* X1Bhi = (bf16_t*)(a.ws + WS_X1B_HI);
    float* SSP = (float*)(a.ws + WS_SSP);
    constexpr int REPS[8] = {1, 1, 1, 1, 1, 1, 1, 1};
    if (IN(0)) { for (int rep = 0; rep < REPS[0]; ++rep) p0_prologue(a, lds, tid, G); } SEAM(0);
    if (IN(1)) { for (int rep = 0; rep < REPS[1]; ++rep) { pg8::Gemm g{XN, (const bf16_t*)(a.ws + WS_WIN), 1024, 1024, nullptr, 1 << 30}; SchedP1 S{G, c};
        EpiP1 E{Z, (float*)((unsigned char*)a.out + OS_P), a.out + O_MK, a.out + O_MV, (bf16_t*)((unsigned char*)a.out + OS_KB), (bf16_t*)((unsigned char*)a.out + OS_VTB)};
        pg8::gemm_phase(lds, g, S, E, wave_s); } } SEAM(1);
    if (IN(2)) { p2_mixers(a, lds, tid, G); } SEAM(2);
    if (IN(3)) {
        unsigned* cnt = (unsigned*)a.ws + 8192;
        const pg8::Gemm g3{Z, (const bf16_t*)(a.ws + WS_WBR), DIN, 1024, nullptr, 1 << 30}; const EpiP3 E3{Z, MG, G != 256};
        const pg8::Gemm g4{MG, (const bf16_t*)(a.ws + WS_WO), 1024, 1024, nullptr, 1 << 30}; const EpiP4 E4{a.x_prompt, a.x_sample, a.out, X1Blo, X1Bhi, SSP, (float*)(a.ws + WS_SSP4), lds};
        if (G == 256) {
            int pm, pn; pg8::tile_map(64, 4, c, pm, pn);
            { SchedOne3 S{pm, pn}; pg8::gemm_phase(lds, g3, S, E3, wave_s); }
            mini_block<true>(a, lds, c, tid);
            xcd_barrier(bar, wave_s);
            { SchedOne S{pm, pn, 16}; pg8::gemm_phase(lds, g4, S, E4, wave_s); }
            mini_block<false>(a, lds, c, tid);
        } else {
            for (int L = c; L < 272; L += G) { int pm, pn; tile272(L, pm, pn); SchedOne3 S{pm, pn}; pg8::gemm_phase(lds, g3, S, E3, wave_s); panel_signal(cnt + 64 * pm, wave_s); }
            int L0 = (c - 16) % G; if (L0 < 0) L0 += G;
            for (int L = L0; L < 272; L += G) { int pm, pn; tile272(L, pm, pn); panel_wait(cnt + 64 * pm, 4u, (unsigned*)a.ws, wave_s); SchedOne S{pm, pn, 16}; pg8::gemm_phase(lds, g4, S, E4, wave_s); }
        }
        p0_deferred(a, lds, tid, G);
    } SEAM(4);
    if (IN(5)) { for (int rep = 0; rep < REPS[5]; ++rep) { pg8::Gemm g{X1Blo, (const bf16_t*)(a.ws + WS_WUP), 1024, 1024, X1Bhi, X1B_SPLIT}; SchedT S{68, 16, 16, G, c}; EpiP5 E{SSP, H, (const float*)(a.ws + WS_SSP4), G == 256 ? 64 : 68}; pg8::gemm_phase(lds, g, S, E, wave_s); } } SEAM(5);
    if (IN(6)) { pg8::Gemm g{H, (const bf16_t*)(a.ws + WS_WDN), DFF, DFF, nullptr, 1 << 30}; SchedP6 S{G, c};
        if (G == 256) { EpiP6F E{a.out, a.ws, X1Blo, X1Bhi, a.out + (size_t)MP * DM  , (unsigned*)a.ws + 8192 + 64 * 68, (unsigned*)a.ws, a.g_final, lds}; pg8::gemm_phase(lds, g, S, E, wave_s); }
        else { EpiP6 E{a.out, a.ws, X1Blo, X1Bhi}; pg8::gemm_phase(lds, g, S, E, wave_s); } } SEAM(6);
    if (IN(7)) { p7_final(a, lds, tid, G); }
#undef IN
#undef SEAM
#undef tid
}

extern "C" void kernel_launch(void* const* d_in, const int* in_sizes, int n_in, void* d_out, int out_size, void* d_ws, size_t ws_size, hipStream_t stream) {
    static int grid = 0;
    if (grid == 0) {
        int dev = 0, cus = 0, per_cu = 0;
        if (n_in != 24 || ws_size < 256 * MiB) { fprintf(stderr, "kernel_launch: unexpected n_in %d / ws %zu\n", n_in, ws_size); grid = -1; return; }
        (void)hipGetDevice(&dev);
        (void)hipDeviceGetAttribute(&cus, hipDeviceAttributeMultiprocessorCount, dev);
        if (hipFuncSetAttribute((const void*)fwd_kernel, hipFuncAttributeMaxDynamicSharedMemorySize, LDS_BYTES) != hipSuccess) fprintf(stderr, "kernel_launch: hipFuncSetAttribute failed\n");
        if (hipOccupancyMaxActiveBlocksPerMultiprocessor(&per_cu, (const void*)fwd_kernel, 512, LDS_BYTES) != hipSuccess || per_cu < 1) per_cu = 1;
        (void)hipGetLastError();
        grid = cus * per_cu;
        if (grid <= 0) grid = 256;
    }
    if (grid < 0) return;
    if (hipMemsetAsync(d_ws, 0, 131072, stream) != hipSuccess) { fprintf(stderr, "kernel_launch: memset failed\n"); return; }
    Args a{};
    const float** pp = (const float**)&a;
    for (int i = 0; i < 24; ++i) pp[i] = (const float*)d_in[i];
    a.out = (float*)d_out; a.ws = (unsigned char*)d_ws; a.ph_lo = 0; a.ph_hi = 8;
    void* args[] = {&a};
    hipError_t e = hipLaunchCooperativeKernel((const void*)fwd_kernel, dim3(grid), dim3(512), args, LDS_BYTES, stream);
    if (e != hipSuccess) fprintf(stderr, "kernel_launch: cooperative launch failed: %s (grid %d)\n", hipGetErrorString(e), grid);
}
```

```cpp
#include <hip/hip_runtime.h>
#include <hip/hip_cooperative_groups.h>
#include <cstdio>
#include <cstdint>
namespace cg = cooperative_groups;

#define LAS __attribute__((address_space(3)))
typedef unsigned short bf16_t;
typedef short bf16x8 __attribute__((ext_vector_type(8)));
typedef float f32x4 __attribute__((ext_vector_type(4)));
typedef float f32x2 __attribute__((ext_vector_type(2)));
typedef unsigned u32x4 __attribute__((ext_vector_type(4)));
typedef unsigned u32x2 __attribute__((ext_vector_type(2)));

constexpr int DM = 1024, MP = 16384, MS = 1024, MT = MP + MS  , DIN = 4608, DFF = 4096;
constexpr int MKV = 2048;
constexpr float EPS = 1e-6f;
constexpr size_t MiB = 1u << 20;
constexpr size_t WS_WIN = 1 * MiB;
constexpr size_t WS_WO = 11 * MiB;
constexpr size_t WS_WUP = 13 * MiB;
constexpr size_t WS_WDN = 21 * MiB;
constexpr size_t WS_WBR = 29 * MiB;
constexpr size_t WS_WSB = 31 * MiB;
constexpr size_t WS_SSP4 = 2 * MiB + 256 * 1024;
constexpr size_t WS_SSP = 1 * MiB;
constexpr size_t WS_XN = 48 * MiB;
constexpr size_t WS_Z = 86 * MiB;
constexpr size_t WS_X1B_LO = 239 * MiB, WS_X1B_HI = 31 * MiB;
constexpr int X1B_SPLIT = 34;
constexpr size_t OS_P = 0;
constexpr size_t OS_KB = 17 * MiB;
constexpr size_t OS_VTB = 34 * MiB;
constexpr size_t O_Y = 0, O_MK = 17825792, O_MV = 18350080, O_PP = 18874368, O_PS = 18905088, O_CVP = 19396608, O_CVS = 19920896;
constexpr int LDS_BYTES = 147456 + 256;

__device__ __forceinline__ unsigned f2bf(float f) { unsigned u = __builtin_bit_cast(unsigned, f); return (u + 0x7fffu + ((u >> 16) & 1u)) >> 16; }
__device__ __forceinline__ unsigned pk2(float lo, float hi) { return f2bf(lo) | (f2bf(hi) << 16); }
__device__ __forceinline__ float bf_lo(unsigned w) { return __builtin_bit_cast(float, w << 16); }
__device__ __forceinline__ float bf_hi(unsigned w) { return __builtin_bit_cast(float, w & 0xffff0000u); }
__device__ __forceinline__ unsigned cvt_pk_bf16(float lo, float hi) { unsigned r; asm volatile("v_cvt_pk_bf16_f32 %0, %1, %2" : "=v"(r) : "v"(lo), "v"(hi)); return r; }
__device__ __forceinline__ float gelu_t(float x) {
    const float y = 0.7978845608f * (x + 0.044715f * x * x * x);
    const float e = __builtin_amdgcn_exp2f(-2.885390082f * y);
    return x * __builtin_amdgcn_rcpf(1.0f + e);
}
__device__ __forceinline__ unsigned gate_q(float x) { const float g = __builtin_amdgcn_rcpf(1.0f + __builtin_amdgcn_exp2f(-1.4426950409f * x)); return (unsigned)fminf(fmaxf(g * 255.0f + 0.5f, 1.0f), 255.0f); }
__device__ __forceinline__ float ub0(unsigned w) { return (float)(w & 0xffu); }
__device__ __forceinline__ float ub1(unsigned w) { return (float)((w >> 8) & 0xffu); }
__device__ __forceinline__ float ub2(unsigned w) { return (float)((w >> 16) & 0xffu); }
__device__ __forceinline__ float ub3(unsigned w) { return (float)(w >> 24); }
__device__ __forceinline__ f32x2 gelu_t2(f32x2 x) {
    const f32x2 x2 = x * x, pch = x2 * 0.0356774081f + 0.7978845608f, t = (pch * x) * (-2.885390082f);
    f32x2 e; e.x = __builtin_amdgcn_exp2f(t.x); e.y = __builtin_amdgcn_exp2f(t.y);
    const f32x2 d = e + 1.0f; f32x2 r; r.x = __builtin_amdgcn_rcpf(d.x); r.y = __builtin_amdgcn_rcpf(d.y);
    return x * r;
}

__device__ __forceinline__ int lane_id() { int l; asm volatile("v_mbcnt_lo_u32_b32 %0, -1, 0\n\tv_mbcnt_hi_u32_b32 %0, -1, %0" : "=v"(l)); return l; }
struct Args {
    const float *x_prompt, *x_sample, *mem, *cache_k, *cache_v, *state_pool;
    const float *g_mix, *w_in, *g_v, *b_v, *w_s, *b_s, *w_pool, *pool_scale, *g_mem, *w_kv;
    const float *w_out_a, *w_out_b, *w_out_c, *w_o, *g_ffn, *w_up, *w_down, *g_final;
    float* out; unsigned char* ws; int ph_lo, ph_hi;
};

namespace pg8 {
constexpr int BM = 256, BK = 64, HALF = 128, HTB = HALF * BK * 2, STAGE_BYTES = 8 * HTB;
__device__ __forceinline__ int lds_byte(int r, int c) { const int st = (r >> 4) * 2 + (c >> 5), rr = r & 15, cc = c & 31, ob = rr * 64 + cc * 2; return st * 1024 + (ob ^ (((ob >> 9) & 1) << 5)); }
__device__ __forceinline__ void stage_rc(int b, int& R, int& C) { const int st = b / 1024, sb = b % 1024, swz = sb ^ (((sb >> 9) & 1) << 5); R = (st >> 1) * 16 + swz / 64; C = (st & 1) * 32 + (swz % 64) / 2; }
__device__ __forceinline__ int perm32(int rho) { const int n = rho >> 4, i = rho & 15; return 8 * (i >> 2) + 4 * n + (i & 3); }

struct Unit { int pm, pn, ka, kb, nt, tag; };
struct Gemm { const bf16_t* A; const bf16_t* Bt; int lda, ldb; const bf16_t* A2; int psplit; };

__device__ __forceinline__ void tile_map(int nM, int nN, int L, int& pm, int& pn) {
    const int nwg = nM * nN; int wgid = L;
    { const int q = nwg / 8, r = nwg % 8, xcd = wgid % 8, off = wgid / 8; wgid = (xcd < r ? xcd * (q + 1) : r * (q + 1) + (xcd - r) * q) + off; }
    const int nig = 8 * nN, gid = wgid / nig, fm = gid * 8, gsz = (nM - fm) < 8 ? (nM - fm) : 8;
    pm = fm + ((wgid % nig) % gsz); pn = (wgid % nig) / gsz;
}

template <class Epi, class Sched>
__device__ __forceinline__ void gemm_phase(LAS unsigned char* lds, const Gemm g, const Sched& S, const Epi& E, int wave_s) {
    const int wid = wave_s, lane = lane_id(), tid = wid * 64 + lane, wr = wid >> 2, wc = wid & 3, fr = lane & 15, fq = lane >> 4;
    unsigned voffA[2], voffB[2];
#pragma unroll
    for (int i = 0; i < 2; ++i) { int R, C; stage_rc(tid * 16 + i * 8192, R, C); const int Rb = (R & ~31) + perm32(R & 31);
        voffA[i] = (unsigned)(R * g.lda + C) * 2u; voffB[i] = (unsigned)(Rb * g.ldb + C) * 2u; }
    const size_t kstep = (size_t)(BK * 2);
    const size_t hstepA = (size_t)HALF * g.lda * 2, hstepB = (size_t)HALF * g.ldb * 2;
    const size_t tstepA = 2 * hstepA, tstepB = 2 * hstepB;
    const unsigned ldsw = (unsigned)wid * 1024u;
    const int aoff = lds_byte(wr * 64 + fr, fq * 8), boff = lds_byte(wc * 32 + fr, fq * 8);
#define PG8_SA(b, h) (((b) * 2 + (h)) * HTB)
#define PG8_SB(b, h) ((4 + (b) * 2 + (h)) * HTB)
#define PG8_STAGE(bufoff, gbase, voff) do { _Pragma("unroll") for (int _i = 0; _i < 2; ++_i) \
        __builtin_amdgcn_global_load_lds((const unsigned*)((const char*)(gbase) + (voff)[_i]), (LAS unsigned*)(lds + (bufoff) + ldsw + _i * 8192), 16, 0, 0); } while (0)
#define PG8_LDA(dst, b, h) do { _Pragma("unroll") for (int m = 0; m < 4; ++m) _Pragma("unroll") for (int k = 0; k < 2; ++k) dst[m][k] = *(const LAS bf16x8*)(lds + PG8_SA(b, h) + aoff + m * 2048 + k * 1024); } while (0)
#define PG8_LDB(dst, b, h) do { _Pragma("unroll") for (int n = 0; n < 2; ++n) _Pragma("unroll") for (int k = 0; k < 2; ++k) dst[n][k] = *(const LAS bf16x8*)(lds + PG8_SB(b, h) + boff + n * 2048 + k * 1024); } while (0)
#define PG8_MMA(ai, bj, At, Bt) do { __builtin_amdgcn_s_setprio(1); _Pragma("unroll") for (int m = 0; m < 4; ++m) _Pragma("unroll") for (int n = 0; n < 2; ++n) _Pragma("unroll") for (int k = 0; k < 2; ++k) \
        acc[ai][bj][m][n] = __builtin_amdgcn_mfma_f32_16x16x32_bf16(Bt[n][k], At[m][k], acc[ai][bj][m][n], 0, 0, 0); __builtin_amdgcn_s_setprio(0); } while (0)
#define PG8_WAIT_V(n) asm volatile("s_waitcnt vmcnt(" #n ")" ::: "memory")
#define PG8_WAIT_L(n) asm volatile("s_waitcnt lgkmcnt(" #n ")" ::: "memory")
#define PG8_BAR __builtin_amdgcn_s_barrier()
#define PG8_SCHED __builtin_amdgcn_sched_barrier(0)
    Unit cur, nxt; int ui = 0;
    if (!S.next(0, cur)) return;
    f32x4 acc[2][2][4][2];
#pragma unroll
    for (int a = 0; a < 2; ++a)
#pragma unroll
        for (int b = 0; b < 2; ++b)
#pragma unroll
            for (int m = 0; m < 4; ++m)
#pragma unroll
                for (int n = 0; n < 2; ++n) acc[a][b][m][n] = (f32x4){0.f, 0.f, 0.f, 0.f};
    bf16x8 At[4][2], B0[2][2], B1[2][2];
    const char* cA = (cur.pm < g.psplit ? (const char*)g.A + (size_t)cur.pm * tstepA : (const char*)g.A2 + (size_t)(cur.pm - g.psplit) * tstepA) + cur.ka; const char* cB = (const char*)g.Bt + (size_t)cur.pn * tstepB + cur.kb;
    PG8_STAGE(PG8_SB(0, 0), cB, voffB); PG8_STAGE(PG8_SB(0, 1), cB + hstepB, voffB); PG8_STAGE(PG8_SA(0, 0), cA, voffA); PG8_STAGE(PG8_SA(0, 1), cA + hstepA, voffA);
    if (wr == 1) PG8_BAR;
    PG8_WAIT_V(2); PG8_BAR;
    PG8_STAGE(PG8_SB(1, 0), cB + kstep, voffB); PG8_STAGE(PG8_SA(1, 0), cA + kstep, voffA); PG8_STAGE(PG8_SB(1, 1), cB + hstepB + kstep, voffB);
    PG8_WAIT_V(6); PG8_BAR;
    for (;;) {
        const bool has_next = S.next(ui + 1, nxt);
        const char* nA = has_next ? (nxt.pm < g.psplit ? (const char*)g.A + (size_t)nxt.pm * tstepA : (const char*)g.A2 + (size_t)(nxt.pm - g.psplit) * tstepA) + nxt.ka : cA; const char* nB = has_next ? (const char*)g.Bt + (size_t)nxt.pn * tstepB + nxt.kb : cB;
        const int nt = cur.nt;
        for (int t = 0; t < nt; t += 2) {
            const bool last = (t == nt - 2);
            const char* a1 = cA + (size_t)(t + 1) * kstep;
            const char* a2 = last ? nA : cA + (size_t)(t + 2) * kstep; const char* b2 = last ? nB : cB + (size_t)(t + 2) * kstep;
            const char* a3 = a2 + kstep; const char* b3 = b2 + kstep;
            PG8_LDB(B0, 0, 0); PG8_LDB(B1, 0, 1); PG8_SCHED; PG8_LDA(At, 0, 0); PG8_STAGE(PG8_SA(1, 1), a1 + hstepA, voffA);
            PG8_WAIT_V(8); PG8_WAIT_L(0); PG8_BAR; PG8_MMA(0, 0, At, B0); PG8_MMA(0, 1, At, B1); PG8_BAR; PG8_SCHED;
            PG8_LDA(At, 0, 1); PG8_STAGE(PG8_SB(0, 0), b2, voffB); PG8_STAGE(PG8_SB(0, 1), b2 + hstepB, voffB); PG8_STAGE(PG8_SA(0, 0), a2, voffA);
            PG8_WAIT_V(8); PG8_WAIT_L(0); PG8_BAR; PG8_MMA(1, 0, At, B0); PG8_MMA(1, 1, At, B1); PG8_BAR; PG8_SCHED;
            PG8_LDB(B0, 1, 0); PG8_LDB(B1, 1, 1); PG8_SCHED; PG8_LDA(At, 1, 0); PG8_STAGE(PG8_SA(0, 1), a2 + hstepA, voffA);
            PG8_WAIT_V(8); PG8_WAIT_L(0); PG8_BAR; PG8_MMA(0, 0, At, B0); PG8_MMA(0, 1, At, B1); PG8_BAR; PG8_SCHED;
            PG8_LDA(At, 1, 1); PG8_STAGE(PG8_SB(1, 0), b3, voffB); PG8_STAGE(PG8_SB(1, 1), b3 + hstepB, voffB); PG8_STAGE(PG8_SA(1, 0), a3, voffA);
            PG8_WAIT_V(8); PG8_WAIT_L(0); PG8_BAR; PG8_MMA(1, 0, At, B0); PG8_MMA(1, 1, At, B1); PG8_BAR; PG8_SCHED;
        }
        if (wr == 0) PG8_BAR;
        const bool zero = E(acc, cur, wr, wc, fr, fq);
        if (!has_next) break;
        if (zero) {
#pragma unroll
            for (int a = 0; a < 2; ++a)
#pragma unroll
                for (int b = 0; b < 2; ++b)
#pragma unroll
                    for (int m = 0; m < 4; ++m)
#pragma unroll
                        for (int n = 0; n < 2; ++n) acc[a][b][m][n] = (f32x4){0.f, 0.f, 0.f, 0.f};
        }
        cur = nxt; cA = nA; cB = nB; ++ui;
        if (wr == 1) PG8_BAR;
    }
    PG8_WAIT_V(0);
    PG8_BAR;
#undef PG8_SA
#undef PG8_SB
#undef PG8_STAGE
#undef PG8_LDA
#undef PG8_LDB
#undef PG8_MMA
#undef PG8_WAIT_V
#undef PG8_WAIT_L
#undef PG8_BAR
#undef PG8_SCHED
}
}
using pg8::Unit;

struct SchedP1 {
    int G, c;
    __device__ __forceinline__ bool next(int i, Unit& u) const {
        int L = i * G + c;
        if (L < 1224) { pg8::tile_map(68, 18, L, u.pm, u.pn); u.ka = 0; u.kb = 0; u.nt = 16; u.tag = 0; return true; }
        L -= 1224;
        if (L < 16) { u.pm = 68 + (L & 7); u.pn = 18 + (L >> 3); u.ka = 0; u.kb = 0; u.nt = 16; u.tag = 1; return true; }
        return false;
    }
};
struct SchedT {
    int nM, nN, nt, G, c;
    __device__ __forceinline__ bool next(int i, Unit& u) const {
        const int L = i * G + c; if (L >= nM * nN) return false;
        pg8::tile_map(nM, nN, L, u.pm, u.pn); u.ka = 0; u.kb = 0; u.nt = nt; u.tag = 0; return true;
    }
};
struct SchedP3 {
    int G, c;
    __device__ __forceinline__ bool next(int i, Unit& u) const {
        const int j = i / 3, br = i - 3 * j; const int L = j * G + c; if (L >= 272) return false;
        pg8::tile_map(68, 4, L, u.pm, u.pn);
        u.tag = br; u.nt = br == 0 ? 8 : 4; u.ka = br == 0 ? 0 : (br == 1 ? 2048 : 2560); u.kb = br == 0 ? 0 : (br == 1 ? 1024 : 1536);
        return true;
    }
};

struct SchedOne3 {
    int pm, pn;
    __device__ __forceinline__ bool next(int i, Unit& u) const {
        if (i >= 3) return false;
        u.pm = pm; u.pn = pn; u.tag = i; u.nt = i == 0 ? 8 : 4; u.ka = i == 0 ? 0 : (i == 1 ? 2048 : 2560); u.kb = i == 0 ? 0 : (i == 1 ? 1024 : 1536); return true;
    }
};
struct SchedOne {
    int pm, pn, nt;
    __device__ __forceinline__ bool next(int i, Unit& u) const { if (i >= 1) return false; u.pm = pm; u.pn = pn; u.ka = 0; u.kb = 0; u.nt = nt; u.tag = 0; return true; }
};
__device__ __forceinline__ void tile272(int L, int& pm, int& pn) { if (L < 256) pg8::tile_map(64, 4, L, pm, pn); else { pm = 64 + ((L - 256) >> 2); pn = (L - 256) & 3; } }
struct SchedP6 {
    int G, c;
    __device__ __forceinline__ bool next(int i, Unit& u) const {
        if (G == 256) {
            if (i == 1) { pg8::tile_map(64, 4, c, u.pm, u.pn); u.ka = 0; u.kb = 0; u.nt = 64; u.tag = 0; return true; }
            if (i == 0) { const int j = c >> 4; u.pm = 64 + (j >> 2); u.pn = j & 3; u.ka = (c & 15) * 512; u.kb = u.ka; u.nt = 4; u.tag = 1 + (c & 15); return true; }
            return false;
        }
        const int L = i * G + c; if (L >= 272) return false;
        pg8::tile_map(68, 4, L, u.pm, u.pn); u.ka = 0; u.kb = 0; u.nt = 64; u.tag = 0; return true;
    }
};
__device__ __forceinline__ float* part_base(unsigned char* ws, int s) {
    const size_t mb = s < 8 ? 48 + 4 * (size_t)s : (s < 12 ? 222 + 4 * (size_t)(s - 8) : (s < 14 ? 13 + 4 * (size_t)(s - 12) : 3 + 4 * (size_t)(s - 14)));
    return (float*)(ws + mb * MiB);
}
__device__ __forceinline__ void panel_signal(unsigned* cnt, int wave_s);
__device__ __forceinline__ void panel_wait(unsigned* cnt, unsigned want, unsigned* bar, int wave_s);
#define EPI_ROWS(u) const int row0 = (u).pm * 256 + wr * 64 + fr; const int col0 = (u).pn * 256 + wc * 32 + 8 * fq;
struct EpiP1 {
    bf16_t* Z; float* P; float* outk; float* outv; bf16_t* KB; bf16_t* VTB;
    __device__ __forceinline__ bool operator()(const f32x4 (&acc)[2][2][4][2], const Unit& u, int wr, int wc, int fr, int fq) const {
        EPI_ROWS(u)
        if (u.tag == 0 && u.pn >= 6) {
#pragma unroll
            for (int ai = 0; ai < 2; ++ai)
#pragma unroll
                for (int m = 0; m < 4; ++m) { const int row = row0 + ai * 128 + m * 16; u32x4 q;
                    { const f32x4 v0 = acc[ai][0][m][0], v1 = acc[ai][0][m][1]; q.x = gate_q(v0[0]) | (gate_q(v0[1]) << 8) | (gate_q(v0[2]) << 16) | (gate_q(v0[3]) << 24); q.y = gate_q(v1[0]) | (gate_q(v1[1]) << 8) | (gate_q(v1[2]) << 16) | (gate_q(v1[3]) << 24); }
                    { const f32x4 v0 = acc[ai][1][m][0], v1 = acc[ai][1][m][1]; q.z = gate_q(v0[0]) | (gate_q(v0[1]) << 8) | (gate_q(v0[2]) << 16) | (gate_q(v0[3]) << 24); q.w = gate_q(v1[0]) | (gate_q(v1[1]) << 8) | (gate_q(v1[2]) << 16) | (gate_q(v1[3]) << 24); }
                    *(u32x4*)((unsigned char*)Z + (size_t)row * (DIN * 2) + 3072 + (u.pn - 6) * 256 + (wc * 4 + fq) * 16) = q; }
            return true;
        }
        if (u.tag == 0) {
            const int pn = u.pn;
#pragma unroll
            for (int ai = 0; ai < 2; ++ai)
#pragma unroll
                for (int m = 0; m < 4; ++m) { const int row = row0 + ai * 128 + m * 16;
#pragma unroll
                    for (int bj = 0; bj < 2; ++bj) { const int col = col0 + bj * 128; f32x4 v0 = acc[ai][bj][m][0], v1 = acc[ai][bj][m][1];
                        if (pn == 4) { float* p = P + (size_t)row * 256 + (col - 1024); *(f32x4*)p = v0; *(f32x4*)(p + 4) = v1; }
                        else {
                            if (pn < 4) {
                                const f32x2 a0 = gelu_t2((f32x2){v0[0], v0[1]}), a1 = gelu_t2((f32x2){v0[2], v0[3]}), a2 = gelu_t2((f32x2){v1[0], v1[1]}), a3 = gelu_t2((f32x2){v1[2], v1[3]});
                                v0 = (f32x4){a0.x, a0.y, a1.x, a1.y}; v1 = (f32x4){a2.x, a2.y, a3.x, a3.y};
                            } else if (pn >= 6) {
                                u32x2 q; q.x = gate_q(v0[0]) | (gate_q(v0[1]) << 8) | (gate_q(v0[2]) << 16) | (gate_q(v0[3]) << 24); q.y = gate_q(v1[0]) | (gate_q(v1[1]) << 8) | (gate_q(v1[2]) << 16) | (gate_q(v1[3]) << 24);
                                *(u32x2*)((unsigned char*)Z + (size_t)row * (DIN * 2) + 1536 + col) = q; continue;
                            }
                            u32x4 w; w.x = cvt_pk_bf16(v0[0], v0[1]); w.y = cvt_pk_bf16(v0[2], v0[3]); w.z = cvt_pk_bf16(v1[0], v1[1]); w.w = cvt_pk_bf16(v1[2], v1[3]);
                            *(u32x4*)(Z + (size_t)row * DIN + col) = w;
                        } } }
        } else {
            const bool isv = (u.pn == 19);
#pragma unroll
            for (int ai = 0; ai < 2; ++ai)
#pragma unroll
                for (int m = 0; m < 4; ++m) { const int r = row0 - 68 * 256 + ai * 128 + m * 16;
#pragma unroll
                    for (int bj = 0; bj < 2; ++bj) { const int c = wc * 32 + 8 * fq + bj * 128; const f32x4 v0 = acc[ai][bj][m][0], v1 = acc[ai][bj][m][1];
                        float* o = (isv ? outv : outk) + (size_t)r * 256 + c; __builtin_nontemporal_store(v0, (f32x4*)o); __builtin_nontemporal_store(v1, (f32x4*)(o + 4));
                        if (!isv) { u32x4 w; w.x = cvt_pk_bf16(v0[0], v0[1]); w.y = cvt_pk_bf16(v0[2], v0[3]); w.z = cvt_pk_bf16(v1[0], v1[1]); w.w = cvt_pk_bf16(v1[2], v1[3]);
                            *(u32x4*)(KB + (size_t)r * 256 + c) = w; }
                        else { bf16_t* vt = VTB + ((size_t)(r >> 8) * 256 + c) * 256 + (r & 255);
#pragma unroll
                            for (int e = 0; e < 4; ++e) { vt[(size_t)e * 256] = (bf16_t)f2bf(v0[e]); vt[(size_t)(e + 4) * 256] = (bf16_t)f2bf(v1[e]); } }
                    } }
        }
        return true;
    }
};
struct EpiP3 {
    const bf16_t* Z; bf16_t* MG; bool wt;
    __device__ __forceinline__ bool operator()(f32x4 (&acc)[2][2][4][2], const Unit& u, int wr, int wc, int fr, int fq) const {
        EPI_ROWS(u)
        const int br = u.tag;
        u32x4 gn[2][4], gd[2][4];
#pragma unroll
        for (int ai = 0; ai < 2; ++ai)
#pragma unroll
            for (int m = 0; m < 4; ++m) { const unsigned char* gp = (const unsigned char*)Z + (size_t)(row0 + ai * 128 + m * 16) * (DIN * 2) + 3072 + br * 1024 + u.pn * 256 + (wc * 4 + fq) * 16;
                gn[ai][m] = *(const u32x4*)gp; if (br < 2) gd[ai][m] = *(const u32x4*)(gp + 1024); }
        asm volatile("" ::: "memory");
#pragma unroll
        for (int ai = 0; ai < 2; ++ai)
#pragma unroll
            for (int m = 0; m < 4; ++m) { const int row = row0 + ai * 128 + m * 16;
#pragma unroll
                for (int bj = 0; bj < 2; ++bj) { const int col = col0 + bj * 128;
                    u32x2 g1; g1.x = bj == 0 ? gn[ai][m].x : gn[ai][m].z; g1.y = bj == 0 ? gn[ai][m].y : gn[ai][m].w;
                    float f[8];
                    f[0] = ub0(g1.x); f[1] = ub1(g1.x); f[2] = ub2(g1.x); f[3] = ub3(g1.x); f[4] = ub0(g1.y); f[5] = ub1(g1.y); f[6] = ub2(g1.y); f[7] = ub3(g1.y);
                    if (br < 2) { u32x2 g2; g2.x = bj == 0 ? gd[ai][m].x : gd[ai][m].z; g2.y = bj == 0 ? gd[ai][m].y : gd[ai][m].w;
                        f[0] *= __builtin_amdgcn_rcpf(ub0(g2.x)); f[1] *= __builtin_amdgcn_rcpf(ub1(g2.x)); f[2] *= __builtin_amdgcn_rcpf(ub2(g2.x)); f[3] *= __builtin_amdgcn_rcpf(ub3(g2.x));
                        f[4] *= __builtin_amdgcn_rcpf(ub0(g2.y)); f[5] *= __builtin_amdgcn_rcpf(ub1(g2.y)); f[6] *= __builtin_amdgcn_rcpf(ub2(g2.y)); f[7] *= __builtin_amdgcn_rcpf(ub3(g2.y)); }
                    else {
#pragma unroll
                        for (int e = 0; e < 8; ++e) f[e] *= (1.0f / 255.0f); }
                    f32x4 v0 = acc[ai][bj][m][0], v1 = acc[ai][bj][m][1];
                    v0[0] *= f[0]; v0[1] *= f[1]; v0[2] *= f[2]; v0[3] *= f[3]; v1[0] *= f[4]; v1[1] *= f[5]; v1[2] *= f[6]; v1[3] *= f[7];
                    if (br < 2) { acc[ai][bj][m][0] = v0; acc[ai][bj][m][1] = v1; }
                    else { u32x4 w; w.x = cvt_pk_bf16(v0[0], v0[1]); w.y = cvt_pk_bf16(v0[2], v0[3]); w.z = cvt_pk_bf16(v1[0], v1[1]); w.w = cvt_pk_bf16(v1[2], v1[3]);
                        if (!wt) *(u32x4*)(MG + (size_t)row * DM + col) = w;
                        else { unsigned long long* mp = (unsigned long long*)(MG + (size_t)row * DM + col);
                            __hip_atomic_store(mp, (unsigned long long)w.x | ((unsigned long long)w.y << 32), __ATOMIC_RELAXED, __HIP_MEMORY_SCOPE_AGENT);
                            __hip_atomic_store(mp + 1, (unsigned long long)w.z | ((unsigned long long)w.w << 32), __ATOMIC_RELAXED, __HIP_MEMORY_SCOPE_AGENT); } }
                } }
        return br == 2;
    }
};
struct EpiP4 {
    const float* xp; const float* xs; float* out; bf16_t* X1Blo; bf16_t* X1Bhi; float* SSP; float* SSP4; LAS unsigned char* lds;
    __device__ __forceinline__ bool operator()(const f32x4 (&acc)[2][2][4][2], const Unit& u, int wr, int wc, int fr, int fq) const {
        EPI_ROWS(u)
        const float* xb = u.pm < 64 ? xp : xs - (size_t)MP * DM;
        bf16_t* X1B = u.pm < X1B_SPLIT ? X1Blo : X1Bhi - (size_t)X1B_SPLIT * 256 * DM;
#pragma unroll
        for (int ai = 0; ai < 2; ++ai) {
            f32x4 xv[4][2][2];
#pragma unroll
            for (int m = 0; m < 4; ++m)
#pragma unroll
                for (int bj = 0; bj < 2; ++bj) { const size_t off = (size_t)(row0 + ai * 128 + m * 16) * DM + col0 + bj * 128; xv[m][bj][0] = __builtin_nontemporal_load((const f32x4*)(xb + off)); xv[m][bj][1] = __builtin_nontemporal_load((const f32x4*)(xb + off + 4)); }
            asm volatile("" ::: "memory");
#pragma unroll
            for (int m = 0; m < 4; ++m) { const int row = row0 + ai * 128 + m * 16; float ss = 0.f;
#pragma unroll
                for (int bj = 0; bj < 2; ++bj) { const int col = col0 + bj * 128; const size_t off = (size_t)row * DM + col;
                    const f32x4 v0 = acc[ai][bj][m][0] + xv[m][bj][0], v1 = acc[ai][bj][m][1] + xv[m][bj][1];
                    u32x4 w; w.x = cvt_pk_bf16(v0[0], v0[1]); w.y = cvt_pk_bf16(v0[2], v0[3]); w.z = cvt_pk_bf16(v1[0], v1[1]); w.w = cvt_pk_bf16(v1[2], v1[3]);
                    *(u32x4*)(X1B + off) = w;
                    ss += (v0[0] * v0[0] + v0[1] * v0[1]) + (v0[2] * v0[2] + v0[3] * v0[3]) + (v1[0] * v1[0] + v1[1] * v1[1]) + (v1[2] * v1[2] + v1[3] * v1[3]); }
                ss += __shfl_xor(ss, 16); ss += __shfl_xor(ss, 32);
                if (fq == 0) { SSP[(size_t)row * 16 + u.pn * 4 + wc] = ss; ((LAS float*)(lds + 131072))[(ai * 128 + wr * 64 + m * 16 + fr) * 4 + wc] = ss; } }
            asm volatile("" ::: "memory");
        }
        __syncthreads();
        { const int t = (wr * 4 + wc) * 64 + fq * 16 + fr;
          if (t < 256) { const f32x4 q = *(const LAS f32x4*)(lds + 131072 + t * 16); SSP4[(size_t)(u.pm * 256 + t) * 4 + u.pn] = (q[0] + q[1]) + (q[2] + q[3]); } }
        __syncthreads();
        return true;
    }
};
struct EpiP5 {
    const float* SSP; bf16_t* H; const float* SSP4; int n4;
    __device__ __forceinline__ bool operator()(const f32x4 (&acc)[2][2][4][2], const Unit& u, int wr, int wc, int fr, int fq) const {
        EPI_ROWS(u)
        if (u.pm < n4) {
            f32x4 sq[2][4];
#pragma unroll
            for (int ai = 0; ai < 2; ++ai)
#pragma unroll
                for (int m = 0; m < 4; ++m) sq[ai][m] = *(const f32x4*)(SSP4 + (size_t)(row0 + ai * 128 + m * 16) * 4);
            asm volatile("" ::: "memory");
#pragma unroll
            for (int ai = 0; ai < 2; ++ai)
#pragma unroll
                for (int m = 0; m < 4; ++m) { const int row = row0 + ai * 128 + m * 16; const f32x4 q = sq[ai][m];
                    const float rstd = 1.0f / sqrtf(((q[0] + q[1]) + (q[2] + q[3])) * (1.0f / DM) + EPS);
#pragma unroll
                    for (int bj = 0; bj < 2; ++bj) { const int col = col0 + bj * 128; f32x4 v0 = acc[ai][bj][m][0] * rstd, v1 = acc[ai][bj][m][1] * rstd;
#pragma unroll
                        for (int e = 0; e < 4; ++e) { const float a = fmaxf(v0[e], 0.f), b = fmaxf(v1[e], 0.f); v0[e] = a * a; v1[e] = b * b; }
                        u32x4 w; w.x = cvt_pk_bf16(v0[0], v0[1]); w.y = cvt_pk_bf16(v0[2], v0[3]); w.z = cvt_pk_bf16(v1[0], v1[1]); w.w = cvt_pk_bf16(v1[2], v1[3]);
                        *(u32x4*)(H + (size_t)row * DFF + col) = w; } }
            return true;
        }
#pragma unroll
        for (int ai = 0; ai < 2; ++ai) {
            f32x4 sv[4][4];
#pragma unroll
            for (int m = 0; m < 4; ++m) { const f32x4* sp = (const f32x4*)(SSP + (size_t)(row0 + ai * 128 + m * 16) * 16);
#pragma unroll
                for (int k = 0; k < 4; ++k) sv[m][k] = sp[k]; }
            asm volatile("" ::: "memory");
#pragma unroll
            for (int m = 0; m < 4; ++m) { const int row = row0 + ai * 128 + m * 16;
                const f32x4 s0 = sv[m][0], s1 = sv[m][1], s2 = sv[m][2], s3 = sv[m][3];
                const float ss = ((s0[0] + s0[1]) + (s0[2] + s0[3])) + ((s1[0] + s1[1]) + (s1[2] + s1[3])) + ((s2[0] + s2[1]) + (s2[2] + s2[3])) + ((s3[0] + s3[1]) + (s3[2] + s3[3]));
                const float rstd = 1.0f / sqrtf(ss * (1.0f / DM) + EPS);
#pragma unroll
                for (int bj = 0; bj < 2; ++bj) { const int col = col0 + bj * 128; f32x4 v0 = acc[ai][bj][m][0] * rstd, v1 = acc[ai][bj][m][1] * rstd;
#pragma unroll
                    for (int e = 0; e < 4; ++e) { const float a = fmaxf(v0[e], 0.f), b = fmaxf(v1[e], 0.f); v0[e] = a * a; v1[e] = b * b; }
                    u32x4 w; w.x = cvt_pk_bf16(v0[0], v0[1]); w.y = cvt_pk_bf16(v0[2], v0[3]); w.z = cvt_pk_bf16(v1[0], v1[1]); w.w = cvt_pk_bf16(v1[2], v1[3]);
                    *(u32x4*)(H + (size_t)row * DFF + col) = w; } }
            asm volatile("" ::: "memory");
        }
        return true;
    }
};
struct EpiP6 {
    float* out; unsigned char* ws; const bf16_t* X1Blo; const bf16_t* X1Bhi;
    __device__ __forceinline__ bool operator()(const f32x4 (&acc)[2][2][4][2], const Unit& u, int wr, int wc, int fr, int fq) const {
        EPI_ROWS(u)
        if (u.tag == 0) {
            const bf16_t* X1B = u.pm < X1B_SPLIT ? X1Blo : X1Bhi - (size_t)X1B_SPLIT * 256 * DM;
#pragma unroll
            for (int ai = 0; ai < 2; ++ai) {
                u32x4 xv[4][2];
#pragma unroll
                for (int m = 0; m < 4; ++m)
#pragma unroll
                    for (int bj = 0; bj < 2; ++bj) xv[m][bj] = *(const u32x4*)(X1B + (size_t)(row0 + ai * 128 + m * 16) * DM + col0 + bj * 128);
                asm volatile("" ::: "memory");
#pragma unroll
                for (int m = 0; m < 4; ++m)
#pragma unroll
                    for (int bj = 0; bj < 2; ++bj) { const size_t off = (size_t)(row0 + ai * 128 + m * 16) * DM + col0 + bj * 128; const u32x4 xw = xv[m][bj];
                        *(f32x4*)(out + off) = acc[ai][bj][m][0] + (f32x4){bf_lo(xw.x), bf_hi(xw.x), bf_lo(xw.y), bf_hi(xw.y)};
                        *(f32x4*)(out + off + 4) = acc[ai][bj][m][1] + (f32x4){bf_lo(xw.z), bf_hi(xw.z), bf_lo(xw.w), bf_hi(xw.w)}; }
                asm volatile("" ::: "memory");
            }
        } else {
            float* pb = part_base(ws, u.tag - 1);
#pragma unroll
            for (int ai = 0; ai < 2; ++ai)
#pragma unroll
                for (int m = 0; m < 4; ++m) { const int row = row0 - MP + ai * 128 + m * 16;
#pragma unroll
                    for (int bj = 0; bj < 2; ++bj) { float* o = pb + (size_t)row * DM + col0 + bj * 128; *(f32x4*)o = acc[ai][bj][m][0]; *(f32x4*)(o + 4) = acc[ai][bj][m][1]; } }
        }
        return true;
    }
};

struct EpiP6F {
    float* out; unsigned char* ws; const bf16_t* X1Blo; const bf16_t* X1Bhi; float* SSP4; unsigned* cnt; unsigned* bar; const float* gfin; LAS unsigned char* lds;
    __device__ __forceinline__ bool operator()(f32x4 (&acc)[2][2][4][2], const Unit& u, int wr, int wc, int fr, int fq) const {
        EPI_ROWS(u)
        if (u.tag != 0) {
            float* pb = part_base(ws, u.tag - 1);
#pragma unroll
            for (int ai = 0; ai < 2; ++ai)
#pragma unroll
                for (int m = 0; m < 4; ++m) { const int row = row0 - MP + ai * 128 + m * 16;
#pragma unroll
                    for (int bj = 0; bj < 2; ++bj) { float* o = pb + (size_t)row * DM + col0 + bj * 128; *(f32x4*)o = acc[ai][bj][m][0]; *(f32x4*)(o + 4) = acc[ai][bj][m][1]; } }
            return true;
        }
        const bf16_t* X1B = u.pm < X1B_SPLIT ? X1Blo : X1Bhi - (size_t)X1B_SPLIT * 256 * DM;
#pragma unroll
        for (int ai = 0; ai < 2; ++ai) {
            u32x4 xv[4][2];
#pragma unroll
            for (int m = 0; m < 4; ++m)
#pragma unroll
                for (int bj = 0; bj < 2; ++bj) xv[m][bj] = __builtin_nontemporal_load((const u32x4*)(X1B + (size_t)(row0 + ai * 128 + m * 16) * DM + col0 + bj * 128));
            asm volatile("" ::: "memory");
#pragma unroll
            for (int m = 0; m < 4; ++m) { const int row = row0 + ai * 128 + m * 16; float ss = 0.f;
#pragma unroll
                for (int bj = 0; bj < 2; ++bj) { const u32x4 xw = xv[m][bj];
                    const f32x4 v0 = acc[ai][bj][m][0] + (f32x4){bf_lo(xw.x), bf_hi(xw.x), bf_lo(xw.y), bf_hi(xw.y)}, v1 = acc[ai][bj][m][1] + (f32x4){bf_lo(xw.z), bf_hi(xw.z), bf_lo(xw.w), bf_hi(xw.w)};
                    acc[ai][bj][m][0] = v0; acc[ai][bj][m][1] = v1;
                    ss += (v0[0] * v0[0] + v0[1] * v0[1]) + (v0[2] * v0[2] + v0[3] * v0[3]) + (v1[0] * v1[0] + v1[1] * v1[1]) + (v1[2] * v1[2] + v1[3] * v1[3]); }
                ss += __shfl_xor(ss, 16); ss += __shfl_xor(ss, 32);
                if (fq == 0) ((LAS float*)(lds + 131072))[(ai * 128 + wr * 64 + m * 16 + fr) * 4 + wc] = ss; (void)row; }
            asm volatile("" ::: "memory");
        }
        __syncthreads();
        { const int t = (wr * 4 + wc) * 64 + fq * 16 + fr;
          if (t < 256) { const f32x4 q = *(const LAS f32x4*)(lds + 131072 + t * 16); __hip_atomic_store(SSP4 + (size_t)(u.pm * 256 + t) * 4 + u.pn, (q[0] + q[1]) + (q[2] + q[3]), __ATOMIC_RELAXED, __HIP_MEMORY_SCOPE_AGENT); } }
        panel_signal(cnt + 64 * u.pm, wr * 4 + wc);
        panel_wait(cnt + 64 * u.pm, 4u, bar, wr * 4 + wc);
        f32x4 sq[2][4];
#pragma unroll
        for (int ai = 0; ai < 2; ++ai)
#pragma unroll
            for (int m = 0; m < 4; ++m) sq[ai][m] = *(const f32x4*)(SSP4 + (size_t)(row0 + ai * 128 + m * 16) * 4);
        asm volatile("" ::: "memory");
#pragma unroll
        for (int ai = 0; ai < 2; ++ai)
#pragma unroll
            for (int m = 0; m < 4; ++m) { const int row = row0 + ai * 128 + m * 16; const f32x4 q = sq[ai][m];
                const float rstd = 1.0f / sqrtf(((q[0] + q[1]) + (q[2] + q[3])) * (1.0f / DM) + EPS);
#pragma unroll
                for (int bj = 0; bj < 2; ++bj) { const size_t off = (size_t)row * DM + col0 + bj * 128;
                    const f32x4 g0 = *(const f32x4*)(gfin + col0 + bj * 128), g1 = *(const f32x4*)(gfin + col0 + bj * 128 + 4);
                    __builtin_nontemporal_store(acc[ai][bj][m][0] * rstd * g0, (f32x4*)(out + off)); __builtin_nontemporal_store(acc[ai][bj][m][1] * rstd * g1, (f32x4*)(out + off + 4)); } }
        return true;
    }
};

__device__ __forceinline__ float wave_sum(float v) {
#pragma unroll
    for (int o = 1; o < 64; o <<= 1) v += __shfl_xor(v, o);
    return v;
}
__device__ __forceinline__ void tr_item(const float* W, int N, bf16_t* WT, int ldt, int col_off, const float* kscale, LAS float* scr, int item, int lane) {
    const int nblk = N / 32, kb = item / nblk, nb = item % nblk, k0 = 64 * kb, n0 = 32 * nb;
    f32x4 t[8];
#pragma unroll
    for (int i = 0; i < 8; ++i) { const int kk = 8 * i + (lane >> 3); t[i] = __builtin_nontemporal_load((const f32x4*)(W + (size_t)(k0 + kk) * N + n0 + 4 * (lane & 7))); }
    if (kscale) {
#pragma unroll
        for (int i = 0; i < 8; ++i) t[i] = t[i] * kscale[k0 + 8 * i + (lane >> 3)];
    }
#pragma unroll
    for (int i = 0; i < 8; ++i) { LAS float* d = scr + (8 * i + (lane >> 3)) * 33 + 4 * (lane & 7); d[0] = t[i][0]; d[1] = t[i][1]; d[2] = t[i][2]; d[3] = t[i][3]; }
    asm volatile("s_waitcnt lgkmcnt(0)" ::: "memory");
    const int c = lane & 7;
#pragma unroll
    for (int j = 0; j < 4; ++j) { const int n = (lane >> 3) + 8 * j; const LAS float* s = scr + (8 * c) * 33 + n;
        u32x4 o; o.x = pk2(s[0 * 33], s[1 * 33]); o.y = pk2(s[2 * 33], s[3 * 33]); o.z = pk2(s[4 * 33], s[5 * 33]); o.w = pk2(s[6 * 33], s[7 * 33]);
        *(u32x4*)(WT + (size_t)(n0 + n) * ldt + col_off + k0 + 8 * c) = o; }
    asm volatile("s_waitcnt lgkmcnt(0)" ::: "memory");
}
__device__ __forceinline__ const float* p0_src_row(const Args& a, int row) { return row < MP ? a.x_prompt + (size_t)row * DM : (row < MT ? a.x_sample + (size_t)(row - MP) * DM : a.mem + (size_t)(row - MT) * DM); }
__device__ __forceinline__ void rms_rows2_to_bf16(const float* x0, const float* x1, const float* g0, const float* g1, bf16_t* o0, bf16_t* o1, int lane) {
    const f32x4* xr0 = (const f32x4*)x0 + lane; const f32x4* xr1 = (const f32x4*)x1 + lane;
    f32x4 v[2][4]; float s0 = 0.f, s1 = 0.f;
#pragma unroll
    for (int j = 0; j < 4; ++j) { v[0][j] = __builtin_nontemporal_load(xr0 + 64 * j); v[1][j] = __builtin_nontemporal_load(xr1 + 64 * j); }
#pragma unroll
    for (int j = 0; j < 4; ++j) { s0 += (v[0][j][0] * v[0][j][0] + v[0][j][1] * v[0][j][1]) + (v[0][j][2] * v[0][j][2] + v[0][j][3] * v[0][j][3]);
                                  s1 += (v[1][j][0] * v[1][j][0] + v[1][j][1] * v[1][j][1]) + (v[1][j][2] * v[1][j][2] + v[1][j][3] * v[1][j][3]); }
    const float r0 = 1.0f / sqrtf(wave_sum(s0) * (1.0f / DM) + EPS), r1 = 1.0f / sqrtf(wave_sum(s1) * (1.0f / DM) + EPS);
    u32x2* p0 = (u32x2*)o0 + lane; u32x2* p1 = (u32x2*)o1 + lane;
#pragma unroll
    for (int j = 0; j < 4; ++j) { const f32x4 ga = ((const f32x4*)g0 + lane)[64 * j], gb = ((const f32x4*)g1 + lane)[64 * j]; u32x2 w;
        w.x = pk2(v[0][j][0] * r0 * ga[0], v[0][j][1] * r0 * ga[1]); w.y = pk2(v[0][j][2] * r0 * ga[2], v[0][j][3] * r0 * ga[3]); p0[64 * j] = w;
        w.x = pk2(v[1][j][0] * r1 * gb[0], v[1][j][1] * r1 * gb[1]); w.y = pk2(v[1][j][2] * r1 * gb[2], v[1][j][3] * r1 * gb[3]); p1[64 * j] = w; }
}
__device__ __forceinline__ void p0_prologue(const Args& a, LAS unsigned char* lds, int tid, int G) {
    const int wave = tid >> 6, lane = tid & 63;
    LAS float* scr = (LAS float*)(lds + wave * 16384);
    const int gw = blockIdx.x * 8 + wave, NGW = G * 8;
    const int gt = blockIdx.x * 512 + tid, NGT = G * 512;
    bf16_t* WinT = (bf16_t*)(a.ws + WS_WIN); bf16_t* WoT = (bf16_t*)(a.ws + WS_WO); bf16_t* WupT = (bf16_t*)(a.ws + WS_WUP); bf16_t* WdnT = (bf16_t*)(a.ws + WS_WDN); bf16_t* WbrT = (bf16_t*)(a.ws + WS_WBR);
    bf16_t* VTB = (bf16_t*)((unsigned char*)a.out + OS_VTB); bf16_t* KB = (bf16_t*)((unsigned char*)a.out + OS_KB);
    constexpr int I_IN = 16 * 144, I_KV = 16 * 16, I_O = 16 * 32, I_UP = 16 * 128, I_DN = 64 * 32, I_A = 8 * 32, I_C = 4 * 32, I_V = 128 * 32;
    constexpr int NITEMS = I_IN + I_KV + I_O + I_A + I_C + I_V;
    for (int it = gw; it < NITEMS; it += NGW) {
        int r = it;
        if (r < I_IN) { tr_item(a.w_in, DIN, WinT, 1024, 0, nullptr, scr, r, lane); continue; } r -= I_IN;
        if (r < I_KV) { tr_item(a.w_kv, 512, WinT + (size_t)4608 * 1024, 1024, 0, nullptr, scr, r, lane); continue; } r -= I_KV;
        if (r < I_O) { tr_item(a.w_o, 1024, WoT, 1024, 0, nullptr, scr, r, lane); continue; } r -= I_O;
        if (r < I_A) { tr_item(a.w_out_a, 1024, WbrT, 1024, 0, nullptr, scr, r, lane); continue; } r -= I_A;
        if (r < I_C) { tr_item(a.w_out_c, 1024, WbrT, 1024, 768, nullptr, scr, r, lane); continue; } r -= I_C;
        { const int b = r >> 5; tr_item(a.cache_v + (size_t)b * 65536, 256, VTB + (size_t)(8 + b) * 65536, 256, 0, nullptr, scr, r & 31, lane); }
    }
    for (int idx = gt; idx < 256 * 1024; idx += NGT) { const int n = idx & 1023, k = idx >> 10, g = k >> 6, kk = k & 63; float s = 0.f;
        const float* wp = a.w_pool + g * 4096 + kk * 64; const float* sc = a.pool_scale + g * 64; const float* wb = a.w_out_b + (size_t)(g * 64) * 1024 + n;
#pragma unroll 32
        for (int e = 0; e < 64; ++e) s += wp[e] * sc[e] * wb[(size_t)e * 1024];
        WbrT[(size_t)n * 1024 + 512 + k] = (bf16_t)f2bf(s); }
    bf16_t* XN = (bf16_t*)(a.ws + WS_XN);
    for (int r2 = gw; r2 < (MT + MKV) / 2; r2 += NGW) { const int row = 2 * r2;
        rms_rows2_to_bf16(p0_src_row(a, row), p0_src_row(a, row + 1), row < MT ? a.g_mix : a.g_mem, row < MT ? a.g_mix : a.g_mem, XN + (size_t)row * DM, XN + (size_t)(row + 1) * DM, lane); }
    bf16_t* WsB = (bf16_t*)(a.ws + WS_WSB);
    for (int idx = gt; idx < 131072; idx += NGT) { const int e = idx & 65535, g = e >> 14, r = (e >> 7) & 127, c = e & 127; float v;
        if (idx < 65536) v = c <= r ? a.w_s[e] : 0.f;
        else v = ((r >> 3) == (c >> 3) && (c & 7) <= (r & 7)) ? a.w_s[g * 16384 + (r & 7) * 128 + (c & 7)] : 0.f;
        WsB[idx] = (bf16_t)f2bf(v); }
}

__device__ __forceinline__ void p0_deferred(const Args& a, LAS unsigned char* lds, int tid, int G) {
    const int wave = tid >> 6, lane = tid & 63;
    LAS float* scr = (LAS float*)(lds + wave * 16384);
    const int nc = G, cc = (int)blockIdx.x;
    bf16_t* WupT = (bf16_t*)(a.ws + WS_WUP); bf16_t* WdnT = (bf16_t*)(a.ws + WS_WDN);
    for (int it = cc * 8 + wave; it < 4096; it += nc * 8) {
        if (it < 2048) tr_item(a.w_up, DFF, WupT, 1024, 0, a.g_ffn, scr, it, lane);
        else tr_item(a.w_down, 1024, WdnT, 4096, 0, nullptr, scr, it - 2048, lane);
    }
}

__device__ __forceinline__ void p2a_unit(const Args& a, LAS unsigned char* lds, int c, int tid) {
    const int w = __builtin_amdgcn_readfirstlane(tid >> 6), l = tid & 63;
    bf16_t* Z = (bf16_t*)(a.ws + WS_Z);
    const int row0 = c * 128;
    const int g = w >> 1, ih = w & 1, fr = l & 15, fq = l >> 4;
    const bf16_t* Wg = (const bf16_t*)(a.ws + WS_WSB) + (c >= 128 ? 65536 : 0) + g * 16384;
    __syncthreads();
    u32x4 v[2][8];
#pragma unroll
    for (int rr = 0; rr < 2; ++rr) { const u32x4* src = (const u32x4*)(Z + (size_t)(row0 + 2 * l + rr) * DIN + 512 + 64 * w);
#pragma unroll
        for (int e = 0; e < 8; ++e) v[rr][e] = src[e]; }
    LAS f32x2* ST = (LAS f32x2*)(lds + 139264);
#pragma unroll
    for (int rr = 0; rr < 2; ++rr) { float s = 0.f, q = 0.f;
#pragma unroll
        for (int e = 0; e < 8; ++e)
#pragma unroll
            for (int d = 0; d < 4; ++d) { const float x0 = bf_lo(v[rr][e][d]), x1 = bf_hi(v[rr][e][d]); s += x0 + x1; q += x0 * x0 + x1 * x1; }
        ST[(2 * l + rr) * 8 + w] = (f32x2){s, q}; }
    __syncthreads();
    float mean[2], rstd[2];
#pragma unroll
    for (int rr = 0; rr < 2; ++rr) { float s = 0.f, q = 0.f;
#pragma unroll
        for (int k = 0; k < 8; ++k) { const f32x2 t = ST[(2 * l + rr) * 8 + k]; s += t[0]; q += t[1]; }
        mean[rr] = s * (1.0f / 512.0f); const float var = fmaxf(q * (1.0f / 512.0f) - mean[rr] * mean[rr], 0.f); rstd[rr] = 1.0f / sqrtf(var + EPS); }
    const bool wout = (c >= 128) || ((c & 15) == 15);
    float* op = c >= 128 ? a.out + O_CVS + (size_t)((c - 128) * 128 + 2 * l) * 512 : a.out + O_CVP + (size_t)((c >> 4) * 128 + 2 * l) * 512;
#pragma unroll
    for (int e = 0; e < 8; ++e) { float y[2][8];
#pragma unroll
        for (int d = 0; d < 4; ++d) { const int ch = 64 * w + 8 * e + 2 * d; const float g0 = a.g_v[ch], g1 = a.g_v[ch + 1], b0 = a.b_v[ch], b1 = a.b_v[ch + 1];
            y[0][2 * d] = (bf_lo(v[0][e][d]) - mean[0]) * rstd[0] * g0 + b0; y[0][2 * d + 1] = (bf_hi(v[0][e][d]) - mean[0]) * rstd[0] * g1 + b1;
            y[1][2 * d] = (bf_lo(v[1][e][d]) - mean[1]) * rstd[1] * g0 + b0; y[1][2 * d + 1] = (bf_hi(v[1][e][d]) - mean[1]) * rstd[1] * g1 + b1;
            *(LAS unsigned*)(lds + ch * 272 + 4 * l) = pk2(y[0][2 * d], y[1][2 * d]);
            *(LAS unsigned*)(lds + (ch + 1) * 272 + 4 * l) = pk2(y[0][2 * d + 1], y[1][2 * d + 1]); }
        if (wout) {
#pragma unroll
            for (int rr = 0; rr < 2; ++rr) { float* o = op + rr * 512 + 64 * w + 8 * e; __builtin_nontemporal_store((f32x4){y[rr][0], y[rr][1], y[rr][2], y[rr][3]}, (f32x4*)o); __builtin_nontemporal_store((f32x4){y[rr][4], y[rr][5], y[rr][6], y[rr][7]}, (f32x4*)(o + 4)); } }
    }
    bf16x8 wf[4][4];
#pragma unroll
    for (int mt = 0; mt < 4; ++mt)
#pragma unroll
        for (int ks = 0; ks < 4; ++ks) wf[mt][ks] = *(const bf16x8*)(Wg + (64 * ih + 16 * mt + fr) * 128 + 32 * ks + 8 * fq);
    __syncthreads();
    const int nks = ih ? 4 : 2;
    for (int np = 0; np < 2; ++np) {
        u32x2 uu[4][4];
#pragma unroll
        for (int mt = 0; mt < 4; ++mt)
#pragma unroll
            for (int nt = 0; nt < 4; ++nt) uu[mt][nt] = *(const u32x2*)(Z + (size_t)(row0 + 64 * ih + 16 * mt + fr) * DIN + g * 128 + np * 64 + nt * 16 + 4 * fq);
        f32x4 acc[4][4];
#pragma unroll
        for (int i = 0; i < 4; ++i)
#pragma unroll
            for (int j = 0; j < 4; ++j) acc[i][j] = (f32x4){0.f, 0.f, 0.f, 0.f};
#pragma unroll
        for (int ks = 0; ks < 4; ++ks) if (ks < nks) {
            bf16x8 vf[4];
#pragma unroll
            for (int nt = 0; nt < 4; ++nt) vf[nt] = *(const LAS bf16x8*)(lds + (g * 128 + np * 64 + nt * 16 + fr) * 272 + (32 * ks + 8 * fq) * 2);
#pragma unroll
            for (int mt = 0; mt < 4; ++mt)
#pragma unroll
                for (int nt = 0; nt < 4; ++nt) acc[mt][nt] = __builtin_amdgcn_mfma_f32_16x16x32_bf16(vf[nt], wf[mt][ks], acc[mt][nt], 0, 0, 0);
        }
#pragma unroll
        for (int mt = 0; mt < 4; ++mt) { const int i = 64 * ih + 16 * mt + fr; const float bias = a.b_s[g * 128 + (c >= 128 ? (i & 7) : i)];
#pragma unroll
            for (int nt = 0; nt < 4; ++nt) { bf16_t* up = Z + (size_t)(row0 + i) * DIN + g * 128 + np * 64 + nt * 16 + 4 * fq;
                const u32x2 u2 = uu[mt][nt]; u32x2 o;
                o.x = pk2(bf_lo(u2.x) * (acc[mt][nt][0] + bias), bf_hi(u2.x) * (acc[mt][nt][1] + bias));
                o.y = pk2(bf_lo(u2.y) * (acc[mt][nt][2] + bias), bf_hi(u2.y) * (acc[mt][nt][3] + bias));
                *(u32x2*)up = o; } }
    }
}
template <int WIN, bool SAMPLE>
__device__ __forceinline__ void p2b_rows(const Args& a, const float* P, bf16_t* Z, int grow0, int ch) {
#pragma unroll 1
    for (int r4 = 0; r4 < 32; r4 += 4) {
        float v[4][WIN];
#pragma unroll
        for (int i = 0; i < 4; ++i) { const int grow = grow0 + r4 + i;
            if (!SAMPLE) { const int t = grow & 2047;
#pragma unroll
                for (int k = 0; k < WIN; ++k) v[i][k] = (t - k >= 0) ? P[(size_t)(grow - k) * 256 + ch] : 0.f;
            } else { const int sr = grow - MP, b = sr >> 3, t = sr & 7;
#pragma unroll
                for (int k = 0; k < WIN; ++k) v[i][k] = (t - k >= 0) ? P[(size_t)(grow - k) * 256 + ch] : a.state_pool[((size_t)b * 15 + 15 + t - k) * 256 + ch];
            } }
#pragma unroll
        for (int i = 0; i < 4; ++i) { const int grow = grow0 + r4 + i; float sum = 0.f;
#pragma unroll
            for (int k = 0; k < WIN; ++k) sum += v[i][k];
            float inv = 1.0f / (float)WIN;
            if (!SAMPLE) { const int t = grow & 2047; if (t + 1 < WIN) inv = 1.0f / (float)(t + 1); }
            Z[(size_t)grow * DIN + 1024 + ch] = (bf16_t)f2bf(sum * inv - v[i][0]); }
    }
}
template <int WIN>
__device__ __forceinline__ void p2b_rows_prompt(const float* P, bf16_t* Z, int grow0, int ch) {
    const int t0 = grow0 & 2047;
    float x[32 + WIN - 1];
#pragma unroll
    for (int j = 0; j < 32 + WIN - 1; ++j) { const int d = j - (WIN - 1); x[j] = (t0 + d >= 0) ? P[(size_t)(grow0 + d) * 256 + ch] : 0.f; }
    float sum = 0.f;
#pragma unroll
    for (int j = 0; j < WIN; ++j) sum += x[j];
#pragma unroll
    for (int i = 0; i < 32; ++i) {
        if (i > 0) sum += x[i + WIN - 1] - x[i - 1];
        const int t = t0 + i; const float inv = (t + 1 < WIN) ? 1.0f / (float)(t + 1) : 1.0f / (float)WIN;
        Z[(size_t)(grow0 + i) * DIN + 1024 + ch] = (bf16_t)f2bf(sum * inv - x[i + WIN - 1]);
    }
}
template <int WIN>
__device__ __forceinline__ void p2b_rows_sample(const Args& a, const float* P, bf16_t* Z, int grow0, int ch) {
    float x[4][8 + WIN - 1];
#pragma unroll
    for (int q = 0; q < 4; ++q) { const int b = (grow0 - MP) / 8 + q;
#pragma unroll
        for (int j = 0; j < 8 + WIN - 1; ++j) { const int d = j - (WIN - 1);
            x[q][j] = d >= 0 ? P[(size_t)(grow0 + 8 * q + d) * 256 + ch] : a.state_pool[((size_t)b * 15 + 15 + d) * 256 + ch]; } }
#pragma unroll
    for (int q = 0; q < 4; ++q) { float sum = 0.f;
#pragma unroll
        for (int j = 0; j < WIN; ++j) sum += x[q][j];
#pragma unroll
        for (int i = 0; i < 8; ++i) { if (i > 0) sum += x[q][i + WIN - 1] - x[q][i - 1];
            Z[(size_t)(grow0 + 8 * q + i) * DIN + 1024 + ch] = (bf16_t)f2bf(sum * (1.0f / (float)WIN) - x[q][i + WIN - 1]); } }
}
__device__ __forceinline__ void p2b_unit(const Args& a, int u, int tid) {
    bf16_t* Z = (bf16_t*)(a.ws + WS_Z);
    const float* P = (const float*)((const unsigned char*)a.out + OS_P);
    const int ch = tid & 255, grow0 = u * 64 + (tid >> 8) * 32, gi = __builtin_amdgcn_readfirstlane(ch >> 6);
    if (grow0 < MP) { if (gi == 0) p2b_rows_prompt<2>(P, Z, grow0, ch); else if (gi == 1) p2b_rows_prompt<4>(P, Z, grow0, ch); else if (gi == 2) p2b_rows_prompt<8>(P, Z, grow0, ch); else p2b_rows_prompt<16>(P, Z, grow0, ch); }
    else { if (gi == 0) p2b_rows_sample<2>(a, P, Z, grow0, ch); else if (gi == 1) p2b_rows_sample<4>(a, P, Z, grow0, ch); else if (gi == 2) p2b_rows_sample<8>(a, P, Z, grow0, ch); else p2b_rows_sample<16>(a, P, Z, grow0, ch); }
}
__device__ __forceinline__ void attn_wave(const Args& a, int qrow0, int valid, int kvb, int h, int lane) {
    bf16_t* Z = (bf16_t*)(a.ws + WS_Z);
    const bf16_t* KB = (const bf16_t*)((const unsigned char*)a.out + OS_KB) + (size_t)kvb * 65536 + h * 64;
    const bf16_t* VT = (const bf16_t*)((const unsigned char*)a.out + OS_VTB) + (size_t)kvb * 65536 + (size_t)(h * 64) * 256;
    const int fr = lane & 15, fq = lane >> 4;
    const int qr = qrow0 + (fr < valid ? fr : valid - 1);
    bf16x8 qf[2];
#pragma unroll
    for (int ks = 0; ks < 2; ++ks) qf[ks] = *(const bf16x8*)(Z + (size_t)qr * DIN + 1280 + h * 64 + 32 * ks + 8 * fq);
    f32x4 s[16];
#pragma unroll
    for (int t = 0; t < 16; ++t) { s[t] = (f32x4){0.f, 0.f, 0.f, 0.f};
        const int key = 32 * (t >> 1) + 8 * (fr >> 2) + 4 * (t & 1) + (fr & 3);
#pragma unroll
        for (int ks = 0; ks < 2; ++ks) { bf16x8 kf;
            if (kvb < 8) kf = *(const bf16x8*)(KB + (size_t)key * 256 + 32 * ks + 8 * fq);
            else { const f32x4* kp = (const f32x4*)(a.cache_k + (size_t)(kvb - 8) * 65536 + (size_t)key * 256 + h * 64 + 32 * ks + 8 * fq); const f32x4 k0 = __builtin_nontemporal_load(kp), k1 = __builtin_nontemporal_load(kp + 1);
                u32x4 kw; kw.x = pk2(k0[0], k0[1]); kw.y = pk2(k0[2], k0[3]); kw.z = pk2(k1[0], k1[1]); kw.w = pk2(k1[2], k1[3]); kf = __builtin_bit_cast(bf16x8, kw); }
            s[t] = __builtin_amdgcn_mfma_f32_16x16x32_bf16(kf, qf[ks], s[t], 0, 0, 0); } }
    float mx = -3.0e38f;
#pragma unroll
    for (int t = 0; t < 16; ++t) mx = fmaxf(mx, fmaxf(fmaxf(s[t][0], s[t][1]), fmaxf(s[t][2], s[t][3])));
    mx = fmaxf(mx, __shfl_xor(mx, 16)); mx = fmaxf(mx, __shfl_xor(mx, 32));
    const float sc = 0.125f * 1.4426950409f; float sum = 0.f;
#pragma unroll
    for (int t = 0; t < 16; ++t)
#pragma unroll
        for (int e = 0; e < 4; ++e) { const float p = __builtin_amdgcn_exp2f((s[t][e] - mx) * sc); s[t][e] = p; sum += p; }
    sum += __shfl_xor(sum, 16); sum += __shfl_xor(sum, 32);
    const float rs = 1.0f / sum;
    f32x4 o[4];
#pragma unroll
    for (int dt = 0; dt < 4; ++dt) o[dt] = (f32x4){0.f, 0.f, 0.f, 0.f};
#pragma unroll
    for (int sk = 0; sk < 8; ++sk) { u32x4 pw; pw.x = pk2(s[2 * sk][0], s[2 * sk][1]); pw.y = pk2(s[2 * sk][2], s[2 * sk][3]); pw.z = pk2(s[2 * sk + 1][0], s[2 * sk + 1][1]); pw.w = pk2(s[2 * sk + 1][2], s[2 * sk + 1][3]);
        const bf16x8 pf = __builtin_bit_cast(bf16x8, pw);
#pragma unroll
        for (int dt = 0; dt < 4; ++dt) { const bf16x8 vf = *(const bf16x8*)(VT + (size_t)(16 * dt + fr) * 256 + 32 * sk + 8 * fq);
            o[dt] = __builtin_amdgcn_mfma_f32_16x16x32_bf16(vf, pf, o[dt], 0, 0, 0); } }
    if (fr < valid) {
#pragma unroll
        for (int dt = 0; dt < 4; ++dt) { u32x2 w; w.x = pk2(o[dt][0] * rs, o[dt][1] * rs); w.y = pk2(o[dt][2] * rs, o[dt][3] * rs);
            *(u32x2*)(Z + (size_t)(qrow0 + fr) * DIN + 1280 + h * 64 + 16 * dt + 4 * fq) = w; } }
}
__device__ __forceinline__ void attn_block_prompt(const Args& a, LAS unsigned char* lds, int c, int h, int tid) {
    const int w = tid >> 6, lane = tid & 63, fr = lane & 15, fq = lane >> 4, kvb = c >> 4, qrow0 = c * 128 + 16 * w;
    bf16_t* Z = (bf16_t*)(a.ws + WS_Z);
    const bf16_t* KB = (const bf16_t*)((const unsigned char*)a.out + OS_KB) + (size_t)kvb * 65536 + h * 64;
    const bf16_t* VT = (const bf16_t*)((const unsigned char*)a.out + OS_VTB) + (size_t)kvb * 65536 + (size_t)(h * 64) * 256;
    u32x4 kst[4], vst[4];
#pragma unroll
    for (int i = 0; i < 4; ++i) { const int ck = tid + 512 * i;
        kst[i] = *(const u32x4*)(KB + (size_t)(ck >> 3) * 256 + (ck & 7) * 8);
        vst[i] = *(const u32x4*)(VT + (size_t)(ck >> 5) * 256 + (ck & 31) * 8); }
    bf16x8 qf[2];
#pragma unroll
    for (int ks = 0; ks < 2; ++ks) qf[ks] = *(const bf16x8*)(Z + (size_t)(qrow0 + fr) * DIN + 1280 + h * 64 + 32 * ks + 8 * fq);
    __syncthreads();
#pragma unroll
    for (int i = 0; i < 4; ++i) { const int ck = tid + 512 * i;
        *(LAS u32x4*)(lds + (ck >> 3) * 144 + (ck & 7) * 16) = kst[i];
        *(LAS u32x4*)(lds + 36864 + (ck >> 5) * 528 + (ck & 31) * 16) = vst[i]; }
    __syncthreads();
    f32x4 s[16];
#pragma unroll
    for (int t = 0; t < 16; ++t) { s[t] = (f32x4){0.f, 0.f, 0.f, 0.f};
        const int key = 32 * (t >> 1) + 8 * (fr >> 2) + 4 * (t & 1) + (fr & 3);
#pragma unroll
        for (int ks = 0; ks < 2; ++ks) { const bf16x8 kf = *(const LAS bf16x8*)(lds + key * 144 + (32 * ks + 8 * fq) * 2);
            s[t] = __builtin_amdgcn_mfma_f32_16x16x32_bf16(kf, qf[ks], s[t], 0, 0, 0); } }
    float mx = -3.0e38f;
#pragma unroll
    for (int t = 0; t < 16; ++t) mx = fmaxf(mx, fmaxf(fmaxf(s[t][0], s[t][1]), fmaxf(s[t][2], s[t][3])));
    mx = fmaxf(mx, __shfl_xor(mx, 16)); mx = fmaxf(mx, __shfl_xor(mx, 32));
    const float sc = 0.125f * 1.4426950409f; float sum = 0.f;
#pragma unroll
    for (int t = 0; t < 16; ++t)
#pragma unroll
        for (int e = 0; e < 4; ++e) { const float pe = __builtin_amdgcn_exp2f((s[t][e] - mx) * sc); s[t][e] = pe; sum += pe; }
    sum += __shfl_xor(sum, 16); sum += __shfl_xor(sum, 32);
    const float rs = 1.0f / sum;
    f32x4 o[4];
#pragma unroll
    for (int dt = 0; dt < 4; ++dt) o[dt] = (f32x4){0.f, 0.f, 0.f, 0.f};
#pragma unroll
    for (int sk = 0; sk < 8; ++sk) { u32x4 pw; pw.x = pk2(s[2 * sk][0], s[2 * sk][1]); pw.y = pk2(s[2 * sk][2], s[2 * sk][3]); pw.z = pk2(s[2 * sk + 1][0], s[2 * sk + 1][1]); pw.w = pk2(s[2 * sk + 1][2], s[2 * sk + 1][3]);
        const bf16x8 pf = __builtin_bit_cast(bf16x8, pw);
#pragma unroll
        for (int dt = 0; dt < 4; ++dt) { const bf16x8 vf = *(const LAS bf16x8*)(lds + 36864 + (16 * dt + fr) * 528 + (32 * sk + 8 * fq) * 2);
            o[dt] = __builtin_amdgcn_mfma_f32_16x16x32_bf16(vf, pf, o[dt], 0, 0, 0); } }
#pragma unroll
    for (int dt = 0; dt < 4; ++dt) { u32x2 wv; wv.x = pk2(o[dt][0] * rs, o[dt][1] * rs); wv.y = pk2(o[dt][2] * rs, o[dt][3] * rs);
        *(u32x2*)(Z + (size_t)(qrow0 + fr) * DIN + 1280 + h * 64 + 16 * dt + 4 * fq) = wv; }
}
__device__ __forceinline__ void p2_mixers(const Args& a, LAS unsigned char* lds, int tid, int G) {
    const int w = tid >> 6, lane = tid & 63;
    {
        const float* P = (const float*)((const unsigned char*)a.out + OS_P);
        constexpr int TOT = 30720 + 491520;
        for (int base = blockIdx.x * 512 + tid; base < TOT; base += 4 * G * 512) {
            float val[4]; float* dst[4];
#pragma unroll
            for (int k = 0; k < 4; ++k) { const int idx = base + k * G * 512; dst[k] = nullptr; val[k] = 0.f;
                if (idx < TOT) {
                    if (idx < 30720) { const int b = idx / 3840, rem = idx % 3840; dst[k] = a.out + O_PP + idx; val[k] = P[(size_t)(b * 2048 + 2033) * 256 + rem]; }
                    else { const int j = idx - 30720, b = j / 3840, rem = j % 3840, sx = rem >> 8, cc = rem & 255; dst[k] = a.out + O_PS + j;
                        val[k] = sx < 7 ? a.state_pool[((size_t)b * 15 + 8 + sx) * 256 + cc] : P[(size_t)(MP + b * 8 + (sx - 7)) * 256 + cc]; } } }
#pragma unroll
            for (int k = 0; k < 4; ++k) if (dst[k]) *dst[k] = val[k];
        }
    }
    for (int it = blockIdx.x; it < 136; it += G) p2a_unit(a, lds, it, tid);
    { int u0 = ((int)blockIdx.x - 136) % G; if (u0 < 0) u0 += G;
      for (int u = u0; u < 272; u += G) p2b_unit(a, u, tid); }
    { int u0 = ((int)blockIdx.x - 408) % G; if (u0 < 0) u0 += G;
      for (int idx = u0; idx < 576; idx += G) {
        if (idx < 512) { attn_block_prompt(a, lds, idx >> 2, idx & 3, tid); }
        else { const int batch = 2 * (idx - 512) + (w >> 2); attn_wave(a, MP + 8 * batch, 8, 8 + batch, w & 3, lane); } } }
}
__device__ __forceinline__ void p7_final(const Args& a, LAS unsigned char* lds, int tid, int G) {
    const int wave = tid >> 6, lane = tid & 63;
    const f32x4* gr = (const f32x4*)a.g_final + lane;
    const bool split = (G == 256);
    for (int r2 = blockIdx.x * 8 + wave; r2 < (split ? 0 : MT) / 2; r2 += G * 8) {
        f32x4* xa = (f32x4*)(a.out + (size_t)(2 * r2) * DM) + lane; f32x4* xb = xa + DM / 4; f32x4 v[2][4]; float s0 = 0.f, s1 = 0.f;
#pragma unroll
        for (int j = 0; j < 4; ++j) { v[0][j] = xa[64 * j]; v[1][j] = xb[64 * j]; }
#pragma unroll
        for (int j = 0; j < 4; ++j) { s0 += (v[0][j][0] * v[0][j][0] + v[0][j][1] * v[0][j][1]) + (v[0][j][2] * v[0][j][2] + v[0][j][3] * v[0][j][3]);
                                      s1 += (v[1][j][0] * v[1][j][0] + v[1][j][1] * v[1][j][1]) + (v[1][j][2] * v[1][j][2] + v[1][j][3] * v[1][j][3]); }
        const float r0 = 1.0f / sqrtf(wave_sum(s0) * (1.0f / DM) + EPS), r1 = 1.0f / sqrtf(wave_sum(s1) * (1.0f / DM) + EPS);
#pragma unroll
        for (int j = 0; j < 4; ++j) { const f32x4 gg = gr[64 * j]; xa[64 * j] = v[0][j] * r0 * gg; xb[64 * j] = v[1][j] * r1 * gg; }
    }
    if (split) {
        LAS float* red = (LAS float*)lds;
        const int rr = tid >> 7, t7 = tid & 127, c8 = t7 * 8;
        const f32x4 g0 = *(const f32x4*)(a.g_final + c8), g1 = *(const f32x4*)(a.g_final + c8 + 4);
        for (int sr0 = blockIdx.x * 4; sr0 < MS; sr0 += G * 4) { const int sr = sr0 + rr;
            const u32x4 xw = __builtin_nontemporal_load((const u32x4*)((const bf16_t*)(a.ws + WS_X1B_HI) + (size_t)(MP + sr - X1B_SPLIT * 256) * DM + c8));
            f32x4 pv[16][2];
#pragma unroll
            for (int k = 0; k < 16; ++k) { const f32x4* pp = (const f32x4*)(part_base(a.ws, k) + (size_t)sr * DM + c8); pv[k][0] = pp[0]; pv[k][1] = pp[1]; }
            f32x4 v0 = (f32x4){bf_lo(xw.x), bf_hi(xw.x), bf_lo(xw.y), bf_hi(xw.y)}, v1 = (f32x4){bf_lo(xw.z), bf_hi(xw.z), bf_lo(xw.w), bf_hi(xw.w)};
#pragma unroll
            for (int k = 0; k < 16; ++k) { v0 += pv[k][0]; v1 += pv[k][1]; }
            const float ws_ = wave_sum((v0[0] * v0[0] + v0[1] * v0[1]) + (v0[2] * v0[2] + v0[3] * v0[3]) + (v1[0] * v1[0] + v1[1] * v1[1]) + (v1[2] * v1[2] + v1[3] * v1[3]));
            __syncthreads();
            if (lane == 0) red[wave] = ws_;
            __syncthreads();
            const float rstd = 1.0f / sqrtf((red[2 * rr] + red[2 * rr + 1]) * (1.0f / DM) + EPS);
            float* xo = a.out + (size_t)(MP + sr) * DM + c8;
            __builtin_nontemporal_store(v0 * rstd * g0, (f32x4*)xo); __builtin_nontemporal_store(v1 * rstd * g1, (f32x4*)(xo + 4));
        }
    }
}

#define XB_TMO      128
#define XB_XCNT(j)  (256  + 64 * (j))
#define XB_XSUB(j)  (1280 + 64 * (j))
#define XB_XGEN(j)  (2304 + 64 * (j))
#define XB_TOP      3328
#define XB_TOPGEN   3392
#define XCD_BAR_WORDS 3456
#define XB_SPIN_CAP (1u << 18)
__device__ __forceinline__ unsigned xb_ld(unsigned* p)              { return __hip_atomic_load(p, __ATOMIC_RELAXED, __HIP_MEMORY_SCOPE_AGENT); }
__device__ __forceinline__ unsigned xb_add(unsigned* p, unsigned v) { return __hip_atomic_fetch_add(p, v, __ATOMIC_RELAXED, __HIP_MEMORY_SCOPE_AGENT); }
__device__ __forceinline__ unsigned xb_xcc_id() { return (unsigned)__builtin_amdgcn_s_getreg((3 << 11) | 20) & 0xFu; }
#define XB_SPIN(cond, bar) do { unsigned _sp = 0; while (cond) { __builtin_amdgcn_s_sleep(1); \
    if ((++_sp & 255u) == 0u) { if (xb_ld(&(bar)[XB_TMO])) break; if (_sp > XB_SPIN_CAP) { atomicAdd(&(bar)[XB_TMO], 1u); break; } } } } while (0)
struct XcdBarrier { unsigned* bar; unsigned x; volatile LAS unsigned* st; };
__device__ __forceinline__ XcdBarrier xcd_barrier_post(unsigned* bar, volatile LAS unsigned* st, int wave_s) {
    XcdBarrier b; b.bar = bar; b.x = xb_xcc_id(); b.st = st;
    if (wave_s == 0 && lane_id() == 0) (void)xb_add(&bar[XB_XCNT(b.x)], 1u);
    return b;
}
__device__ __forceinline__ void xcd_barrier_complete(unsigned* bar, unsigned x, unsigned& nloc, unsigned& nx) {
    const unsigned G = gridDim.x * gridDim.y * gridDim.z;
    unsigned sum, cnt, mine, sp = 0u;
    for (;;) {
        sum = 0u; cnt = 0u; mine = 0u;
#pragma unroll
        for (unsigned j = 0; j < 16; ++j) { const unsigned c = xb_ld(&bar[XB_XCNT(j)]); sum += c; cnt += (c > 0u) ? 1u : 0u; mine = (j == x) ? c : mine; }
        if (sum == G) break;
        __builtin_amdgcn_s_sleep(1);
        if ((++sp & 255u) == 0u) { if (xb_ld(&bar[XB_TMO])) break; if (sp > XB_SPIN_CAP) { atomicAdd(&bar[XB_TMO], 1u); break; } }
    }
    nloc = mine > 0u ? mine : 1u; nx = cnt > 0u ? cnt : 1u;
}
__device__ __forceinline__ void xcd_barrier(const XcdBarrier& b, int wave_s) {
    asm volatile("s_waitcnt vmcnt(0)" ::: "memory");
    __syncthreads();
    if (wave_s == 0 && lane_id() == 0) {
        unsigned* bar = b.bar;
        __builtin_amdgcn_s_waitcnt(0);
        unsigned nloc = b.st[0], nx = b.st[1];
        if (nloc == 0u) { xcd_barrier_complete(bar, b.x, nloc, nx); b.st[0] = nloc; b.st[1] = nx; }
        const unsigned old = xb_add(&bar[XB_XSUB(b.x)], 1u);
        const unsigned gen = old / nloc;
        if (old + 1u == (gen + 1u) * nloc) {
            __builtin_amdgcn_fence(__ATOMIC_RELEASE, "agent");
            asm volatile("s_waitcnt vmcnt(0)" ::: "memory");
            const unsigned og = xb_add(&bar[XB_TOP], 1u);
            const unsigned tg = og / nx;
            if (og + 1u == (tg + 1u) * nx) xb_add(&bar[XB_TOPGEN], 1u);
            else XB_SPIN(xb_ld(&bar[XB_TOPGEN]) == tg, bar);
            __builtin_amdgcn_fence(__ATOMIC_ACQUIRE, "agent");
            xb_add(&bar[XB_XGEN(b.x)], 1u);
            asm volatile("s_waitcnt vmcnt(0)" ::: "memory");
        } else {
            XB_SPIN(xb_ld(&bar[XB_XGEN(b.x)]) == gen, bar);
            __builtin_amdgcn_fence(__ATOMIC_ACQUIRE, "agent");
            asm volatile("s_waitcnt vmcnt(0)" ::: "memory");
        }
    }
    __syncthreads();
}

__device__ __forceinline__ void panel_signal(unsigned* cnt, int wave_s) {
    asm volatile("s_waitcnt vmcnt(0)" ::: "memory");
    __syncthreads();
    if (wave_s == 0 && lane_id() == 0) (void)xb_add(cnt, 1u);
}
__device__ __forceinline__ void panel_wait(unsigned* cnt, unsigned want, unsigned* bar, int wave_s) {
    if (wave_s == 0 && lane_id() == 0) { XB_SPIN(xb_ld(cnt) < want, bar); __builtin_amdgcn_fence(__ATOMIC_ACQUIRE, "agent"); asm volatile("s_waitcnt vmcnt(0)" ::: "memory"); }
    __syncthreads();
}

template <bool P3S>
__device__ __forceinline__ void mini_block(const Args& a, LAS unsigned char* lds, int blk, int tid) {
    const int w = tid >> 6, lane = tid & 63, fr = lane & 15, fq = lane >> 4, rb = blk >> 4, cb = blk & 15;
    const int k0 = 128 * w;
    const bf16_t* Ab; int lda, acol;
    if (P3S) { Ab = (const bf16_t*)(a.ws + WS_Z); lda = DIN; acol = k0 + (k0 >= 512 ? 512 : 0); }
    else { Ab = (const bf16_t*)(a.ws + WS_XN); lda = DM; acol = k0; }
    const bf16_t* Bb = (const bf16_t*)(a.ws + (P3S ? WS_WBR : WS_WO));
    bf16x8 af[4][4], bf[4][4];
#pragma unroll
    for (int t = 0; t < 4; ++t)
#pragma unroll
        for (int ks = 0; ks < 4; ++ks) { af[t][ks] = *(const bf16x8*)(Ab + (size_t)(MP + 64 * rb + 16 * t + fr) * lda + acol + 32 * ks + 8 * fq);
                                         bf[t][ks] = *(const bf16x8*)(Bb + (size_t)(64 * cb + 16 * t + fr) * 1024 + k0 + 32 * ks + 8 * fq); }
    f32x4 acc[4][4];
#pragma unroll
    for (int mt = 0; mt < 4; ++mt)
#pragma unroll
        for (int nt = 0; nt < 4; ++nt) acc[mt][nt] = (f32x4){0.f, 0.f, 0.f, 0.f};
#pragma unroll
    for (int ks = 0; ks < 4; ++ks)
#pragma unroll
        for (int mt = 0; mt < 4; ++mt)
#pragma unroll
            for (int nt = 0; nt < 4; ++nt) acc[mt][nt] = __builtin_amdgcn_mfma_f32_16x16x32_bf16(bf[nt][ks], af[mt][ks], acc[mt][nt], 0, 0, 0);
    LAS float* red = (LAS float*)lds;
    __syncthreads();
#pragma unroll
    for (int mt = 0; mt < 4; ++mt)
#pragma unroll
        for (int nt = 0; nt < 4; ++nt) *(LAS f32x4*)(red + (size_t)((w * 64 + 16 * mt + fr) * 68 + 16 * nt + 4 * fq)) = acc[mt][nt];
    __syncthreads();
    const int r = tid >> 3, c8 = (tid & 7) * 8, row = MP + 64 * rb + r, col = 64 * cb + c8;
    f32x4 s0[3], s1[3];
#pragma unroll
    for (int g = 0; g < 3; ++g) { s0[g] = (f32x4){0.f, 0.f, 0.f, 0.f}; s1[g] = s0[g]; }
#pragma unroll
    for (int ww = 0; ww < 8; ++ww) { const int g = P3S ? (ww < 4 ? 0 : (ww < 6 ? 1 : 2)) : 0; const LAS f32x4* pp = (const LAS f32x4*)(red + (size_t)((ww * 64 + r) * 68 + c8)); s0[g] += pp[0]; s1[g] += pp[1]; }
    if (P3S) {
        bf16_t* MG = (bf16_t*)(a.ws + WS_XN);
        const unsigned char* gp = (const unsigned char*)(a.ws + WS_Z) + (size_t)row * (DIN * 2) + 3072 + (col & ~255) + ((col & 127) >> 3) * 16 + ((col >> 7) & 1) * 8;
        const u32x2 qa = *(const u32x2*)gp, qb = *(const u32x2*)(gp + 1024), qc = *(const u32x2*)(gp + 2048); const float k = 1.0f / 255.0f;
        float m[8];
        m[0] = (s0[0][0] * ub0(qa.x) + s0[1][0] * ub0(qb.x) + s0[2][0] * ub0(qc.x)) * k; m[1] = (s0[0][1] * ub1(qa.x) + s0[1][1] * ub1(qb.x) + s0[2][1] * ub1(qc.x)) * k;
        m[2] = (s0[0][2] * ub2(qa.x) + s0[1][2] * ub2(qb.x) + s0[2][2] * ub2(qc.x)) * k; m[3] = (s0[0][3] * ub3(qa.x) + s0[1][3] * ub3(qb.x) + s0[2][3] * ub3(qc.x)) * k;
        m[4] = (s1[0][0] * ub0(qa.y) + s1[1][0] * ub0(qb.y) + s1[2][0] * ub0(qc.y)) * k; m[5] = (s1[0][1] * ub1(qa.y) + s1[1][1] * ub1(qb.y) + s1[2][1] * ub1(qc.y)) * k;
        m[6] = (s1[0][2] * ub2(qa.y) + s1[1][2] * ub2(qb.y) + s1[2][2] * ub2(qc.y)) * k; m[7] = (s1[0][3] * ub3(qa.y) + s1[1][3] * ub3(qb.y) + s1[2][3] * ub3(qc.y)) * k;
        u32x4 o; o.x = pk2(m[0], m[1]); o.y = pk2(m[2], m[3]); o.z = pk2(m[4], m[5]); o.w = pk2(m[6], m[7]);
        *(u32x4*)(MG + (size_t)row * DM + col) = o;
    } else {
        const f32x4* xp = (const f32x4*)(a.x_sample + (size_t)(row - MP) * DM + col);
        const f32x4 v0 = s0[0] + __builtin_nontemporal_load(xp), v1 = s1[0] + __builtin_nontemporal_load(xp + 1);
        u32x4 o; o.x = pk2(v0[0], v0[1]); o.y = pk2(v0[2], v0[3]); o.z = pk2(v1[0], v1[1]); o.w = pk2(v1[2], v1[3]);
        *(u32x4*)((bf16_t*)(a.ws + WS_X1B_HI) + (size_t)(row - X1B_SPLIT * 256) * DM + col) = o;
        float ss = (v0[0] * v0[0] + v0[1] * v0[1]) + (v0[2] * v0[2] + v0[3] * v0[3]) + (v1[0] * v1[0] + v1[1] * v1[1]) + (v1[2] * v1[2] + v1[3] * v1[3]);
        ss += __shfl_xor(ss, 1); ss += __shfl_xor(ss, 2); ss += __shfl_xor(ss, 4);
        if ((tid & 7) == 0) ((float*)(a.ws + WS_SSP))[(size_t)row * 16 + cb] = ss;
    }
    __syncthreads();
}

__global__ void __launch_bounds__(512, 2) fwd_kernel(Args a) {
    extern __shared__ __attribute__((aligned(16))) unsigned char lds_raw[];
    LAS unsigned char* lds = (LAS unsigned char*)lds_raw;
    cg::grid_group grid = cg::this_grid();
    const int wave_s = __builtin_amdgcn_readfirstlane((int)threadIdx.x >> 6);
#define tid (wave_s * 64 + lane_id())
    const int G = gridDim.x, c = blockIdx.x;
    const int lo = a.ph_lo, hi = a.ph_hi;
#define IN(k) (lo <= (k) && (k) < hi)
#define SEAM(k) do { if (IN(k) && IN((k) + 1)) xcd_barrier(bar, wave_s); } while (0)
    if (tid < 64) ((LAS unsigned*)(lds + 147456))[tid] = 0u;
    __syncthreads();
    const XcdBarrier bar = xcd_barrier_post((unsigned*)a.ws, (volatile LAS unsigned*)(lds + 147456), wave_s);
    if (lo < 0) grid.sync();
    bf16_t* XN = (bf16_t*)(a.ws + WS_XN); bf16_t* Z = (bf16_t*)(a.ws + WS_Z); bf16_t* MG = XN; bf16_t* H = Z; bf16_t* X1Blo = (bf16_t*)(a.ws + WS_X1B_LO); bf16_t* X1Bhi = (bf16_t*)(a.ws + WS_X1B_HI);
    float* SSP = (float*)(a.ws + WS_SSP);
    constexpr int REPS[8] = {1, 1, 1, 1, 1, 1, 1, 1};
    if (IN(0)) { for (int rep = 0; rep < REPS[0]; ++rep) p0_prologue(a, lds, tid, G); } SEAM(0);
    if (IN(1)) { for (int rep = 0; rep < REPS[1]; ++rep) { pg8::Gemm g{XN, (const bf16_t*)(a.ws + WS_WIN), 1024, 1024, nullptr, 1 << 30}; SchedP1 S{G, c};
        EpiP1 E{Z, (float*)((unsigned char*)a.out + OS_P), a.out + O_MK, a.out + O_MV, (bf16_t*)((unsigned char*)a.out + OS_KB), (bf16_t*)((unsigned char*)a.out + OS_VTB)};
        pg8::gemm_phase(lds, g, S, E, wave_s); } } SEAM(1);
    if (IN(2)) { p2_mixers(a, lds, tid, G); } SEAM(2);
    if (IN(3)) {
        unsigned* cnt = (unsigned*)a.ws + 8192;
        const pg8::Gemm g3{Z, (const bf16_t*)(a.ws + WS_WBR), DIN, 1024, nullptr, 1 << 30}; const EpiP3 E3{Z, MG, G != 256};
        const pg8::Gemm g4{MG, (const bf16_t*)(a.ws + WS_WO), 1024, 1024, nullptr, 1 << 30}; const EpiP4 E4{a.x_prompt, a.x_sample, a.out, X1Blo, X1Bhi, SSP, (float*)(a.ws + WS_SSP4), lds};
        if (G == 256) {
            int pm, pn; pg8::tile_map(64, 4, c, pm, pn);
            { SchedOne3 S{pm, pn}; pg8::gemm_phase(lds, g3, S, E3, wave_s); }
            mini_block<true>(a, lds, c, tid);
            xcd_barrier(bar, wave_s);
            { SchedOne S{pm, pn, 16}; pg8::gemm_phase(lds, g4, S, E4, wave_s); }
            mini_block<false>(a, lds, c, tid);
        } else {
            for (int L = c; L < 272; L += G) { int pm, pn; tile272(L, pm, pn); SchedOne3 S{pm, pn}; pg8::gemm_phase(lds, g3, S, E3, wave_s); panel_signal(cnt + 64 * pm, wave_s); }
            int L0 = (c - 16) % G; if (L0 < 0) L0 += G;
            for (int L = L0; L < 272; L += G) { int pm, pn; tile272(L, pm, pn); panel_wait(cnt + 64 * pm, 4u, (unsigned*)a.ws, wave_s); SchedOne S{pm, pn, 16}; pg8::gemm_phase(lds, g4, S, E4, wave_s); }
        }
        p0_deferred(a, lds, tid, G);
    } SEAM(4);
    if (IN(5)) { for (int rep = 0; rep < REPS[5]; ++rep) { pg8::Gemm g{X1Blo, (const bf16_t*)(a.ws + WS_WUP), 1024, 1024, X1Bhi, X1B_SPLIT}; SchedT S{68, 16, 16, G, c}; EpiP5 E{SSP, H, (const float*)(a.ws + WS_SSP4), G == 256 ? 64 : 68}; pg8::gemm_phase(lds, g, S, E, wave_s); } } SEAM(5);
    if (IN(6)) { pg8::Gemm g{H, (const bf16_t*)(a.ws + WS_WDN), DFF, DFF, nullptr, 1 << 30}; SchedP6 S{G, c};
        if (G == 256) { EpiP6F E{a.out, a.ws, X1Blo, X1Bhi, a.out + (size_t)MP * DM  , (unsigned*)a.ws + 8192 + 64 * 68, (unsigned*)a.ws, a.g_final, lds}; pg8::gemm_phase(lds, g, S, E, wave_s); }
        else { EpiP6 E{a.out, a.ws, X1Blo, X1Bhi}; pg8::gemm_phase(lds, g, S, E, wave_s); } } SEAM(6);
    if (IN(7)) { p7_final(a, lds, tid, G); }
#undef IN
#undef SEAM
#undef tid
}

extern "C" void kernel_launch(void* const* d_in, const int* in_sizes, int n_in, void* d_out, int out_size, void* d_ws, size_t ws_size, hipStream_t stream) {
    static int grid = 0;
    if (grid == 0) {
        int dev = 0, cus = 0, per_cu = 0;
        if (n_in != 24 || ws_size < 256 * MiB) { fprintf(stderr, "kernel_launch: unexpected n_in %d / ws %zu\n", n_in, ws_size); grid = -1; return; }
        (void)hipGetDevice(&dev);
        (void)hipDeviceGetAttribute(&cus, hipDeviceAttributeMultiprocessorCount, dev);
        if (hipFuncSetAttribute((const void*)fwd_kernel, hipFuncAttributeMaxDynamicSharedMemorySize, LDS_BYTES) != hipSuccess) fprintf(stderr, "kernel_launch: hipFuncSetAttribute failed\n");
        if (hipOccupancyMaxActiveBlocksPerMultiprocessor(&per_cu, (const void*)fwd_kernel, 512, LDS_BYTES) != hipSuccess || per_cu < 1) per_cu = 1;
        (void)hipGetLastError();
        grid = cus * per_cu;
        if (grid <= 0) grid = 256;
    }
    if (grid < 0) return;
    if (hipMemsetAsync(d_ws, 0, 131072, stream) != hipSuccess) { fprintf(stderr, "kernel_launch: memset failed\n"); return; }
    Args a{};
    const float** pp = (const float**)&a;
    for (int i = 0; i < 24; ++i) pp[i] = (const float*)d_in[i];
    a.out = (float*)d_out; a.ws = (unsigned char*)d_ws; a.ph_lo = 0; a.ph_hi = 8;
    void* args[] = {&a};
    hipError_t e = hipLaunchCooperativeKernel((const void*)fwd_kernel, dim3(grid), dim3(512), args, LDS_BYTES, stream);
    if (e != hipSuccess) fprintf(stderr, "kernel_launch: cooperative launch failed: %s (grid %d)\n", hipGetErrorString(e), grid);
}
```
